# Optimizing an MI355X kernel written in HIP

```python
import math
import jax
import jax.numpy as jnp
from jax import lax
import numpy as np

D_MODEL = 1024
BATCH = 32
SEQ = 2048
DEPTH = 4

HG_HEADS = 4
HG_DK = 128
HG_DV = 128
HG_F = HG_HEADS * HG_DK
HG_V = HG_HEADS * HG_DV
HG_CHUNK = 64
SB_HEADS = 8
SB_DH = 64
SB_W = SB_HEADS * SB_DH
SB_BLOCK = 128
PEER_HEADS = 8
PEER_NKEYS = 128
PEER_N = PEER_NKEYS * PEER_NKEYS
PEER_DKEY = 128
PEER_TOPK = 16
PEER_TOK_BLOCK = 16
DN_ALPHA = (2.0 * DEPTH) ** 0.25
DN_BETA = (8.0 * DEPTH) ** -0.25
LN_EPS = 1e-5
RMS_EPS = 1e-6
IN_SIZES = (HG_F, HG_F, HG_V, HG_V, SB_W, SB_W, SB_W, D_MODEL, D_MODEL)
IN_WIDTH = sum(IN_SIZES)
IN_SPLITS = tuple(int(s) for s in np.cumsum(IN_SIZES)[:-1])

kernel_name = "hybrid_hgrn2_stickbreak_peer_deepnorm"


def layer_norm(x, g, b):
    xf = x.astype(jnp.float32)
    mu = jnp.mean(xf, axis=-1, keepdims=True)
    var = jnp.mean(jnp.square(xf - mu), axis=-1, keepdims=True)
    return (xf - mu) * lax.rsqrt(var + LN_EPS) * g + b


def head_rms_norm(o, g):
    of = o.astype(jnp.float32)
    return of * lax.rsqrt(jnp.mean(jnp.square(of), axis=-1, keepdims=True) + RMS_EPS) * g


def hgrn2_chunkwise(q, f_logit, v, lb):
    B, S, H, DK = q.shape
    DV = v.shape[-1]
    C = HG_CHUNK
    NC = S // C
    q = q.astype(jnp.float32)
    z = f_logit.astype(jnp.float32)
    v = v.astype(jnp.float32)
    lb = lb.reshape(H, DK)
    log_f = jnp.log(lb + (1.0 - lb) * jax.nn.sigmoid(z))
    k = (1.0 - lb) * jax.nn.sigmoid(-z)

    def chunks(a):
        return a.reshape(B, NC, C, H, a.shape[-1]).transpose(1, 0, 3, 2, 4)

    qc, kc, vc, gc = chunks(q), chunks(k), chunks(v), chunks(log_f)
    bc = jnp.cumsum(gc, axis=3)
    tri = jnp.tril(jnp.ones((C, C), dtype=bool))[:, :, None]

    def step(state, inp):
        q_, k_, v_, b_ = inp
        b_end = b_[:, :, -1:, :]
        inter = jnp.einsum('bhtd,bhde->bhte', q_ * jnp.exp(b_), state)
        diff = b_[:, :, :, None, :] - b_[:, :, None, :, :]
        decay = jnp.where(tri, jnp.exp(jnp.where(tri, diff, 0.0)), 0.0)
        scores = jnp.einsum('bhtd,bhsd,bhtsd->bhts', q_, k_, decay)
        intra = jnp.einsum('bhts,bhse->bhte', scores, v_)
        new_state = (jnp.exp(b_end[:, :, 0, :])[..., None] * state
                     + jnp.einsum('bhsd,bhse->bhde', k_ * jnp.exp(b_end - b_), v_))
        return new_state, inter + intra

    state0 = jnp.zeros((B, H, DK, DV), jnp.float32)
    _, o = lax.scan(step, state0, (qc, kc, vc, bc))
    return o.transpose(1, 0, 3, 2, 4).reshape(B, S, H, DV)


def stick_breaking_attention(q, k, v):
    B, S, H, d = q.shape
    scale = 1.0 / math.sqrt(d)
    qh = q.astype(jnp.float32).transpose(0, 2, 1, 3)
    kh = k.astype(jnp.float32).transpose(0, 2, 1, 3)
    vh = v.astype(jnp.float32).transpose(0, 2, 1, 3)
    outs = []
    for blk in range(S // SB_BLOCK):
        t0 = blk * SB_BLOCK
        t1 = t0 + SB_BLOCK
        z = jnp.einsum('bhtd,bhsd->bhts', qh[:, :, t0:t1], kh[:, :, :t1]) * scale
        tpos = t0 + jnp.arange(SB_BLOCK)[:, None]
        spos = jnp.arange(t1)[None, :]
        causal = spos < tpos
        log_1mb = jnp.where(causal, jax.nn.log_sigmoid(-z), 0.0)
        after = lax.cumsum(log_1mb, axis=3, reverse=True) - log_1mb
        w = jnp.where(causal, jnp.exp(jax.nn.log_sigmoid(z) + after), 0.0)
        outs.append(jnp.einsum('bhts,bhsd->bhtd', w, vh[:, :, :t1]))
    o = jnp.concatenate(outs, axis=2)
    return o.transpose(0, 2, 1, 3)


def peer_ffn(h, w_pq, sub_keys, peer_u, peer_v):
    B, S, D = h.shape
    half = PEER_DKEY // 2
    q = (h @ w_pq).reshape(B, S, PEER_HEADS, 2, half).astype(jnp.float32)
    s1 = jnp.einsum('bshd,hnd->bshn', q[..., 0, :], sub_keys[0].astype(jnp.float32))
    s2 = jnp.einsum('bshd,hnd->bshn', q[..., 1, :], sub_keys[1].astype(jnp.float32))
    v1, i1 = lax.top_k(s1, PEER_TOPK)
    v2, i2 = lax.top_k(s2, PEER_TOPK)
    cand = (v1[..., :, None] + v2[..., None, :]).reshape(B, S, PEER_HEADS, PEER_TOPK * PEER_TOPK)
    cand_idx = (i1[..., :, None] * PEER_NKEYS + i2[..., None, :]).reshape(B, S, PEER_HEADS, PEER_TOPK * PEER_TOPK)
    top, pos = lax.top_k(cand, PEER_TOPK)
    idx = jnp.take_along_axis(cand_idx, pos, axis=-1)
    gates = jax.nn.softmax(top, axis=-1)

    T = PEER_TOK_BLOCK
    nb = S // T

    def blockify(a):
        return a.reshape((B, nb, T) + a.shape[2:]).swapaxes(0, 1)

    def expert_block(args):
        hb, ib, gb = args
        u = peer_u[ib]
        act = jax.nn.gelu(jnp.einsum('btd,bthkd->bthk', hb, u), approximate=False)
        return jnp.einsum('bthk,bthkd->btd', gb * act, peer_v[ib])

    out = lax.map(expert_block, (blockify(h), blockify(idx), blockify(gates)))
    return out.swapaxes(0, 1).reshape(B, S, D)


def setup_inputs(seed: int = 0) -> dict:
    key = jax.random.key(seed)
    ks = jax.random.split(key, 16)
    nrm = jax.random.normal
    f32 = jnp.float32
    D = D_MODEL
    return {
        "x": nrm(ks[0], (BATCH, SEQ, D), f32),
        "c": nrm(ks[1], (BATCH, D), f32),
        "w_ada": nrm(ks[2], (DEPTH, D, 6 * D), f32) * (0.5 * D ** -0.5),
        "b_ada": nrm(ks[3], (DEPTH, 6 * D), f32) * 0.01,
        "w_in": nrm(ks[4], (DEPTH, D, IN_WIDTH), f32) * D ** -0.5,
        "lb_logits": nrm(ks[5], (DEPTH, HG_F), f32) * 0.1,
        "hg_norm_g": 1.0 + 0.02 * nrm(ks[6], (DEPTH, HG_V), f32),
        "w_up_a": nrm(ks[7], (DEPTH, HG_V, D), f32) * HG_V ** -0.5,
        "w_up_b": nrm(ks[8], (DEPTH, SB_W, D), f32) * SB_W ** -0.5,
        "w_o": nrm(ks[9], (DEPTH, D, D), f32) * (DN_BETA * D ** -0.5),
        "w_pq": nrm(ks[10], (DEPTH, D, PEER_HEADS * PEER_DKEY), f32) * D ** -0.5,
        "sub_keys": nrm(ks[11], (DEPTH, 2, PEER_HEADS, PEER_NKEYS, PEER_DKEY // 2), f32) * (PEER_DKEY // 2) ** -0.5,
        "peer_u": nrm(ks[12], (DEPTH, PEER_N, D), f32) * D ** -0.5,
        "peer_v": nrm(ks[13], (DEPTH, PEER_N, D), f32) * DN_BETA,
        "ln_g": 1.0 + 0.02 * nrm(ks[14], (DEPTH, 2, D), f32),
        "ln_b": 0.02 * nrm(ks[15], (DEPTH, 2, D), f32),
    }


def reference(x, c, w_ada, b_ada, w_in, lb_logits, hg_norm_g, w_up_a, w_up_b, w_o,
              w_pq, sub_keys, peer_u, peer_v, ln_g, ln_b):
    B, S, _ = x.shape
    p = jax.nn.softmax(lb_logits.astype(jnp.float32), axis=0)
    lower_bounds = jnp.cumsum(p, axis=0) - p[0:1]
    cond = jax.nn.silu(c)
    for l in range(DEPTH):
        mod = cond @ w_ada[l] + b_ada[l]
        sh1, sc1, gt1, sh2, sc2, gt2 = jnp.split(mod, 6, axis=-1)

        hm = x * (1.0 + sc1[:, None]) + sh1[:, None]
        proj = hm @ w_in[l]
        qa, fa, ia, ga, qb, kb, vb, gate_a, gate_b = jnp.split(proj, IN_SPLITS, axis=-1)
        oa = hgrn2_chunkwise(qa.reshape(B, S, HG_HEADS, HG_DK),
                             fa.reshape(B, S, HG_HEADS, HG_DK),
                             ia.reshape(B, S, HG_HEADS, HG_DV),
                             lower_bounds[l])
        oa = head_rms_norm(oa, hg_norm_g[l].reshape(HG_HEADS, HG_DV)).reshape(B, S, HG_V) * jax.nn.silu(ga)
        ob = stick_breaking_attention(qb.reshape(B, S, SB_HEADS, SB_DH),
                                      kb.reshape(B, S, SB_HEADS, SB_DH),
                                      vb.reshape(B, S, SB_HEADS, SB_DH)).reshape(B, S, SB_W)
        merged = jax.nn.sigmoid(gate_a) * (oa @ w_up_a[l]) + jax.nn.sigmoid(gate_b) * (ob @ w_up_b[l])
        y = (merged @ w_o[l]) * gt1[:, None]
        x = layer_norm(DN_ALPHA * x + y, ln_g[l, 0], ln_b[l, 0])

        hf = x * (1.0 + sc2[:, None]) + sh2[:, None]
        y = peer_ffn(hf, w_pq[l], sub_keys[l], peer_u[l], peer_v[l]) * gt2[:, None]
        x = layer_norm(DN_ALPHA * x + y, ln_g[l, 1], ln_b[l, 1])
    return x
```

```cpp
#include <hip/hip_runtime.h>
#include <cstdio>
#include <cstdint>

#ifndef MK_PER_PHASE
#define MK_PER_PHASE 0
#endif

#ifndef PROBE_MASK
#define PROBE_MASK 0
#endif

#ifndef FAST_ATTN
#define FAST_ATTN 1
#endif
#ifndef FAST_TOPK
#define FAST_TOPK 1
#endif
#ifndef FAST_HGRN
#define FAST_HGRN 1
#endif

#ifndef PEER_FP8
#define PEER_FP8 1
#endif

#ifndef PEER_KSLICE
#define PEER_KSLICE 1
#endif

namespace pg8 {
#define PG8_LAS __attribute__((address_space(3)))
typedef unsigned short bf16_t;
typedef short bf16x8 __attribute__((ext_vector_type(8)));
typedef float f32x4 __attribute__((ext_vector_type(4)));
typedef unsigned u32x4 __attribute__((ext_vector_type(4)));
constexpr int BM = 256, BK = 64, HALF = 128, HTB = HALF * BK * 2  , STAGE_BYTES = 8 * HTB, NXCD = 8, WGM = 8;

__host__ __device__ __forceinline__ int lds_byte(int r, int c) { const int st = (r >> 4) * 2 + (c >> 5), rr = r & 15, cc = c & 31, ob = rr * 64 + cc * 2; return st * 1024 + (ob ^ (((ob >> 9) & 1) << 5)); }
__host__ __device__ __forceinline__ void stage_rc(int b, int& R, int& C) { const int st = b / 1024, sb = b % 1024, swz = sb ^ (((sb >> 9) & 1) << 5); R = (st >> 1) * 16 + swz / 64; C = (st & 1) * 32 + (swz % 64) / 2; }
__host__ __device__ __forceinline__ int perm32(int rho) { const int n = rho >> 4, i = rho & 15; return 8 * (i >> 2) + 4 * n + (i & 3); }

struct Unit { int pm, pn; };
struct Gemm { const bf16_t* A; const bf16_t* Bt; int M, N, K; };

struct StaticOrder {
    int nM, nN, nwg, G, c;
    __host__ __device__ void init(int M, int N, int G_, int c_) { nM = M / BM; nN = N / BM; nwg = nM * nN; G = G_; c = c_; }
    __host__ __device__ bool next(int i, Unit& u) const {
        const long L = (long)i * G + c; if (L >= nwg) return false;
        int wgid = (int)L; { const int q = nwg / NXCD, r = nwg % NXCD, xcd = wgid % NXCD, off = wgid / NXCD; wgid = (xcd < r ? xcd * (q + 1) : r * (q + 1) + (xcd - r) * q) + off; }
        const int nig = WGM * nN, gid = wgid / nig, fm = gid * WGM, gsz = (nM - fm) < WGM ? (nM - fm) : WGM;
        u.pm = fm + ((wgid % nig) % gsz); u.pn = (wgid % nig) / gsz; return true;
    }
    __device__ __forceinline__ void a_ready(const Unit&) const {}
    __device__ __forceinline__ void done(const Unit&) const {}
};

__device__ __forceinline__ unsigned cvt_pk_bf16(float lo, float hi) { unsigned r; asm volatile("v_cvt_pk_bf16_f32 %0, %1, %2" : "=v"(r) : "v"(lo), "v"(hi)); return r; }
__device__ __forceinline__ u32x4 pack8(f32x4 v0, f32x4 v1) { u32x4 w; w.x = cvt_pk_bf16(v0[0], v0[1]); w.y = cvt_pk_bf16(v0[2], v0[3]); w.z = cvt_pk_bf16(v1[0], v1[1]); w.w = cvt_pk_bf16(v1[2], v1[3]); return w; }
__device__ __forceinline__ float bf_lo(unsigned w) { return __uint_as_float(w << 16); }
__device__ __forceinline__ float bf_hi(unsigned w) { return __uint_as_float(w & 0xffff0000u); }
__device__ __forceinline__ void unpack8(u32x4 w, f32x4& a, f32x4& b) { a = (f32x4){bf_lo(w.x), bf_hi(w.x), bf_lo(w.y), bf_hi(w.y)}; b = (f32x4){bf_lo(w.z), bf_hi(w.z), bf_lo(w.w), bf_hi(w.w)}; }
__device__ __forceinline__ float sigm(float z) { return 1.0f / (1.0f + __expf(-z)); }

struct EpiInProj {
    static constexpr bool PERM = true, AFTER_DRAIN = false;
    unsigned char* ws; const float* lb;
    static constexpr size_t M_ = 1u << 20, oQA = 202 * M_, oGLOG = 266 * M_, oKK = 330 * M_, oIA = 394 * M_, oGA = 458 * M_, oQB = 522 * M_, oKB = 586 * M_, oVT = 650 * M_, oGTA = 714 * M_, oGTB = 842 * M_;
    __device__ __forceinline__ void operator()(const f32x4 (&acc)[2][2][4][2], const Unit& u, int wr, int wc, int fr, int fq) const {
        const int pn = u.pn, row0 = u.pm * BM + wr * 64 + fr, cl0 = wc * 32 + 8 * fq;
        if (pn < 2 || (pn >= 4 && pn < 8)) {
            bf16_t* base = (bf16_t*)(ws + (pn < 2 ? oQA : (pn < 6 ? oIA : oGA))); const int cb = (pn & 1) * 256 + cl0; const bool act = pn >= 6;
#pragma unroll
            for (int ai = 0; ai < 2; ++ai)
#pragma unroll
                for (int m = 0; m < 4; ++m) { bf16_t* rowp = base + (size_t)(row0 + ai * HALF + m * 16) * 512 + cb;
#pragma unroll
                    for (int bj = 0; bj < 2; ++bj) { f32x4 v0 = acc[ai][bj][m][0], v1 = acc[ai][bj][m][1];
                        if (act) {
#pragma unroll
                            for (int j = 0; j < 4; ++j) { v0[j] = v0[j] * sigm(v0[j]); v1[j] = v1[j] * sigm(v1[j]); } }
                        *(u32x4*)(rowp + bj * HALF) = pack8(v0, v1); } }
        } else if (pn < 4) {
            const int cb = (pn - 2) * 256 + cl0; f32x4 l0[2], l1[2];
#pragma unroll
            for (int bj = 0; bj < 2; ++bj) { l0[bj] = *(const f32x4*)(lb + cb + bj * HALF); l1[bj] = *(const f32x4*)(lb + cb + bj * HALF + 4); }
#pragma unroll
            for (int ai = 0; ai < 2; ++ai)
#pragma unroll
                for (int m = 0; m < 4; ++m) { const size_t ro = (size_t)(row0 + ai * HALF + m * 16) * 512 + cb;
#pragma unroll
                    for (int bj = 0; bj < 2; ++bj) { f32x4 z0 = acc[ai][bj][m][0], z1 = acc[ai][bj][m][1], g0, g1, k0, k1;
#pragma unroll
                        for (int j = 0; j < 4; ++j) {
                            { const float z = fminf(fmaxf(z0[j], -30.f), 30.f), lbv = l0[bj][j], e = __expf(-z), s = 1.0f / (1.0f + e), omlb = 1.0f - lbv; g0[j] = __logf(lbv + omlb * s); k0[j] = omlb * e * s; }
                            { const float z = fminf(fmaxf(z1[j], -30.f), 30.f), lbv = l1[bj][j], e = __expf(-z), s = 1.0f / (1.0f + e), omlb = 1.0f - lbv; g1[j] = __logf(lbv + omlb * s); k1[j] = omlb * e * s; } }
                        *(u32x4*)((bf16_t*)(ws + oGLOG) + ro + bj * HALF) = pack8(g0, g1); *(u32x4*)((bf16_t*)(ws + oKK) + ro + bj * HALF) = pack8(k0, k1); } }
        } else if (pn < 12) {
            bf16_t* base = (bf16_t*)(ws + (pn < 10 ? oQB : oKB)); const float sc = pn < 10 ? 0.125f : 1.0f;
#pragma unroll
            for (int ai = 0; ai < 2; ++ai)
#pragma unroll
                for (int m = 0; m < 4; ++m) { const int row = row0 + ai * HALF + m * 16, b = row >> 11, t = row & 2047;
#pragma unroll
                    for (int bj = 0; bj < 2; ++bj) { const int c = (pn & 1) * 256 + bj * HALF + cl0, h = c >> 6, d = c & 63;
                        *(u32x4*)(base + ((size_t)(b * 8 + h) * 2048 + t) * 64 + d) = pack8(acc[ai][bj][m][0] * sc, acc[ai][bj][m][1] * sc); } }
        } else if (pn < 14) {
#pragma unroll
            for (int ai = 0; ai < 2; ++ai)
#pragma unroll
                for (int m = 0; m < 4; ++m) { const int row = row0 + ai * HALF + m * 16, b = row >> 11, t = row & 2047;
#pragma unroll
                    for (int bj = 0; bj < 2; ++bj) { const int c = (pn & 1) * 256 + bj * HALF + cl0, h = c >> 6, d = c & 63; const u32x4 w = pack8(acc[ai][bj][m][0], acc[ai][bj][m][1]);
                        bf16_t* p = (bf16_t*)(ws + oVT) + ((size_t)(b * 8 + h) * 64 + d) * 2048 + t;
                        p[0] = (bf16_t)(w.x & 0xffffu); p[2048] = (bf16_t)(w.x >> 16); p[2 * 2048] = (bf16_t)(w.y & 0xffffu); p[3 * 2048] = (bf16_t)(w.y >> 16);
                        p[4 * 2048] = (bf16_t)(w.z & 0xffffu); p[5 * 2048] = (bf16_t)(w.z >> 16); p[6 * 2048] = (bf16_t)(w.w & 0xffffu); p[7 * 2048] = (bf16_t)(w.w >> 16); } }
        } else {
            bf16_t* base = (bf16_t*)(ws + (pn < 18 ? oGTA : oGTB)); const int cb = ((pn - 14) & 3) * 256 + cl0;
#pragma unroll
            for (int ai = 0; ai < 2; ++ai)
#pragma unroll
                for (int m = 0; m < 4; ++m) { bf16_t* rowp = base + (size_t)(row0 + ai * HALF + m * 16) * 1024 + cb;
#pragma unroll
                    for (int bj = 0; bj < 2; ++bj) { f32x4 v0 = acc[ai][bj][m][0], v1 = acc[ai][bj][m][1];
#pragma unroll
                        for (int j = 0; j < 4; ++j) { v0[j] = sigm(v0[j]); v1[j] = sigm(v1[j]); }
                        *(u32x4*)(rowp + bj * HALF) = pack8(v0, v1); } }
        }
    }
};
template <int MODE> struct EpiGate {
    static constexpr bool PERM = true, AFTER_DRAIN = false;
    bf16_t* O; const bf16_t* G;
    __device__ __forceinline__ void operator()(const f32x4 (&acc)[2][2][4][2], const Unit& u, int wr, int wc, int fr, int fq) const {
        const int row0 = u.pm * BM + wr * 64 + fr, col0 = u.pn * BM + wc * 32 + 8 * fq;
#pragma unroll
        for (int ai = 0; ai < 2; ++ai)
#pragma unroll
            for (int m = 0; m < 4; ++m) { const size_t ro = (size_t)(row0 + ai * HALF + m * 16) * 1024 + col0;
#pragma unroll
                for (int bj = 0; bj < 2; ++bj) { f32x4 v0 = acc[ai][bj][m][0], v1 = acc[ai][bj][m][1];
                    if (MODE != 2) { f32x4 g0, g1; unpack8(*(const u32x4*)(G + ro + bj * HALF), g0, g1); v0 = v0 * g0; v1 = v1 * g1; }
                    if (MODE == 1) { f32x4 o0, o1; unpack8(*(const u32x4*)(O + ro + bj * HALF), o0, o1); v0 = v0 + o0; v1 = v1 + o1; }
                    *(u32x4*)(O + ro + bj * HALF) = pack8(v0, v1); } }
    }
};
struct EpiWo {
    static constexpr bool PERM = false, AFTER_DRAIN = false;
    const float* RES; float* X; const float* gt;
    float alpha;
    __device__ __forceinline__ void operator()(const f32x4 (&acc)[2][2][4][2], const Unit& u, int wr, int wc, int fr, int fq) const {
        const int row0 = u.pm * BM + wr * 64 + fr, col0 = u.pn * BM + wc * 32 + 4 * fq;
        const int b = (u.pm * BM) >> 11;
        f32x4 gv[2][2];
#pragma unroll
        for (int bj = 0; bj < 2; ++bj)
#pragma unroll
            for (int n = 0; n < 2; ++n) gv[bj][n] = *(const f32x4*)(gt + (size_t)b * 6144 + col0 + bj * HALF + n * 16);
#pragma unroll
        for (int ai = 0; ai < 2; ++ai)
#pragma unroll
            for (int m = 0; m < 4; ++m) { const size_t ro = (size_t)(row0 + ai * HALF + m * 16) * 1024 + col0;
#pragma unroll
                for (int bj = 0; bj < 2; ++bj)
#pragma unroll
                    for (int n = 0; n < 2; ++n) { const f32x4 r = *(const f32x4*)(RES + ro + bj * HALF + n * 16);
                        *(f32x4*)(X + ro + bj * HALF + n * 16) = r * alpha + acc[ai][bj][m][n] * gv[bj][n]; } }
    }
};

template <class Epi, class Sched, bool ALIGN_EPI = false, bool SP2 = false>
__device__ __forceinline__ void gemm_phase(PG8_LAS unsigned char* lds, const Gemm g, const Sched& S, const Epi& E) {
    int tid_ = threadIdx.x; asm volatile("" : "+v"(tid_)); const int tid = tid_, wid = __builtin_amdgcn_readfirstlane(tid >> 6), lane = tid & 63, wr = wid >> 2, wc = wid & 3, fr = lane & 15, fq = lane >> 4;
    const int K = g.K, nt = K / BK;
    unsigned voffA[2], voffB[2];
#pragma unroll
    for (int i = 0; i < 2; ++i) { int R, C; stage_rc(tid * 16 + i * 8192, R, C); const int Rb = Epi::PERM ? ((R & ~31) + perm32(R & 31)) : R;
        voffA[i] = (unsigned)(R * K + C) * 2u; voffB[i] = (unsigned)(Rb * K + C) * 2u; }
    const size_t kstep = (size_t)(BK * 2);
    const size_t hstep = (size_t)HALF * K * 2;
    const size_t tstep = 2 * hstep;
    const unsigned ldsw = (unsigned)wid * 1024u;
    const int aoff = lds_byte(wr * 64 + fr, fq * 8), boff = lds_byte(wc * 32 + fr, fq * 8);
#define PG8_SA(b, h) (((b) * 2 + (h)) * HTB)
#define PG8_SB(b, h) ((4 + (b) * 2 + (h)) * HTB)
#define PG8_STAGE(bufoff, gbase, voff) do { _Pragma("unroll") for (int _i = 0; _i < 2; ++_i) \
        __builtin_amdgcn_global_load_lds((const unsigned*)((const char*)(gbase) + (voff)[_i]), (PG8_LAS unsigned*)(lds + (bufoff) + ldsw + _i * 8192), 16, 0, 0); } while (0)
#define PG8_LDA(dst, b, h) do { _Pragma("unroll") for (int m = 0; m < 4; ++m) _Pragma("unroll") for (int k = 0; k < 2; ++k) dst[m][k] = *(const PG8_LAS bf16x8*)(lds + PG8_SA(b, h) + aoff + m * 2048 + k * 1024); } while (0)
#define PG8_LDB(dst, b, h) do { _Pragma("unroll") for (int n = 0; n < 2; ++n) _Pragma("unroll") for (int k = 0; k < 2; ++k) dst[n][k] = *(const PG8_LAS bf16x8*)(lds + PG8_SB(b, h) + boff + n * 2048 + k * 1024); } while (0)
#define PG8_MMA(ai, bj, At, Bt) do { __builtin_amdgcn_s_setprio(1); _Pragma("unroll") for (int m = 0; m < 4; ++m) _Pragma("unroll") for (int n = 0; n < 2; ++n) _Pragma("unroll") for (int k = 0; k < 2; ++k) \
        acc[ai][bj][m][n] = __builtin_amdgcn_mfma_f32_16x16x32_bf16(Bt[n][k], At[m][k], acc[ai][bj][m][n], 0, 0, 0); __builtin_amdgcn_s_setprio(0); } while (0)
#define PG8_WAIT_V(n) asm volatile("s_waitcnt vmcnt(" #n ")" ::: "memory")
#define PG8_WAIT_L(n) asm volatile("s_waitcnt lgkmcnt(" #n ")" ::: "memory")
#define PG8_BAR __builtin_amdgcn_s_barrier()
#define PG8_SCHED __builtin_amdgcn_sched_barrier(0)
    Unit cur, nxt; int ui = 0;
    if (!S.next(0, cur)) return;
    f32x4 acc[2][2][4][2];
#pragma unroll
    for (int a = 0; a < 2; ++a)
#pragma unroll
        for (int b = 0; b < 2; ++b)
#pragma unroll
            for (int m = 0; m < 4; ++m)
#pragma unroll
                for (int n = 0; n < 2; ++n) acc[a][b][m][n] = (f32x4){0.f, 0.f, 0.f, 0.f};
    bf16x8 At[4][2], B0[2][2], B1[2][2];
    const char* cA = (const char*)g.A + (size_t)cur.pm * tstep; const char* cB = (const char*)g.Bt + (size_t)cur.pn * tstep;
    S.a_ready(cur);
    if constexpr (SP2) {
        PG8_STAGE(PG8_SB(0, 0), cB, voffB); PG8_STAGE(PG8_SB(0, 1), cB + hstep, voffB); PG8_STAGE(PG8_SA(0, 0), cA, voffA); PG8_STAGE(PG8_SA(0, 1), cA + hstep, voffA);
        if (wr == 1) PG8_BAR;
        PG8_WAIT_V(2); PG8_BAR;
        PG8_STAGE(PG8_SB(1, 0), cB + kstep, voffB); PG8_STAGE(PG8_SA(1, 0), cA + kstep, voffA); PG8_STAGE(PG8_SB(1, 1), cB + hstep + kstep, voffB);
        PG8_WAIT_V(6); PG8_BAR;
    } else {
        PG8_STAGE(PG8_SB(0, 0), cB, voffB); PG8_STAGE(PG8_SA(0, 0), cA, voffA); PG8_STAGE(PG8_SB(0, 1), cB + hstep, voffB); PG8_STAGE(PG8_SA(0, 1), cA + hstep, voffA);
        if (wr == 1) PG8_BAR;
        PG8_WAIT_V(4); PG8_BAR;
        PG8_STAGE(PG8_SB(1, 0), cB + kstep, voffB); PG8_STAGE(PG8_SA(1, 0), cA + kstep, voffA); PG8_STAGE(PG8_SB(1, 1), cB + hstep + kstep, voffB);
        PG8_WAIT_V(6); PG8_BAR;
    }
    for (;;) {
        const bool has_next = S.next(ui + 1, nxt);
        const char* nA = has_next ? (const char*)g.A + (size_t)nxt.pm * tstep : cA; const char* nB = has_next ? (const char*)g.Bt + (size_t)nxt.pn * tstep : cB;
        for (int t = 0; t < nt; t += 2) {
            const bool last = (t == nt - 2);
            const char* a1 = cA + (size_t)(t + 1) * kstep;
            const char* a2 = last ? nA : cA + (size_t)(t + 2) * kstep; const char* b2 = last ? nB : cB + (size_t)(t + 2) * kstep;
            const char* a3 = a2 + kstep; const char* b3 = b2 + kstep;
            if (last && has_next) S.a_ready(nxt);
            if constexpr (SP2) {
            PG8_LDB(B0, 0, 0); PG8_LDB(B1, 0, 1); PG8_SCHED; PG8_LDA(At, 0, 0); PG8_STAGE(PG8_SA(1, 1), a1 + hstep, voffA);
            PG8_WAIT_V(8); PG8_WAIT_L(0); PG8_BAR; PG8_MMA(0, 0, At, B0); PG8_MMA(0, 1, At, B1); PG8_BAR; PG8_SCHED;
            PG8_LDA(At, 0, 1); PG8_STAGE(PG8_SB(0, 0), b2, voffB); PG8_STAGE(PG8_SB(0, 1), b2 + hstep, voffB); PG8_STAGE(PG8_SA(0, 0), a2, voffA);
            PG8_WAIT_V(8); PG8_WAIT_L(0); PG8_BAR; PG8_MMA(1, 0, At, B0); PG8_MMA(1, 1, At, B1); PG8_BAR; PG8_SCHED;
            PG8_LDB(B0, 1, 0); PG8_LDB(B1, 1, 1); PG8_SCHED; PG8_LDA(At, 1, 0); PG8_STAGE(PG8_SA(0, 1), a2 + hstep, voffA);
            PG8_WAIT_V(8); PG8_WAIT_L(0); PG8_BAR; PG8_MMA(0, 0, At, B0); PG8_MMA(0, 1, At, B1); PG8_BAR; PG8_SCHED;
            PG8_LDA(At, 1, 1); PG8_STAGE(PG8_SB(1, 0), b3, voffB); PG8_STAGE(PG8_SB(1, 1), b3 + hstep, voffB); PG8_STAGE(PG8_SA(1, 0), a3, voffA);
            PG8_WAIT_V(8); PG8_WAIT_L(0); PG8_BAR; PG8_MMA(1, 0, At, B0); PG8_MMA(1, 1, At, B1); PG8_BAR; PG8_SCHED;
            } else {
            PG8_LDB(B0, 0, 0); PG8_SCHED; PG8_LDA(At, 0, 0); PG8_STAGE(PG8_SA(1, 1), a1 + hstep, voffA);
            PG8_WAIT_L(8); PG8_BAR; PG8_WAIT_L(0); PG8_MMA(0, 0, At, B0); PG8_BAR; PG8_SCHED;
            PG8_LDB(B1, 0, 1); PG8_STAGE(PG8_SB(0, 0), b2, voffB);
            PG8_BAR; PG8_WAIT_L(0); PG8_MMA(0, 1, At, B1); PG8_BAR;
            PG8_LDA(At, 0, 1); PG8_STAGE(PG8_SA(0, 0), a2, voffA);
            PG8_BAR; PG8_WAIT_L(0); PG8_MMA(1, 0, At, B0); PG8_BAR; PG8_SCHED;
            PG8_STAGE(PG8_SB(0, 1), b2 + hstep, voffB);
            PG8_WAIT_V(6); PG8_BAR; PG8_MMA(1, 1, At, B1); PG8_BAR;
            PG8_LDB(B0, 1, 0); PG8_SCHED; PG8_LDA(At, 1, 0); PG8_STAGE(PG8_SA(0, 1), a2 + hstep, voffA);
            PG8_WAIT_L(8); PG8_BAR; PG8_WAIT_L(0); PG8_MMA(0, 0, At, B0); PG8_BAR; PG8_SCHED;
            PG8_LDB(B1, 1, 1); PG8_STAGE(PG8_SB(1, 0), b3, voffB);
            PG8_BAR; PG8_WAIT_L(0); PG8_MMA(0, 1, At, B1); PG8_BAR;
            PG8_LDA(At, 1, 1); PG8_STAGE(PG8_SA(1, 0), a3, voffA);
            PG8_BAR; PG8_WAIT_L(0); PG8_MMA(1, 0, At, B0); PG8_BAR; PG8_SCHED;
            PG8_STAGE(PG8_SB(1, 1), b3 + hstep, voffB);
            PG8_WAIT_V(6); PG8_BAR; PG8_MMA(1, 1, At, B1); PG8_BAR;
            }
        }
        if constexpr (ALIGN_EPI) { if (wr == 0) PG8_BAR; }
        if constexpr (!Epi::AFTER_DRAIN) { E(acc, cur, wr, wc, fr, fq); S.done(cur); }
        if (!has_next) break;
#pragma unroll
        for (int a = 0; a < 2; ++a)
#pragma unroll
            for (int b = 0; b < 2; ++b)
#pragma unroll
                for (int m = 0; m < 4; ++m)
#pragma unroll
                    for (int n = 0; n < 2; ++n) acc[a][b][m][n] = (f32x4){0.f, 0.f, 0.f, 0.f};
        cur = nxt; cA = nA; cB = nB; ++ui;
        if constexpr (ALIGN_EPI) { if (wr == 1) PG8_BAR; }
    }
    PG8_WAIT_V(0);
    if constexpr (!ALIGN_EPI) { if (wr == 0) PG8_BAR; }
    PG8_BAR;
    if constexpr (Epi::AFTER_DRAIN) { E.fused(acc, cur, wr, wc, fr, fq, lds, wid, lane); S.done(cur); }
#undef PG8_SA
#undef PG8_SB
#undef PG8_STAGE
#undef PG8_LDA
#undef PG8_LDB
#undef PG8_MMA
#undef PG8_WAIT_V
#undef PG8_WAIT_L
#undef PG8_BAR
#undef PG8_SCHED
}
}

constexpr int DM = 1024, NBATCH = 32, SEQ = 2048, NTOK = NBATCH * SEQ, DEPTH = 4, INW = 5632, MODW = 6144;
constexpr float DN_ALPHA = 1.681792830507429f;
constexpr float LN_EPS = 1e-5f, RMS_EPS = 1e-6f;
constexpr int NWAVES = 8, NTHREADS = 512;

constexpr size_t MiB = 1u << 20;
constexpr size_t WS_CTL = 0, CTL_ZERO_BYTES = 1 * MiB;
constexpr size_t WS_MOD = 1 * MiB;
constexpr size_t WS_LB = 4 * MiB;
constexpr size_t WS_WIN = 5 * MiB;
constexpr size_t WS_WUA = 49 * MiB, WS_WUB = 53 * MiB;
constexpr size_t WS_WO = 57 * MiB, WS_WPQ = 65 * MiB;
constexpr size_t WS_SK = 73 * MiB;
constexpr size_t WS_HB = 74 * MiB;
constexpr size_t WS_OA = 74 * MiB, WS_OB = 138 * MiB;
constexpr size_t WS_QA = 202 * MiB, WS_GLOG = 266 * MiB;
constexpr size_t WS_MERGED = 202 * MiB;
constexpr size_t WS_KK = 330 * MiB, WS_IA = 394 * MiB;
constexpr size_t WS_PQ = 330 * MiB;
constexpr size_t WS_GA = 458 * MiB;
constexpr size_t WS_IDX = 458 * MiB, WS_GATE = 474 * MiB;
constexpr size_t WS_QB = 522 * MiB, WS_KB = 586 * MiB, WS_VT = 650 * MiB;
constexpr size_t WS_PU = 522 * MiB, WS_PV = 586 * MiB;
constexpr size_t WS_GTA = 714 * MiB, WS_GTB = 842 * MiB;
constexpr size_t WS_MODP = 714 * MiB;
constexpr size_t WS_PART = 650 * MiB;
constexpr size_t WS_Y = 202 * MiB;
constexpr size_t WS_END = 970 * MiB;

constexpr int CW_BAR = 4096;
constexpr int CW_QUEUE = 16384;

constexpr int RING_BYTES = 131072;
constexpr int LDSCTL_OFF = RING_BYTES, MISC_OFF = LDSCTL_OFF + 320;
constexpr int LDS_BYTES = 147456;

#define GAS __attribute__((address_space(1)))
#define LAS __attribute__((address_space(3)))
typedef unsigned short bf16;
typedef unsigned v4u __attribute__((ext_vector_type(4)));
typedef unsigned v2u __attribute__((ext_vector_type(2)));
typedef float f32x4 __attribute__((ext_vector_type(4)));
typedef float f32x2 __attribute__((ext_vector_type(2)));
typedef GAS unsigned gu32;
#define RLX_AGENT __ATOMIC_RELAXED, __HIP_MEMORY_SCOPE_AGENT
#define LDS_WAIT() asm volatile("s_waitcnt lgkmcnt(0)" ::: "memory")
#define VM_WAIT() asm volatile("s_waitcnt vmcnt(0)" ::: "memory")

__device__ __forceinline__ float bf2f(unsigned h) { return __uint_as_float(h << 16); }
__device__ __forceinline__ float bflo(unsigned w) { return __uint_as_float(w << 16); }
__device__ __forceinline__ float bfhi(unsigned w) { return __uint_as_float(w & 0xffff0000u); }
__device__ __forceinline__ unsigned pk2(float lo, float hi) { return pg8::cvt_pk_bf16(lo, hi); }
__device__ __forceinline__ v4u pk8(f32x4 a, f32x4 b) { v4u w; w.x = pk2(a[0], a[1]); w.y = pk2(a[2], a[3]); w.z = pk2(b[0], b[1]); w.w = pk2(b[2], b[3]); return w; }
__device__ __forceinline__ float fsigmoid(float z) { return 1.0f / (1.0f + __expf(-z)); }
__device__ __forceinline__ float wave_sum(float v) {
#pragma unroll
    for (int o = 1; o < 64; o <<= 1) v += __shfl_xor(v, o);
    return v;
}

template <class T> __device__ __forceinline__ T* opq(T* p) { long z = 0; asm volatile("" : "+s"(z)); return p + z; }
__device__ __forceinline__ int opqv(int v) { asm volatile("" : "+v"(v)); return v; }
__device__ __forceinline__ int opqs(int v) { asm volatile("" : "+s"(v)); return v; }
static_assert(WS_QA == pg8::EpiInProj::oQA && WS_GLOG == pg8::EpiInProj::oGLOG && WS_KK == pg8::EpiInProj::oKK && WS_IA == pg8::EpiInProj::oIA && WS_GA == pg8::EpiInProj::oGA && WS_QB == pg8::EpiInProj::oQB
              && WS_KB == pg8::EpiInProj::oKB && WS_VT == pg8::EpiInProj::oVT && WS_GTA == pg8::EpiInProj::oGTA && WS_GTB == pg8::EpiInProj::oGTB, "EpiInProj offsets vs workspace map");
#define XB_TMO      128
#define XB_XCNT(j)  (256  + 64 * (j))
#define XB_XSUB(j)  (1280 + 64 * (j))
#define XB_XGEN(j)  (2304 + 64 * (j))
#define XB_TOP      3328
#define XB_TOPGEN   3392
#define XCD_BAR_WORDS 3456
#define XB_SPIN_CAP (1u << 22)

__device__ __forceinline__ unsigned xb_ld(unsigned* p)              { return __hip_atomic_load(p, __ATOMIC_RELAXED, __HIP_MEMORY_SCOPE_AGENT); }
__device__ __forceinline__ unsigned xb_add(unsigned* p, unsigned v) { return __hip_atomic_fetch_add(p, v, __ATOMIC_RELAXED, __HIP_MEMORY_SCOPE_AGENT); }
__device__ __forceinline__ unsigned xb_xcc_id() { return (unsigned)__builtin_amdgcn_s_getreg((3 << 11) | 20) & 0xFu; }
#define XB_SPIN(cond, bar) do { unsigned _sp = 0; while (cond) { __builtin_amdgcn_s_sleep(1); \
    if ((++_sp & 255u) == 0u) { if (xb_ld(&(bar)[XB_TMO])) break; if (_sp > XB_SPIN_CAP) { atomicAdd(&(bar)[XB_TMO], 1u); break; } } } } while (0)

struct XcdBarrier {
    unsigned* bar; unsigned x;
    volatile LAS unsigned* st;
};

__device__ __forceinline__ XcdBarrier xcd_barrier_post(unsigned* bar, volatile LAS unsigned* st) {
    XcdBarrier b; b.bar = bar; b.x = xb_xcc_id(); b.st = st;
    if (threadIdx.x == 0) (void)xb_add(&bar[XB_XCNT(b.x)], 1u);
    return b;
}
__device__ __forceinline__ void xcd_barrier_complete(unsigned* bar, unsigned x, unsigned& nloc, unsigned& nx) {
    const unsigned G = gridDim.x * gridDim.y * gridDim.z;
    unsigned sum, cnt, mine, sp = 0u;
    for (;;) {
        sum = 0u; cnt = 0u; mine = 0u;
#pragma unroll
        for (unsigned j = 0; j < 16; ++j) { const unsigned c = xb_ld(&bar[XB_XCNT(j)]); sum += c; cnt += (c > 0u) ? 1u : 0u; mine = (j == x) ? c : mine; }
        if (sum == G) break;
        __builtin_amdgcn_s_sleep(1);
        if ((++sp & 255u) == 0u) { if (xb_ld(&bar[XB_TMO])) break; if (sp > XB_SPIN_CAP) { atomicAdd(&bar[XB_TMO], 1u); break; } }
    }
    nloc = mine > 0u ? mine : 1u; nx = cnt > 0u ? cnt : 1u;
}

__device__ __forceinline__ void xcd_barrier(const XcdBarrier& b) {
    asm volatile("s_waitcnt vmcnt(0)" ::: "memory");
    __syncthreads();
    if (threadIdx.x == 0) {
        unsigned* bar = b.bar;
        __builtin_amdgcn_s_waitcnt(0);
        unsigned nloc = b.st[0], nx = b.st[1];
        if (nloc == 0u) { xcd_barrier_complete(bar, b.x, nloc, nx); b.st[0] = nloc; b.st[1] = nx; }
        const unsigned old = xb_add(&bar[XB_XSUB(b.x)], 1u);
        const unsigned gen = old / nloc;
        if (old + 1u == (gen + 1u) * nloc) {
            __builtin_amdgcn_fence(__ATOMIC_RELEASE, "agent");
            asm volatile("s_waitcnt vmcnt(0)" ::: "memory");
            const unsigned og = xb_add(&bar[XB_TOP], 1u);
            const unsigned tg = og / nx;
            if (og + 1u == (tg + 1u) * nx) xb_add(&bar[XB_TOPGEN], 1u);
            else XB_SPIN(xb_ld(&bar[XB_TOPGEN]) == tg, bar);
            __builtin_amdgcn_fence(__ATOMIC_ACQUIRE, "agent");
            xb_add(&bar[XB_XGEN(b.x)], 1u);
            asm volatile("s_waitcnt vmcnt(0)" ::: "memory");
        } else {
            XB_SPIN(xb_ld(&bar[XB_XGEN(b.x)]) == gen, bar);
            __builtin_amdgcn_fence(__ATOMIC_ACQUIRE, "agent");
            asm volatile("s_waitcnt vmcnt(0)" ::: "memory");
        }
    }
    __syncthreads();
}

struct Args { const float* in[16]; float* out; unsigned char* ws; int ph_lo, ph_hi; };
struct Frame {
    LAS unsigned char* lds;
    int tid, lane, wave, vcu, G, gw, NGW;
};
#define IN_x         (A.in[0])
#define IN_c         (A.in[1])
#define IN_w_ada     (A.in[2])
#define IN_b_ada     (A.in[3])
#define IN_w_in      (A.in[4])
#define IN_lb_logits (A.in[5])
#define IN_hg_norm_g (A.in[6])
#define IN_w_up_a    (A.in[7])
#define IN_w_up_b    (A.in[8])
#define IN_w_o       (A.in[9])
#define IN_w_pq      (A.in[10])
#define IN_sub_keys  (A.in[11])
#define IN_peer_u    (A.in[12])
#define IN_peer_v    (A.in[13])
#define IN_ln_g      (A.in[14])
#define IN_ln_b      (A.in[15])
#define P_X      (xout)
#define WSF(off) ((float*)(ws + (off)))
#define WSB(off) ((bf16*)(ws + (off)))
#define P_MOD    WSF(WS_MOD)
#define P_LB     WSF(WS_LB)
#define P_MODP   WSF(WS_MODP)
#define P_GATE   WSF(WS_GATE)
#define P_WIN    WSB(WS_WIN)
#define P_WUA    WSB(WS_WUA)
#define P_WUB    WSB(WS_WUB)
#define P_WO     WSB(WS_WO)
#define P_WPQ    WSB(WS_WPQ)
#define P_SK     WSB(WS_SK)
#define P_HB     WSB(WS_HB)
#define P_OA     WSB(WS_OA)
#define P_OB     WSB(WS_OB)
#define P_QA     WSB(WS_QA)
#define P_GLOG   WSB(WS_GLOG)
#define P_MERGED WSB(WS_MERGED)
#define P_KK     WSB(WS_KK)
#define P_IA     WSB(WS_IA)
#define P_PQ     WSB(WS_PQ)
#define P_GA     WSB(WS_GA)
#define P_IDX    WSB(WS_IDX)
#define P_QB     WSB(WS_QB)
#define P_KB     WSB(WS_KB)
#define P_VT     WSB(WS_VT)
#define P_PU     WSB(WS_PU)
#define P_PV     WSB(WS_PV)
#define P_GTA    WSB(WS_GTA)
#define P_GTB    WSB(WS_GTB)
#define P_PART   WSF(WS_PART)
#define P_Y      WSB(WS_Y)
#define LAUNDER() Args A; { long z_ = 0; asm volatile("" : "+s"(z_)); _Pragma("unroll") for (int i_ = 0; i_ < 16; ++i_) A.in[i_] = A0.in[i_] + z_; A.out = A0.out + z_; A.ws = A0.ws + z_; A.ph_lo = A0.ph_lo; A.ph_hi = A0.ph_hi; } \
    Frame F = F0; F.tid = opqv(F0.tid); F.lane = F.tid & 63; unsigned char* const ws = A.ws; float* const xout = A.out; (void)ws; (void)xout;

__device__ __forceinline__ void transpose_item(const float* W, int K, int N, bf16* WT, LAS float* scr, int item, int lane) {
    const int nblk = N / 32, kb = item / nblk, nb = item % nblk, k0 = 64 * kb, n0 = 32 * nb;
#pragma unroll 8
    for (int i = 0; i < 32; ++i) { const int kk = 2 * i + (lane >> 5); scr[kk * 33 + (lane & 31)] = W[(size_t)(k0 + kk) * N + n0 + (lane & 31)]; }
    LDS_WAIT(); asm volatile("" ::: "memory");
    const int c = lane & 7;
#pragma unroll
    for (int j = 0; j < 4; ++j) { const int n = (lane >> 3) + 8 * j; const LAS float* s = scr + (8 * c) * 33 + n;
        v4u o; o.x = pk2(s[0 * 33], s[1 * 33]); o.y = pk2(s[2 * 33], s[3 * 33]); o.z = pk2(s[4 * 33], s[5 * 33]); o.w = pk2(s[6 * 33], s[7 * 33]);
        *(v4u*)(WT + (size_t)(n0 + n) * K + k0 + 8 * c) = o; }
    LDS_WAIT(); asm volatile("" ::: "memory");
}

__device__ __forceinline__ void phase_proA(const Args& A0, Frame& F0) {
    LAUNDER();
    LAS float* scr = (LAS float*)(F.lds + F.wave * 16384);
    constexpr int I_IN = (DM / 64) * (INW / 32), I_UP = (512 / 64) * (DM / 32), I_SQ = (DM / 64) * (DM / 32), I_L = I_IN + 2 * I_UP + 2 * I_SQ;
    for (int it = F.gw; it < DEPTH * I_L; it += F.NGW) {
        const int l = it / I_L; int r = it % I_L;
        if (r < I_IN) { transpose_item(IN_w_in + (size_t)l * DM * INW, DM, INW, P_WIN + (size_t)l * INW * DM, scr, r, F.lane); continue; } r -= I_IN;
        if (r < I_UP) { transpose_item(IN_w_up_a + (size_t)l * 512 * DM, 512, DM, P_WUA + (size_t)l * DM * 512, scr, r, F.lane); continue; } r -= I_UP;
        if (r < I_UP) { transpose_item(IN_w_up_b + (size_t)l * 512 * DM, 512, DM, P_WUB + (size_t)l * DM * 512, scr, r, F.lane); continue; } r -= I_UP;
        if (r < I_SQ) { transpose_item(IN_w_o + (size_t)l * DM * DM, DM, DM, P_WO + (size_t)l * DM * DM, scr, r, F.lane); continue; } r -= I_SQ;
        transpose_item(IN_w_pq + (size_t)l * DM * DM, DM, DM, P_WPQ + (size_t)l * DM * DM, scr, r, F.lane);
    }
    { const int gt = F.vcu * NTHREADS + F.tid, NGT = F.G * NTHREADS;
      for (int i = gt; i < DEPTH * 2 * 8 * 128 * 64 / 8; i += NGT) { const f32x4 a = *(const f32x4*)(IN_sub_keys + (size_t)i * 8), b = *(const f32x4*)(IN_sub_keys + (size_t)i * 8 + 4); *(v4u*)(P_SK + (size_t)i * 8) = pk8(a, b); } }
    if (blockIdx.x == 0) { const int j = F.tid; float z[4], m = -1e30f, s = 0.f;
#pragma unroll
        for (int l = 0; l < 4; ++l) { z[l] = IN_lb_logits[l * 512 + j]; m = fmaxf(m, z[l]); }
#pragma unroll
        for (int l = 0; l < 4; ++l) { z[l] = __expf(z[l] - m); s += z[l]; }
        const float inv = 1.0f / s; float cum = 0.f; P_LB[j] = 0.f;
#pragma unroll
        for (int l = 1; l < 4; ++l) { cum += z[l] * inv; P_LB[l * 512 + j] = cum; } }
    for (int it = F.gw; it < DEPTH * 96 * 8; it += F.NGW) {
        const int l = it / 768, r = it % 768, nblk = r >> 3, ks = r & 7, n = nblk * 64 + F.lane, k0 = ks * 128;
#pragma unroll 8
        for (int i = 0; i < 64; ++i) { const int idx = F.lane + 64 * i, b = idx >> 7, kk = idx & 127; const float cv = IN_c[b * DM + k0 + kk]; scr[idx] = cv / (1.0f + __expf(-cv)); }
        LDS_WAIT(); asm volatile("" ::: "memory");
        float acc[32];
#pragma unroll
        for (int b = 0; b < 32; ++b) acc[b] = 0.f;
        const float* wp = IN_w_ada + ((size_t)l * DM + k0) * MODW + n;
        for (int kk = 0; kk < 128; kk += 4) {
            const float w0 = wp[(size_t)(kk + 0) * MODW], w1 = wp[(size_t)(kk + 1) * MODW], w2 = wp[(size_t)(kk + 2) * MODW], w3 = wp[(size_t)(kk + 3) * MODW];
#pragma unroll
            for (int b = 0; b < 32; ++b) { const f32x4 s = *(const LAS f32x4*)(scr + b * 128 + kk); acc[b] += s[0] * w0 + s[1] * w1 + s[2] * w2 + s[3] * w3; }
        }
#pragma unroll
        for (int b = 0; b < 32; ++b) P_MODP[(((size_t)ks * DEPTH + l) * 32 + b) * MODW + n] = acc[b];
        LDS_WAIT(); asm volatile("" ::: "memory");
    }
}
__device__ __forceinline__ void phase_proA2(const Args& A0, Frame& F0) {
    LAUNDER();
    const int gt = F.vcu * NTHREADS + F.tid, NGT = F.G * NTHREADS;
    for (int i = gt; i < DEPTH * 32 * MODW; i += NGT) { const int l = i / (32 * MODW), n = i % MODW; float s = IN_b_ada[l * MODW + n];
#pragma unroll
        for (int ks = 0; ks < 8; ++ks) s += P_MODP[(size_t)ks * DEPTH * 32 * MODW + i];
        P_MOD[i] = s; }
}
struct Row16 { f32x4 a0, a1, b0, b1; };
__device__ __forceinline__ Row16 ld_row(const float* p, int lane) { Row16 r; const f32x4* q = (const f32x4*)(p + 8 * lane); r.a0 = q[0]; r.a1 = q[1]; q = (const f32x4*)(p + 512 + 8 * lane); r.b0 = q[0]; r.b1 = q[1]; return r; }
__device__ __forceinline__ void st_row(float* p, int lane, const Row16& r) { f32x4* q = (f32x4*)(p + 8 * lane); q[0] = r.a0; q[1] = r.a1; q = (f32x4*)(p + 512 + 8 * lane); q[0] = r.b0; q[1] = r.b1; }
__device__ __forceinline__ void st_row_bf16(bf16* p, int lane, const Row16& r) { *(v4u*)(p + 8 * lane) = pk8(r.a0, r.a1); *(v4u*)(p + 512 + 8 * lane) = pk8(r.b0, r.b1); }
__device__ __forceinline__ unsigned pk4_fp8(f32x4 a) { int p = 0; p = __builtin_amdgcn_cvt_pk_fp8_f32(a[0], a[1], p, false); p = __builtin_amdgcn_cvt_pk_fp8_f32(a[2], a[3], p, true); return (unsigned)p; }
__device__ __forceinline__ v4u pk16_fp8(f32x4 a, f32x4 b, f32x4 c, f32x4 d) { v4u w; w.x = pk4_fp8(a); w.y = pk4_fp8(b); w.z = pk4_fp8(c); w.w = pk4_fp8(d); return w; }
__device__ __forceinline__ Row16 modulate(const Row16& x, const Row16& sc, const Row16& sh) { Row16 r; r.a0 = x.a0 * (sc.a0 + 1.0f) + sh.a0; r.a1 = x.a1 * (sc.a1 + 1.0f) + sh.a1; r.b0 = x.b0 * (sc.b0 + 1.0f) + sh.b0; r.b1 = x.b1 * (sc.b1 + 1.0f) + sh.b1; return r; }
__device__ __forceinline__ float row_sum(const Row16& r) { const f32x4 s = (r.a0 + r.a1) + (r.b0 + r.b1); return (s[0] + s[1]) + (s[2] + s[3]); }
__device__ __forceinline__ Row16 layer_norm_row(const Row16& v, const float* g, const float* bta, int lane) {
    const float mean = wave_sum(row_sum(v)) * (1.0f / DM);
    Row16 d; d.a0 = v.a0 - mean; d.a1 = v.a1 - mean; d.b0 = v.b0 - mean; d.b1 = v.b1 - mean;
    Row16 q; q.a0 = d.a0 * d.a0; q.a1 = d.a1 * d.a1; q.b0 = d.b0 * d.b0; q.b1 = d.b1 * d.b1;
    const float rstd = 1.0f / sqrtf(wave_sum(row_sum(q)) * (1.0f / DM) + LN_EPS);
    const Row16 gg = ld_row(g, lane), bb = ld_row(bta, lane);
    Row16 o; o.a0 = d.a0 * rstd * gg.a0 + bb.a0; o.a1 = d.a1 * rstd * gg.a1 + bb.a1; o.b0 = d.b0 * rstd * gg.b0 + bb.b0; o.b1 = d.b1 * rstd * gg.b1 + bb.b1; return o;
}
__device__ __forceinline__ void phase_proB(const Args& A0, Frame& F0) {
    LAUNDER();
    for (int tok = F.gw; tok < NTOK; tok += F.NGW) { const int b = tok >> 11; const float* mod = P_MOD + (size_t)b * MODW;
        const Row16 x = ld_row(IN_x + (size_t)tok * DM, F.lane), sh = ld_row(mod, F.lane), sc = ld_row(mod + 1024, F.lane);
        st_row_bf16(P_HB + (size_t)tok * DM, F.lane, modulate(x, sc, sh)); }
}
__device__ __forceinline__ void phase_ln1(const Args& A0, Frame& F0, int l) {
    LAUNDER();
    for (int tok = F.gw; tok < NTOK; tok += F.NGW) { const int b = tok >> 11; const float* mod = P_MOD + ((size_t)l * 32 + b) * MODW;
        const Row16 v = ld_row(P_X + (size_t)tok * DM, F.lane);
        const Row16 xn = layer_norm_row(v, IN_ln_g + (size_t)(l * 2 + 0) * DM, IN_ln_b + (size_t)(l * 2 + 0) * DM, F.lane);
        st_row(P_X + (size_t)tok * DM, F.lane, xn);
        const Row16 sh = ld_row(mod + 3072, F.lane), sc = ld_row(mod + 4096, F.lane);
        st_row_bf16(P_HB + (size_t)tok * DM, F.lane, modulate(xn, sc, sh)); }
    const int gt = F.vcu * NTHREADS + F.tid, NGT = F.G * NTHREADS;
    const float* pu = IN_peer_u + (size_t)l * 16384 * DM; const float* pv = IN_peer_v + (size_t)l * 16384 * DM;
#if PEER_FP8
#if PEER_KSLICE
    for (int i = gt; i < 16384 * 64; i += NGT) { const int row = i >> 6, ln = i & 63; const size_t so = (size_t)row * DM + 16 * ln, dofs = (size_t)(ln >> 3) * 16384 * 128 + (size_t)row * 128 + (ln & 7) * 16;
        { const f32x4 a = *(const f32x4*)(pu + so) * 2048.0f, b = *(const f32x4*)(pu + so + 4) * 2048.0f, c = *(const f32x4*)(pu + so + 8) * 2048.0f, d = *(const f32x4*)(pu + so + 12) * 2048.0f;
          *(v4u*)((unsigned char*)P_PU + dofs) = pk16_fp8(a, b, c, d); }
        { const f32x4 a = *(const f32x4*)(pv + so) * 128.0f, b = *(const f32x4*)(pv + so + 4) * 128.0f, c = *(const f32x4*)(pv + so + 8) * 128.0f, d = *(const f32x4*)(pv + so + 12) * 128.0f;
          *(v4u*)((unsigned char*)P_PV + dofs) = pk16_fp8(a, b, c, d); } }
#else
    for (int i = gt; i < 16384 * 64; i += NGT) { const int row = i >> 6, ln = i & 63; const size_t so = (size_t)row * DM + 8 * ln;
        { const f32x4 a = *(const f32x4*)(pu + so) * 2048.0f, b = *(const f32x4*)(pu + so + 4) * 2048.0f, c = *(const f32x4*)(pu + so + 512) * 2048.0f, d = *(const f32x4*)(pu + so + 516) * 2048.0f;
          *(v4u*)((unsigned char*)P_PU + (size_t)row * 1024 + 16 * ln) = pk16_fp8(a, b, c, d); }
        { const f32x4 a = *(const f32x4*)(pv + so) * 128.0f, b = *(const f32x4*)(pv + so + 4) * 128.0f, c = *(const f32x4*)(pv + so + 512) * 128.0f, d = *(const f32x4*)(pv + so + 516) * 128.0f;
          *(v4u*)((unsigned char*)P_PV + (size_t)row * 1024 + 16 * ln) = pk16_fp8(a, b, c, d); } }
#endif
#else
    for (int i = gt; i < 16384 * DM / 8; i += NGT) {
        const f32x4 a = *(const f32x4*)(pu + (size_t)i * 8), b = *(const f32x4*)(pu + (size_t)i * 8 + 4); *(v4u*)(P_PU + (size_t)i * 8) = pk8(a, b);
        const f32x4 c = *(const f32x4*)(pv + (size_t)i * 8), d = *(const f32x4*)(pv + (size_t)i * 8 + 4); *(v4u*)(P_PV + (size_t)i * 8) = pk8(c, d); }
#endif
}

__device__ __forceinline__ void hgrn_simple(const Args& A0, Frame& F0, int l) {
    LAUNDER();
    LAS float* fL = (LAS float*)F.lds;
    LAS float* kL = fL + 2048, *qL = kL + 2048, *vL = qL + 2048;
    LAS float* part = vL + 2048;
    const int tid = F.tid, e = tid & 127, dq = tid >> 7;
    for (int unit = blockIdx.x; unit < 128; unit += F.G) {
        const int b = unit >> 2, h = unit & 3;
        float S[32];
#pragma unroll
        for (int i = 0; i < 32; ++i) S[i] = 0.f;
        for (int t0 = 0; t0 < SEQ; t0 += 16) {
#pragma unroll
            for (int i = 0; i < 4; ++i) { const int idx = tid + 512 * i, tt = idx >> 7, d = idx & 127; const size_t off = ((size_t)(b * SEQ + t0 + tt)) * 512 + h * 128 + d;
                fL[idx] = __expf(bf2f(P_GLOG[off])); kL[idx] = bf2f(P_KK[off]); qL[idx] = bf2f(P_QA[off]); vL[idx] = bf2f(P_IA[off]); }
            __syncthreads();
            for (int tt = 0; tt < 16; ++tt) {
                const float ve = vL[tt * 128 + e]; float o = 0.f;
#pragma unroll
                for (int i4 = 0; i4 < 8; ++i4) {
                    const f32x4 f4 = *(const LAS f32x4*)(fL + tt * 128 + 32 * dq + 4 * i4), k4 = *(const LAS f32x4*)(kL + tt * 128 + 32 * dq + 4 * i4), q4 = *(const LAS f32x4*)(qL + tt * 128 + 32 * dq + 4 * i4);
#pragma unroll
                    for (int j = 0; j < 4; ++j) { S[4 * i4 + j] = f4[j] * S[4 * i4 + j] + k4[j] * ve; o += S[4 * i4 + j] * q4[j]; }
                }
                part[(tt * 4 + dq) * 128 + e] = o;
            }
            __syncthreads();
            { const int tt = tid >> 5, eg = (tid & 31) * 4; f32x4 o4 = (f32x4){0.f, 0.f, 0.f, 0.f};
#pragma unroll
              for (int q = 0; q < 4; ++q) o4 = o4 + *(const LAS f32x4*)(part + (tt * 4 + q) * 128 + eg);
              float ss = (o4[0] * o4[0] + o4[1] * o4[1]) + (o4[2] * o4[2] + o4[3] * o4[3]);
#pragma unroll
              for (int m = 1; m < 32; m <<= 1) ss += __shfl_xor(ss, m);
              const float rstd = 1.0f / sqrtf(ss * (1.0f / 128.0f) + RMS_EPS);
              const size_t ro = ((size_t)(b * SEQ + t0 + tt)) * 512 + h * 128 + eg;
              const f32x4 gn = *(const f32x4*)(IN_hg_norm_g + l * 512 + h * 128 + eg); const v2u gw2 = *(const v2u*)(P_GA + ro);
              const float r0 = o4[0] * rstd * gn[0] * bflo(gw2.x), r1 = o4[1] * rstd * gn[1] * bfhi(gw2.x), r2 = o4[2] * rstd * gn[2] * bflo(gw2.y), r3 = o4[3] * rstd * gn[3] * bfhi(gw2.y);
              v2u w; w.x = pk2(r0, r1); w.y = pk2(r2, r3); *(v2u*)(P_OA + ro) = w; }
            __syncthreads();
        }
    }
}
__device__ __forceinline__ void attn_simple(const Args& A0, Frame& F0) {
    LAUNDER();
    for (int item = blockIdx.x; item < 1024; item += F.G) {
        const int bh = item >> 2, t = (item & 3) * 512 + F.tid, b = bh >> 3, h = bh & 7;
        float q[64], o[64];
        { const v4u* qp = (const v4u*)(P_QB + ((size_t)bh * SEQ + t) * 64);
#pragma unroll
          for (int i = 0; i < 8; ++i) { const v4u w = qp[i]; q[8 * i] = bflo(w.x); q[8 * i + 1] = bfhi(w.x); q[8 * i + 2] = bflo(w.y); q[8 * i + 3] = bfhi(w.y); q[8 * i + 4] = bflo(w.z); q[8 * i + 5] = bfhi(w.z); q[8 * i + 6] = bflo(w.w); q[8 * i + 7] = bfhi(w.w); } }
#pragma unroll
        for (int d = 0; d < 64; ++d) o[d] = 0.f;
        float R = 0.f;
        for (int s = t - 1; s >= 0; --s) {
            if (R < -104.0f) break;
            const v4u* kp = (const v4u*)(P_KB + ((size_t)bh * SEQ + s) * 64); float z = 0.f;
#pragma unroll
            for (int i = 0; i < 8; ++i) { const v4u w = kp[i]; z += q[8 * i] * bflo(w.x) + q[8 * i + 1] * bfhi(w.x) + q[8 * i + 2] * bflo(w.y) + q[8 * i + 3] * bfhi(w.y) + q[8 * i + 4] * bflo(w.z) + q[8 * i + 5] * bfhi(w.z) + q[8 * i + 6] * bflo(w.w) + q[8 * i + 7] * bfhi(w.w); }
            const float sp = fmaxf(z, 0.f) + __logf(1.0f + __expf(-fabsf(z)));
            const float w = __expf(z - sp + R); R -= sp;
            const bf16* vp = P_VT + (size_t)bh * 64 * SEQ + s;
#pragma unroll
            for (int d = 0; d < 64; ++d) o[d] += w * bf2f(vp[(size_t)d * SEQ]);
        }
        bf16* op = P_OB + ((size_t)(b * SEQ + t)) * 512 + h * 64;
#pragma unroll
        for (int i = 0; i < 8; ++i) { v4u w; w.x = pk2(o[8 * i], o[8 * i + 1]); w.y = pk2(o[8 * i + 2], o[8 * i + 3]); w.z = pk2(o[8 * i + 4], o[8 * i + 5]); w.w = pk2(o[8 * i + 6], o[8 * i + 7]); *(v4u*)(op + 8 * i) = w; }
    }
}

__device__ __forceinline__ unsigned f2sort(float f) { const unsigned u = __float_as_uint(f); return u ^ ((unsigned)((int)u >> 31) | 0x80000000u); }
__device__ __forceinline__ float sort2f(unsigned k) { return __uint_as_float((k & 0x80000000u) ? (k ^ 0x80000000u) : ~k); }
__device__ __forceinline__ void ins16(unsigned (&top)[16], unsigned x) {
#pragma unroll
    for (int i = 0; i < 16; ++i) { const unsigned hi = top[i] > x ? top[i] : x; x = top[i] > x ? x : top[i]; top[i] = hi; }
}
__device__ __forceinline__ void peer_topk_simple(const Args& A0, Frame& F0, int l) {
    LAUNDER();
    LAS unsigned char* nscr = (LAS unsigned char*)F.lds + (F.wave * 64 + F.lane) * 32;
    for (int item = blockIdx.x; item < NTOK / 64; item += F.G) {
        const int tok = item * 64 + F.lane, h = F.wave;
        unsigned top[2][16];
#pragma unroll
        for (int p = 0; p < 2; ++p) {
            float q[64];
            { const v4u* qp = (const v4u*)(P_PQ + (size_t)tok * DM + h * 128 + p * 64);
#pragma unroll
              for (int i = 0; i < 8; ++i) { const v4u w = qp[i]; q[8 * i] = bflo(w.x); q[8 * i + 1] = bfhi(w.x); q[8 * i + 2] = bflo(w.y); q[8 * i + 3] = bfhi(w.y); q[8 * i + 4] = bflo(w.z); q[8 * i + 5] = bfhi(w.z); q[8 * i + 6] = bflo(w.w); q[8 * i + 7] = bfhi(w.w); } }
#pragma unroll
            for (int i = 0; i < 16; ++i) top[p][i] = 0u;
            const bf16* key = P_SK + ((size_t)((l * 2 + p) * 8 + h)) * 128 * 64;
            for (int n = 0; n < 128; ++n) {
                const v4u* kp = (const v4u*)(key + n * 64); float s = 0.f;
#pragma unroll
                for (int i = 0; i < 8; ++i) { const v4u w = kp[i]; s += q[8 * i] * bflo(w.x) + q[8 * i + 1] * bfhi(w.x) + q[8 * i + 2] * bflo(w.y) + q[8 * i + 3] * bfhi(w.y) + q[8 * i + 4] * bflo(w.z) + q[8 * i + 5] * bfhi(w.z) + q[8 * i + 6] * bflo(w.w) + q[8 * i + 7] * bfhi(w.w); }
                ins16(top[p], (f2sort(s) & ~127u) | (unsigned)(127 - n));
            }
        }
        float v1[16], v2[16];
#pragma unroll
        for (int i = 0; i < 16; ++i) { v1[i] = sort2f(top[0][i] & ~127u); v2[i] = sort2f(top[1][i] & ~127u); nscr[i] = (unsigned char)(127u - (top[0][i] & 127u)); nscr[16 + i] = (unsigned char)(127u - (top[1][i] & 127u)); }
        unsigned ct[16];
#pragma unroll
        for (int i = 0; i < 16; ++i) ct[i] = 0u;
#pragma unroll
        for (int i = 0; i < 16; ++i)
#pragma unroll
            for (int j = 0; j < 16; ++j) if ((i + 1) * (j + 1) <= 16) ins16(ct, (f2sort(v1[i] + v2[j]) & ~255u) | (unsigned)(255 - (i * 16 + j)));
        LDS_WAIT(); asm volatile("" ::: "memory");
        float ev[16], es = 0.f; const float vmax = sort2f(ct[0] & ~255u);
#pragma unroll
        for (int k = 0; k < 16; ++k) { ev[k] = __expf(sort2f(ct[k] & ~255u) - vmax); es += ev[k]; }
        const float inv = 1.0f / es;
        bf16* ip = P_IDX + (size_t)tok * 128 + h * 16; float* gp = P_GATE + (size_t)tok * 128 + h * 16;
#pragma unroll
        for (int k = 0; k < 16; ++k) { const unsigned code = 255u - (ct[k] & 255u); const unsigned n1 = nscr[code >> 4], n2 = nscr[16 + (code & 15u)];
            ip[k] = (bf16)(n1 * 128u + n2); gp[k] = ev[k] * inv; }
        LDS_WAIT(); asm volatile("" ::: "memory");
    }
}

typedef __bf16 bf16x2_t __attribute__((ext_vector_type(2)));
__device__ __forceinline__ float dot2(unsigned a, unsigned b, float c) { return __builtin_amdgcn_fdot2_f32_bf16(__builtin_bit_cast(bf16x2_t, a), __builtin_bit_cast(bf16x2_t, b), c, false); }
__device__ __forceinline__ float dot8(v4u a, v4u b, float c) { c = dot2(a.x, b.x, c); c = dot2(a.y, b.y, c); c = dot2(a.z, b.z, c); return dot2(a.w, b.w, c); }
__device__ __forceinline__ void axpy8(float (&y)[16], int o, float w, v4u v) {
    y[o + 0] += w * bflo(v.x); y[o + 1] += w * bfhi(v.x); y[o + 2] += w * bflo(v.y); y[o + 3] += w * bfhi(v.y);
    y[o + 4] += w * bflo(v.z); y[o + 5] += w * bfhi(v.z); y[o + 6] += w * bflo(v.w); y[o + 7] += w * bfhi(v.w);
}
#if PEER_FP8
__device__ __forceinline__ void peer_group8(const bf16* PUp, const bf16* PVp, Frame& F, const float (&hf)[16], unsigned idxv, float gatev, int e0, float (&y)[16]) {
    const int lane = F.lane;
    v4u uq[8], vq[8];
#pragma unroll
    for (int j = 0; j < 8; ++j) { const unsigned e = (unsigned)__builtin_amdgcn_readlane((int)idxv, e0 + j);
        uq[j] = *(const v4u*)((const unsigned char*)PUp + (size_t)e * 1024 + 16 * lane); vq[j] = *(const v4u*)((const unsigned char*)PVp + (size_t)e * 1024 + 16 * lane); }
    float p[8];
#pragma unroll
    for (int j = 0; j < 8; ++j) { float s = 0.f; const unsigned uw[4] = {uq[j].x, uq[j].y, uq[j].z, uq[j].w};
#pragma unroll
        for (int w = 0; w < 4; ++w) { const f32x2 lo = __builtin_amdgcn_cvt_pk_f32_fp8((int)uw[w], false), hi = __builtin_amdgcn_cvt_pk_f32_fp8((int)uw[w], true);
            s += hf[4 * w] * lo[0]; s += hf[4 * w + 1] * lo[1]; s += hf[4 * w + 2] * hi[0]; s += hf[4 * w + 3] * hi[1]; }
        p[j] = s; }
    const bool b5 = lane & 32, b4 = lane & 16, b3 = lane & 8;
    float r[4];
#pragma unroll
    for (int i = 0; i < 4; ++i) { const float snd = b5 ? p[i] : p[i + 4], kp = b5 ? p[i + 4] : p[i]; r[i] = kp + __shfl_xor(snd, 32); }
    float r2[2];
#pragma unroll
    for (int i = 0; i < 2; ++i) { const float snd = b4 ? r[i] : r[i + 2], kp = b4 ? r[i + 2] : r[i]; r2[i] = kp + __shfl_xor(snd, 16); }
    float r3; { const float snd = b3 ? r2[0] : r2[1], kp = b3 ? r2[1] : r2[0]; r3 = kp + __shfl_xor(snd, 8); }
    r3 += __shfl_xor(r3, 4); r3 += __shfl_xor(r3, 2); r3 += __shfl_xor(r3, 1);
    r3 *= (1.0f / 2048.0f);
    const float g = __shfl(gatev, e0 + (lane >> 3));
    const float wv = g * (0.5f / 128.0f) * r3 * (1.0f + erff(r3 * 0.70710678118654752f));
#pragma unroll
    for (int j = 0; j < 8; ++j) { const float w = __int_as_float(__builtin_amdgcn_readlane(__float_as_int(wv), 8 * j)); const unsigned vw[4] = {vq[j].x, vq[j].y, vq[j].z, vq[j].w};
#pragma unroll
        for (int q = 0; q < 4; ++q) { const f32x2 lo = __builtin_amdgcn_cvt_pk_f32_fp8((int)vw[q], false), hi = __builtin_amdgcn_cvt_pk_f32_fp8((int)vw[q], true);
            y[4 * q] += w * lo[0]; y[4 * q + 1] += w * lo[1]; y[4 * q + 2] += w * hi[0]; y[4 * q + 3] += w * hi[1]; } }
}
#else
__device__ __forceinline__ void peer_group8(const bf16* PUp, const bf16* PVp, Frame& F, const v4u hA, const v4u hB, unsigned idxv, float gatev, int e0, float (&y)[16]) {
    const int lane = F.lane;
    v4u uA[8], uB[8], vA[8], vB[8];
#pragma unroll
    for (int j = 0; j < 8; ++j) { const unsigned e = (unsigned)__builtin_amdgcn_readlane((int)idxv, e0 + j);
        const bf16* up = PUp + (size_t)e * DM + 8 * lane; const bf16* vp = PVp + (size_t)e * DM + 8 * lane;
        uA[j] = *(const v4u*)up; uB[j] = *(const v4u*)(up + 512); vA[j] = *(const v4u*)vp; vB[j] = *(const v4u*)(vp + 512); }
    float p[8];
#pragma unroll
    for (int j = 0; j < 8; ++j) p[j] = dot8(hB, uB[j], dot8(hA, uA[j], 0.f));
    const bool b5 = lane & 32, b4 = lane & 16, b3 = lane & 8;
    float r[4];
#pragma unroll
    for (int i = 0; i < 4; ++i) { const float snd = b5 ? p[i] : p[i + 4], kp = b5 ? p[i + 4] : p[i]; r[i] = kp + __shfl_xor(snd, 32); }
    float r2[2];
#pragma unroll
    for (int i = 0; i < 2; ++i) { const float snd = b4 ? r[i] : r[i + 2], kp = b4 ? r[i + 2] : r[i]; r2[i] = kp + __shfl_xor(snd, 16); }
    float r3; { const float snd = b3 ? r2[0] : r2[1], kp = b3 ? r2[1] : r2[0]; r3 = kp + __shfl_xor(snd, 8); }
    r3 += __shfl_xor(r3, 4); r3 += __shfl_xor(r3, 2); r3 += __shfl_xor(r3, 1);
    const float g = __shfl(gatev, e0 + (lane >> 3));
    const float wv = g * 0.5f * r3 * (1.0f + erff(r3 * 0.70710678118654752f));
#pragma unroll
    for (int j = 0; j < 8; ++j) { const float w = __int_as_float(__builtin_amdgcn_readlane(__float_as_int(wv), 8 * j)); axpy8(y, 0, w, vA[j]); axpy8(y, 8, w, vB[j]); }
}
#endif
__device__ __forceinline__ void phase_peer_expert(const Args& A0, Frame& F0, int l) {
    LAUNDER();
    const int lane = opqv(F.lane); const bf16* const PUp = P_PU; const bf16* const PVp = P_PV;
    for (int tok = F.gw; tok < NTOK; tok += F.NGW) {
        const int b = tok >> 11;
        const v4u hA = *(const v4u*)(P_HB + (size_t)tok * DM + 8 * lane), hB = *(const v4u*)(P_HB + (size_t)tok * DM + 512 + 8 * lane);
        const unsigned i0 = P_IDX[(size_t)tok * 128 + lane], i1 = P_IDX[(size_t)tok * 128 + 64 + lane];
        const float g0 = P_GATE[(size_t)tok * 128 + lane], g1 = P_GATE[(size_t)tok * 128 + 64 + lane];
        float y[16];
#pragma unroll
        for (int i = 0; i < 16; ++i) y[i] = 0.f;
        for (int rep = 0; rep < ((PROBE_MASK & 64) ? 2 : 1); ++rep) {
#if PEER_FP8
        float hf[16]; { const unsigned hw[8] = {hA.x, hA.y, hA.z, hA.w, hB.x, hB.y, hB.z, hB.w};
#pragma unroll
          for (int i = 0; i < 8; ++i) { hf[2 * i] = bflo(hw[i]); hf[2 * i + 1] = bfhi(hw[i]); } }
        for (int grp = 0; grp < 8; ++grp) peer_group8(PUp, PVp, F, hf, i0, g0, grp * 8, y);
        for (int grp = 0; grp < 8; ++grp) peer_group8(PUp, PVp, F, hf, i1, g1, grp * 8, y);
#else
        for (int grp = 0; grp < 8; ++grp) peer_group8(PUp, PVp, F, hA, hB, i0, g0, grp * 8, y);
        for (int grp = 0; grp < 8; ++grp) peer_group8(PUp, PVp, F, hA, hB, i1, g1, grp * 8, y);
#endif
        }
        if (PROBE_MASK & 64) {
#pragma unroll
            for (int i = 0; i < 16; ++i) y[i] *= 0.5f; }
        const float* mod = P_MOD + ((size_t)l * 32 + b) * MODW;
        const Row16 xr = ld_row(P_X + (size_t)tok * DM, lane), gt = ld_row(mod + 5120, lane);
        Row16 v;
        v.a0 = xr.a0 * DN_ALPHA + (f32x4){y[0], y[1], y[2], y[3]} * gt.a0; v.a1 = xr.a1 * DN_ALPHA + (f32x4){y[4], y[5], y[6], y[7]} * gt.a1;
        v.b0 = xr.b0 * DN_ALPHA + (f32x4){y[8], y[9], y[10], y[11]} * gt.b0; v.b1 = xr.b1 * DN_ALPHA + (f32x4){y[12], y[13], y[14], y[15]} * gt.b1;
        const Row16 xn = layer_norm_row(v, IN_ln_g + (size_t)(l * 2 + 1) * DM, IN_ln_b + (size_t)(l * 2 + 1) * DM, lane);
        st_row(P_X + (size_t)tok * DM, lane, xn);
        if (l + 1 < DEPTH) { const float* mod2 = P_MOD + ((size_t)(l + 1) * 32 + b) * MODW; const Row16 sh = ld_row(mod2, lane), sc = ld_row(mod2 + 1024, lane);
            st_row_bf16(P_HB + (size_t)tok * DM, lane, modulate(xn, sc, sh)); }
    }
}

typedef short bf16x8 __attribute__((ext_vector_type(8)));
typedef float f32x16 __attribute__((ext_vector_type(16)));
typedef float f32x2_t __attribute__((ext_vector_type(2)));
typedef unsigned u32x2v __attribute__((ext_vector_type(2)));
#define MFMA32(a, b, c) __builtin_amdgcn_mfma_f32_32x32x16_bf16((a), (b), (c), 0, 0, 0)
__device__ __forceinline__ unsigned cvtpk(float lo, float hi) { f32x2_t v = {lo, hi}; bf16x2_t b = __builtin_convertvector(v, bf16x2_t); return __builtin_bit_cast(unsigned, b); }
__device__ __forceinline__ bf16x8 ld_frag(const bf16* p) { return __builtin_bit_cast(bf16x8, *(const v4u*)p); }
__device__ __forceinline__ bf16x8 ld_frag2(const bf16* p0, const bf16* p1) { const v2u a = *(const v2u*)p0, b = *(const v2u*)p1; v4u w; w.x = a.x; w.y = a.y; w.z = b.x; w.w = b.y; return __builtin_bit_cast(bf16x8, w); }

template <bool MASK>
__device__ __forceinline__ void sb_tile(const bf16* Kp, const bf16* Vp, const bf16x8 (&qf)[4], const bf16x8 (&kf)[4], bf16x8 (&kn)[4], f32x16 (&oacc)[2], float& R, int s0, int s0n, int t, int r, int h) {
    bf16x8 vf[2][2];
#pragma unroll
    for (int db = 0; db < 2; ++db)
#pragma unroll
        for (int s2 = 0; s2 < 2; ++s2) { const bf16* vp = Vp + (size_t)(32 * db + r) * SEQ + s0 + 16 * s2 + 4 * h; vf[db][s2] = ld_frag2(vp, vp + 8); }
#pragma unroll
    for (int kk = 0; kk < 4; ++kk) kn[kk] = ld_frag(Kp + (size_t)(s0n + r) * 64 + 16 * kk + 8 * h);
    f32x16 z;
#pragma unroll
    for (int i = 0; i < 16; ++i) z[i] = 0.f;
#pragma unroll
    for (int kk = 0; kk < 4; ++kk) z = MFMA32(kf[kk], qf[kk], z);
    float L[16], lb[16];
#pragma unroll
    for (int i = 0; i < 16; ++i) {
        const float z2 = z[i] * 1.4426950408889634f;
        const float sp = fmaxf(z2, 0.f) + __builtin_amdgcn_logf(1.0f + __builtin_amdgcn_exp2f(-fabsf(z2)));
        const bool valid = !MASK || (s0 + (i & 3) + 8 * (i >> 2) + 4 * h < t);
        L[i] = valid ? -sp : 0.f; lb[i] = valid ? (z2 - sp) : -1.0e30f;
    }
    float a[16], G[4], P[4];
#pragma unroll
    for (int g = 0; g < 4; ++g) { a[4 * g + 3] = 0.f; a[4 * g + 2] = L[4 * g + 3]; a[4 * g + 1] = a[4 * g + 2] + L[4 * g + 2]; a[4 * g] = a[4 * g + 1] + L[4 * g + 1]; G[g] = a[4 * g] + L[4 * g]; }
    { const u32x2v a01 = __builtin_amdgcn_permlane32_swap(__float_as_uint(G[0]), __float_as_uint(G[1]), false, false), b01 = __builtin_amdgcn_permlane32_swap(__float_as_uint(G[1]), __float_as_uint(G[0]), false, false);
      const u32x2v a23 = __builtin_amdgcn_permlane32_swap(__float_as_uint(G[2]), __float_as_uint(G[3]), false, false), b23 = __builtin_amdgcn_permlane32_swap(__float_as_uint(G[3]), __float_as_uint(G[2]), false, false);
      P[0] = __uint_as_float(h ? b01[0] : a01[1]); P[1] = __uint_as_float(h ? a01[0] : b01[1]); P[2] = __uint_as_float(h ? b23[0] : a23[1]); P[3] = __uint_as_float(h ? a23[0] : b23[1]); }
    float off[4]; float run = 0.f;
#pragma unroll
    for (int g = 3; g >= 0; --g) { off[g] = run + (h == 0 ? P[g] : 0.f); run += G[g] + P[g]; }
    float w[16];
#pragma unroll
    for (int i = 0; i < 16; ++i) w[i] = __builtin_amdgcn_exp2f(lb[i] + (R + off[i >> 2] + a[i]));
    R += run;
    bf16x8 pf[2];
#pragma unroll
    for (int s2 = 0; s2 < 2; ++s2) { v4u pw; pw.x = cvtpk(w[8 * s2], w[8 * s2 + 1]); pw.y = cvtpk(w[8 * s2 + 2], w[8 * s2 + 3]); pw.z = cvtpk(w[8 * s2 + 4], w[8 * s2 + 5]); pw.w = cvtpk(w[8 * s2 + 6], w[8 * s2 + 7]); pf[s2] = __builtin_bit_cast(bf16x8, pw); }
#pragma unroll
    for (int db = 0; db < 2; ++db)
#pragma unroll
        for (int s2 = 0; s2 < 2; ++s2) oacc[db] = MFMA32(vf[db][s2], pf[s2], oacc[db]);
}
__device__ __forceinline__ void sb_block(const bf16* QBp, const bf16* KBp, const bf16* VTp, bf16* OBp, int bh, int t0, int r, int h) {
    const int t = t0 + r;
    const bf16* Kp = KBp + (size_t)bh * SEQ * 64; const bf16* Vp = VTp + (size_t)bh * 64 * SEQ;
    bf16x8 qf[4], ka[4], kb[4];
#pragma unroll
    for (int kk = 0; kk < 4; ++kk) { qf[kk] = ld_frag(QBp + ((size_t)bh * SEQ + t) * 64 + 16 * kk + 8 * h); ka[kk] = ld_frag(Kp + (size_t)t * 64 + 16 * kk + 8 * h); }
    f32x16 oacc[2];
#pragma unroll
    for (int i = 0; i < 16; ++i) { oacc[0][i] = 0.f; oacc[1][i] = 0.f; }
    float R = 0.f;
    sb_tile<true>(Kp, Vp, qf, ka, kb, oacc, R, t0, t0 >= 32 ? t0 - 32 : 0, t, r, h);
    for (int s0 = t0 - 32; s0 >= 0; s0 -= 64) {
        if (__all(R < -150.1f)) break;
        sb_tile<false>(Kp, Vp, qf, kb, ka, oacc, R, s0, s0 >= 32 ? s0 - 32 : 0, t, r, h);
        if (s0 < 32 || __all(R < -150.1f)) break;
        sb_tile<false>(Kp, Vp, qf, ka, kb, oacc, R, s0 - 32, s0 >= 64 ? s0 - 64 : 0, t, r, h);
    }
    bf16* op = OBp + ((size_t)((bh >> 3) * SEQ + t)) * 512 + (bh & 7) * 64 + 4 * h;
#pragma unroll
    for (int db = 0; db < 2; ++db)
#pragma unroll
        for (int g = 0; g < 4; ++g) { v2u o; o.x = cvtpk(oacc[db][4 * g], oacc[db][4 * g + 1]); o.y = cvtpk(oacc[db][4 * g + 2], oacc[db][4 * g + 3]); *(v2u*)(op + 32 * db + 8 * g) = o; }
}
__device__ __forceinline__ void attn_fast(const Args& A0, Frame& F0, int l, bool from_queue_only) {
    LAUNDER();
    const int lane = F.lane, r = lane & 31, h = lane >> 5;
    const bf16* QBp = P_QB; const bf16* KBp = P_KB; const bf16* VTp = P_VT; bf16* OBp = P_OB;
    unsigned* qhead = (unsigned*)(A.ws + WS_CTL) + CW_QUEUE + 64 * l;
    const int n_static = (F.G >= 256) ? 1024 : 0;
    int unit = 2048;
    if (!from_queue_only && n_static) unit = ((int)blockIdx.x - (F.G - 128)) * NWAVES + F.wave;
    else { unsigned tk = 0; if (lane == 0) tk = __hip_atomic_fetch_add(qhead, 1u, RLX_AGENT); unit = n_static + __builtin_amdgcn_readfirstlane((int)tk); }
    while (unit < 2048) {
        unsigned tk = 0; if (lane == 0) tk = __hip_atomic_fetch_add(qhead, 1u, RLX_AGENT);
        const int bh = unit >> 3, tb = (unit & 7) * 256;
        for (int sub = 7; sub >= 0; --sub) sb_block(QBp, KBp, VTp, OBp, bh, tb + 32 * sub, r, h);
        unit = n_static + __builtin_amdgcn_readfirstlane((int)tk);
    }
}

__device__ __forceinline__ void ce_desc(unsigned& x, unsigned& y) { const unsigned hi = x > y ? x : y, lo = x > y ? y : x; x = hi; y = lo; }
__device__ __forceinline__ void sort16_desc(unsigned (&a)[16]) {
#pragma unroll
    for (int k = 2; k <= 16; k <<= 1)
#pragma unroll
        for (int j = k >> 1; j > 0; j >>= 1)
#pragma unroll
            for (int i = 0; i < 16; ++i) { const int l = i ^ j; if (l > i) { if ((i & k) == 0) ce_desc(a[i], a[l]); else ce_desc(a[l], a[i]); } }
}
__device__ __forceinline__ void merge_top16(unsigned (&a)[16], const unsigned (&b)[16]) {
#pragma unroll
    for (int i = 0; i < 16; ++i) a[i] = a[i] > b[15 - i] ? a[i] : b[15 - i];
#pragma unroll
    for (int j = 8; j > 0; j >>= 1)
#pragma unroll
        for (int i = 0; i < 16; ++i) { const int l = i ^ j; if (l > i) ce_desc(a[i], a[l]); }
}
__device__ __forceinline__ void topk_scores(const bf16* keyp, const bf16* qp, int r, int hh, unsigned (&top)[16]) {
    bf16x8 qf[4];
#pragma unroll
    for (int kk = 0; kk < 4; ++kk) qf[kk] = ld_frag(qp + 16 * kk + 8 * hh);
#pragma unroll
    for (int nb = 0; nb < 4; ++nb) {
        f32x16 s;
#pragma unroll
        for (int i = 0; i < 16; ++i) s[i] = 0.f;
#pragma unroll
        for (int kk = 0; kk < 4; ++kk) s = MFMA32(ld_frag(keyp + (size_t)(32 * nb + r) * 64 + 16 * kk + 8 * hh), qf[kk], s);
        unsigned u[16];
#pragma unroll
        for (int i = 0; i < 16; ++i) u[i] = (f2sort(s[i]) & ~127u) | (unsigned)(127 - (32 * nb + (i & 3) + 8 * (i >> 2) + 4 * hh));
        sort16_desc(u);
        if (nb == 0) {
#pragma unroll
            for (int i = 0; i < 16; ++i) top[i] = u[i];
        } else merge_top16(top, u);
    }
}
__device__ __forceinline__ void peer_topk_fast(const Args& A0, Frame& F0, int l) {
    LAUNDER();
    const int lane = F.lane, r = lane & 31, hh = lane >> 5;
    LAS unsigned char* nscr = (LAS unsigned char*)F.lds + (F.wave * 64 + lane) * 32;
    for (int item = F.gw; item < NTOK / 32; item += F.NGW) {
        const int tok = item * 32 + r;
        for (int pair = 0; pair < 4; ++pair) {
            unsigned mine[2][16];
#pragma unroll
            for (int p = 0; p < 2; ++p) {
                unsigned ta[16], tb[16];
                topk_scores(P_SK + ((size_t)((l * 2 + p) * 8 + 2 * pair)) * 128 * 64, P_PQ + (size_t)tok * DM + (2 * pair) * 128 + p * 64, r, hh, ta);
                topk_scores(P_SK + ((size_t)((l * 2 + p) * 8 + 2 * pair + 1)) * 128 * 64, P_PQ + (size_t)tok * DM + (2 * pair + 1) * 128 + p * 64, r, hh, tb);
                unsigned other[16];
#pragma unroll
                for (int i = 0; i < 16; ++i) { const unsigned snd = hh ? ta[i] : tb[i]; other[i] = (unsigned)__shfl_xor((int)snd, 32); mine[p][i] = hh ? tb[i] : ta[i]; }
                merge_top16(mine[p], other);
            }
            const int head = 2 * pair + hh;
            float v1[16], v2[16];
#pragma unroll
            for (int i = 0; i < 16; ++i) { v1[i] = sort2f(mine[0][i] & ~127u); v2[i] = sort2f(mine[1][i] & ~127u); nscr[i] = (unsigned char)(127u - (mine[0][i] & 127u)); nscr[16 + i] = (unsigned char)(127u - (mine[1][i] & 127u)); }
#define CKEY(i, j) ((f2sort(v1[i] + v2[j]) & ~255u) | (unsigned)(255 - ((i) * 16 + (j))))
            unsigned ct[16], gb[16], gc[16], gd[16];
#pragma unroll
            for (int j = 0; j < 16; ++j) ct[j] = CKEY(0, j);
            { int n = 0;
#pragma unroll
              for (int i = 1; i <= 2; ++i)
#pragma unroll
                  for (int j = 0; j < 16; ++j) if ((i + 1) * (j + 1) <= 16) { gb[n] = CKEY(i, j); ++n; }
#pragma unroll
              for (int q = 13; q < 16; ++q) gb[q] = 0u; }
            { int n = 0;
#pragma unroll
              for (int i = 3; i <= 7; ++i)
#pragma unroll
                  for (int j = 0; j < 16; ++j) if ((i + 1) * (j + 1) <= 16) { gc[n] = CKEY(i, j); ++n; }
#pragma unroll
              for (int q = 13; q < 16; ++q) gc[q] = 0u; }
#pragma unroll
            for (int i = 8; i < 16; ++i) gd[i - 8] = CKEY(i, 0);
#pragma unroll
            for (int q = 8; q < 16; ++q) gd[q] = 0u;
#undef CKEY
            sort16_desc(gb); sort16_desc(gc); sort16_desc(gd);
            merge_top16(ct, gb); merge_top16(gc, gd); merge_top16(ct, gc);
            LDS_WAIT(); asm volatile("" ::: "memory");
            float ev[16], es = 0.f; const float vmax = sort2f(ct[0] & ~255u);
#pragma unroll
            for (int k = 0; k < 16; ++k) { ev[k] = __expf(sort2f(ct[k] & ~255u) - vmax); es += ev[k]; }
            const float inv = 1.0f / es;
            unsigned idx[16];
#pragma unroll
            for (int k = 0; k < 16; ++k) { const unsigned code = 255u - (ct[k] & 255u); idx[k] = (unsigned)nscr[code >> 4] * 128u + (unsigned)nscr[16 + (code & 15u)]; }
            bf16* ip = P_IDX + (size_t)tok * 128 + head * 16; float* gp = P_GATE + (size_t)tok * 128 + head * 16;
            v4u iw0, iw1; iw0.x = idx[0] | (idx[1] << 16); iw0.y = idx[2] | (idx[3] << 16); iw0.z = idx[4] | (idx[5] << 16); iw0.w = idx[6] | (idx[7] << 16);
            iw1.x = idx[8] | (idx[9] << 16); iw1.y = idx[10] | (idx[11] << 16); iw1.z = idx[12] | (idx[13] << 16); iw1.w = idx[14] | (idx[15] << 16);
            *(v4u*)ip = iw0; *(v4u*)(ip + 8) = iw1;
#pragma unroll
            for (int k4 = 0; k4 < 4; ++k4) *(f32x4*)(gp + 4 * k4) = (f32x4){ev[4 * k4] * inv, ev[4 * k4 + 1] * inv, ev[4 * k4 + 2] * inv, ev[4 * k4 + 3] * inv};
            LDS_WAIT(); asm volatile("" ::: "memory");
        }
    }
}

#define MFMA16(a, b, c) __builtin_amdgcn_mfma_f32_16x16x32_bf16((a), (b), (c), 0, 0, 0)
__device__ __forceinline__ void hgrn_fast(const Args& A0, Frame& F0, int l) {
    LAUNDER();
    constexpr int QM_OFF = 0, KM_OFF = 8704, QI_OFF = 17408, KET_OFF = 26112, VT_OFF = 36352, AL_OFF = 46592, EBC_OFF = 49152, TOT_OFF = 49664, ST_OFF = 51712, OL_OFF = ST_OFF + 8 * 4352;
    static_assert(OL_OFF + 32 * 132 * 4 <= RING_BYTES, "hgrn LDS");
    const int tid = F.tid, lane = F.lane, w = F.wave, fr = lane & 15, fq = lane >> 4;
    const int d = tid & 127, tq = tid >> 7, et = tid >> 4, eg = (tid & 15) * 8;
    LAS unsigned char* L = F.lds;
    LAS float* TOT = (LAS float*)(L + TOT_OFF); LAS float* EBC = (LAS float*)(L + EBC_OFF); LAS float* OL = (LAS float*)(L + OL_OFF);
    LAS unsigned char* STw = L + ST_OFF + w * 4352;
    for (int unit = blockIdx.x; unit < 128; unit += F.G) {
        const int b = unit >> 2, h = unit & 3;
        const size_t ebase = ((size_t)b * SEQ + 8 * tq) * 512 + h * 128 + d;
        const size_t obase = ((size_t)b * SEQ + et) * 512 + h * 128 + eg;
        const f32x4 gn0 = *(const f32x4*)(IN_hg_norm_g + l * 512 + h * 128 + eg), gn1 = *(const f32x4*)(IN_hg_norm_g + l * 512 + h * 128 + eg + 4);
        f32x4 S[8];
#pragma unroll
        for (int i = 0; i < 8; ++i) S[i] = (f32x4){0.f, 0.f, 0.f, 0.f};
        for (int i = lane; i < 4352 / 4; i += 64) ((LAS unsigned*)STw)[i] = 0u;
        unsigned short rg[8], rk[8], rq[8], rv[8];
#define HG_LOAD(c) do { const size_t o_ = ebase + (size_t)(c) * 32 * 512; _Pragma("unroll") for (int i = 0; i < 8; ++i) { rg[i] = P_GLOG[o_ + i * 512]; rk[i] = P_KK[o_ + i * 512]; rq[i] = P_QA[o_ + i * 512]; rv[i] = P_IA[o_ + i * 512]; } } while (0)
        float cs[8];
#define HG_TOT() do { float run_ = 0.f; _Pragma("unroll") for (int i = 0; i < 8; ++i) { run_ += bf2f(rg[i]); cs[i] = run_; } TOT[tq * 128 + d] = run_; } while (0)
#define HG_STAGE() do { const float t0_ = TOT[d], t1_ = TOT[128 + d], t2_ = TOT[256 + d], t3_ = TOT[384 + d]; \
            const float offs_ = (tq > 0 ? t0_ : 0.f) + (tq > 1 ? t1_ : 0.f) + (tq > 2 ? t2_ : 0.f), bmid_ = t0_ + t1_, bC_ = (t0_ + t1_) + (t2_ + t3_); \
            unsigned ke_[8], vv_[8]; \
            _Pragma("unroll") for (int i = 0; i < 8; ++i) { const float bt_ = offs_ + cs[i], q_ = bf2f(rq[i]), k_ = bf2f(rk[i]); const int t_ = 8 * tq + i; \
                const unsigned qm_ = cvtpk(q_ * __expf(bt_ - bmid_), 0.f), km_ = cvtpk(k_ * __expf(bmid_ - bt_), 0.f), qi_ = cvtpk(q_ * __expf(bt_), 0.f); ke_[i] = cvtpk(k_ * __expf(bC_ - bt_), 0.f); vv_[i] = rv[i]; \
                *(LAS unsigned short*)(L + QM_OFF + t_ * 272 + d * 2) = (unsigned short)qm_; *(LAS unsigned short*)(L + KM_OFF + t_ * 272 + d * 2) = (unsigned short)km_; *(LAS unsigned short*)(L + QI_OFF + t_ * 272 + d * 2) = (unsigned short)qi_; } \
            v4u kw_, vw_; kw_.x = (ke_[0] & 0xffffu) | (ke_[1] << 16); kw_.y = (ke_[2] & 0xffffu) | (ke_[3] << 16); kw_.z = (ke_[4] & 0xffffu) | (ke_[5] << 16); kw_.w = (ke_[6] & 0xffffu) | (ke_[7] << 16); \
            vw_.x = vv_[0] | (vv_[1] << 16); vw_.y = vv_[2] | (vv_[3] << 16); vw_.z = vv_[4] | (vv_[5] << 16); vw_.w = vv_[6] | (vv_[7] << 16); \
            *(LAS v4u*)(L + KET_OFF + d * 80 + tq * 16) = kw_; *(LAS v4u*)(L + VT_OFF + d * 80 + tq * 16) = vw_; \
            if (tq == 0) EBC[d] = __expf(bC_); } while (0)
        HG_LOAD(0); HG_TOT(); __syncthreads(); HG_STAGE(); __syncthreads();
        for (int c = 0; c < SEQ / 32; ++c) {
            const bool more = c + 1 < SEQ / 32;
            if (more) HG_LOAD(c + 1);
            const v4u rga = *(const v4u*)(P_GA + obase + (size_t)c * 32 * 512);
            if (w < 4) { const int ts = w >> 1, tt = w & 1; f32x4 at = (f32x4){0.f, 0.f, 0.f, 0.f};
#pragma unroll
                for (int ks = 0; ks < 4; ++ks) at = MFMA16(*(const LAS bf16x8*)(L + KM_OFF + (16 * ts + fr) * 272 + (32 * ks + 8 * fq) * 2), *(const LAS bf16x8*)(L + QM_OFF + (16 * tt + fr) * 272 + (32 * ks + 8 * fq) * 2), at);
                const int t = 16 * tt + fr, s0 = 16 * ts + 4 * fq; v2u aw;
                aw.x = cvtpk(s0 <= t ? at[0] : 0.f, s0 + 1 <= t ? at[1] : 0.f); aw.y = cvtpk(s0 + 2 <= t ? at[2] : 0.f, s0 + 3 <= t ? at[3] : 0.f);
                *(LAS v2u*)(L + AL_OFF + t * 80 + s0 * 2) = aw; }
            f32x4 o[2];
#pragma unroll
            for (int tt = 0; tt < 2; ++tt) { o[tt] = (f32x4){0.f, 0.f, 0.f, 0.f};
#pragma unroll
                for (int ks = 0; ks < 4; ++ks) o[tt] = MFMA16(*(const LAS bf16x8*)(L + QI_OFF + (16 * tt + fr) * 272 + (32 * ks + 8 * fq) * 2), *(const LAS bf16x8*)(STw + fr * 272 + (32 * ks + 8 * fq) * 2), o[tt]); }
            __syncthreads();
            const bf16x8 vb = *(const LAS bf16x8*)(L + VT_OFF + (16 * w + fr) * 80 + 16 * fq);
#pragma unroll
            for (int tt = 0; tt < 2; ++tt) { o[tt] = MFMA16(*(const LAS bf16x8*)(L + AL_OFF + (16 * tt + fr) * 80 + 16 * fq), vb, o[tt]);
#pragma unroll
                for (int j = 0; j < 4; ++j) OL[(16 * tt + 4 * fq + j) * 132 + 16 * w + fr] = o[tt][j]; }
#pragma unroll
            for (int dt = 0; dt < 8; ++dt) { const f32x4 e4 = *(const LAS f32x4*)(EBC + 16 * dt + 4 * fq); S[dt] = S[dt] * e4;
                S[dt] = MFMA16(*(const LAS bf16x8*)(L + KET_OFF + (16 * dt + fr) * 80 + 16 * fq), vb, S[dt]);
                v2u sw; sw.x = cvtpk(S[dt][0], S[dt][1]); sw.y = cvtpk(S[dt][2], S[dt][3]); *(LAS v2u*)(STw + fr * 272 + (16 * dt + 4 * fq) * 2) = sw; }
            if (more) HG_TOT();
            __syncthreads();
            { const f32x4 o0 = *(const LAS f32x4*)(OL + et * 132 + eg), o1 = *(const LAS f32x4*)(OL + et * 132 + eg + 4);
              float ss = ((o0[0] * o0[0] + o0[1] * o0[1]) + (o0[2] * o0[2] + o0[3] * o0[3])) + ((o1[0] * o1[0] + o1[1] * o1[1]) + (o1[2] * o1[2] + o1[3] * o1[3]));
              ss += __shfl_xor(ss, 1); ss += __shfl_xor(ss, 2); ss += __shfl_xor(ss, 4); ss += __shfl_xor(ss, 8);
              const float rstd = 1.0f / sqrtf(ss * (1.0f / 128.0f) + RMS_EPS);
              const f32x4 r0 = o0 * rstd * gn0 * (f32x4){bflo(rga.x), bfhi(rga.x), bflo(rga.y), bfhi(rga.y)}, r1 = o1 * rstd * gn1 * (f32x4){bflo(rga.z), bfhi(rga.z), bflo(rga.w), bfhi(rga.w)};
              *(v4u*)(P_OA + obase + (size_t)c * 32 * 512) = pk8(r0, r1); }
            if (more) HG_STAGE();
            __syncthreads();
        }
#undef HG_LOAD
#undef HG_TOT
#undef HG_STAGE
    }
}

#if PEER_KSLICE
typedef float f32x2v __attribute__((ext_vector_type(2)));
__device__ __forceinline__ f32x2v cvt8lo(unsigned w) { return __builtin_amdgcn_cvt_pk_f32_fp8((int)w, false); }
__device__ __forceinline__ f32x2v cvt8hi(unsigned w) { return __builtin_amdgcn_cvt_pk_f32_fp8((int)w, true); }
template <int CTRL> __device__ __forceinline__ float dppf(float v) { return __int_as_float(__builtin_amdgcn_update_dpp(0, __float_as_int(v), CTRL, 0xF, 0xF, true)); }
__device__ __forceinline__ float swap32_sum(float a, float b) { const u32x2v r = __builtin_amdgcn_permlane32_swap(__float_as_uint(a), __float_as_uint(b), false, false); return __uint_as_float(r[0]) + __uint_as_float(r[1]); }
__device__ __forceinline__ float swap16_sum(float a, float b) { const u32x2v r = __builtin_amdgcn_permlane16_swap(__float_as_uint(a), __float_as_uint(b), false, false); return __uint_as_float(r[0]) + __uint_as_float(r[1]); }
struct SlicePre { v4u ia, ib, x0, x1, x2, x3; };
__device__ __forceinline__ void slice_issue(const unsigned char* tab, const SlicePre& P, v4u (&q)[16]) {
    const unsigned iw[8] = {P.ia.x, P.ia.y, P.ia.z, P.ia.w, P.ib.x, P.ib.y, P.ib.z, P.ib.w};
#pragma unroll
    for (int i = 0; i < 16; ++i) { const unsigned e = (i & 1) ? (iw[i >> 1] >> 16) : (iw[i >> 1] & 0xffffu); q[i] = *(const v4u*)(tab + (size_t)e * 128); }
}
__device__ __forceinline__ SlicePre u_pre(const bf16* HBp, const bf16* IDXp, int tok, int xs, int g, int m) {
    SlicePre P; P.ia = *(const v4u*)(IDXp + (size_t)tok * 128 + 16 * g); P.ib = *(const v4u*)(IDXp + (size_t)tok * 128 + 16 * g + 8);
    P.x0 = *(const v4u*)(HBp + (size_t)tok * DM + 128 * xs + 16 * m); P.x1 = *(const v4u*)(HBp + (size_t)tok * DM + 128 * xs + 16 * m + 8); P.x2 = P.x0; P.x3 = P.x0; return P;
}
__device__ __forceinline__ void u_compute(const SlicePre& P, const v4u (&uq)[16], float* dst, bool b2, bool b1, bool b0) {
    const unsigned hw[8] = {P.x0.x, P.x0.y, P.x0.z, P.x0.w, P.x1.x, P.x1.y, P.x1.z, P.x1.w};
    f32x2v hf[8];
#pragma unroll
    for (int i = 0; i < 8; ++i) hf[i] = (f32x2v){bflo(hw[i]), bfhi(hw[i])};
    float p[16];
#pragma unroll
    for (int i = 0; i < 16; ++i) { const unsigned uw[4] = {uq[i].x, uq[i].y, uq[i].z, uq[i].w}; f32x2v acc = (f32x2v){0.f, 0.f};
#pragma unroll
        for (int w = 0; w < 4; ++w) { acc += hf[2 * w] * cvt8lo(uw[w]); acc += hf[2 * w + 1] * cvt8hi(uw[w]); }
        p[i] = acc[0] + acc[1]; }
    float r[8], r2[4], r3[2];
#pragma unroll
    for (int j = 0; j < 8; ++j) { const float snd = b2 ? p[j] : p[8 + j], kp = b2 ? p[8 + j] : p[j]; r[j] = kp + dppf<0x141>(snd); }
#pragma unroll
    for (int j = 0; j < 4; ++j) { const float snd = b1 ? r[j] : r[4 + j], kp = b1 ? r[4 + j] : r[j]; r2[j] = kp + dppf<0x4E>(snd); }
#pragma unroll
    for (int j = 0; j < 2; ++j) { const float snd = b0 ? r2[j] : r2[2 + j], kp = b0 ? r2[2 + j] : r2[j]; r3[j] = kp + dppf<0xB1>(snd); }
    *(f32x2v*)dst = (f32x2v){r3[0], r3[1]};
}
__device__ __forceinline__ void peer_slice_u(const Args& A0, Frame& F0) {
    LAUNDER();
    const int lane = F.lane, g = lane >> 3, m = lane & 7;
    const int xs = blockIdx.x & 7, nwv = (F.G >> 3) * NWAVES, wv = (blockIdx.x >> 3) * NWAVES + F.wave;
    const unsigned char* tab = (const unsigned char*)P_PU + (size_t)xs * 16384 * 128 + 16 * m;
    float* part = P_PART + (size_t)xs * NTOK * 128 + 2 * lane;
    const bf16* HBp = P_HB; const bf16* IDXp = P_IDX;
    const bool b2 = m & 4, b1 = m & 2, b0 = m & 1;
    const int n = (NTOK - wv + nwv - 1) / nwv;
#define TOKK(k) (wv + ((k) < n ? (k) : n - 1) * nwv)
    v4u qa[16], qb[16];
    SlicePre pa = u_pre(HBp, IDXp, TOKK(0), xs, g, m); slice_issue(tab, pa, qa);
    SlicePre pb = u_pre(HBp, IDXp, TOKK(1), xs, g, m);
    for (int k = 0; k < n; k += 2) {
        slice_issue(tab, pb, qb);
        const SlicePre pc = u_pre(HBp, IDXp, TOKK(k + 2), xs, g, m);
        u_compute(pa, qa, part + (size_t)TOKK(k) * 128, b2, b1, b0);
        slice_issue(tab, pc, qa);
        const SlicePre pd = u_pre(HBp, IDXp, TOKK(k + 3), xs, g, m);
        if (k + 1 < n) u_compute(pb, qb, part + (size_t)TOKK(k + 1) * 128, b2, b1, b0);
        pa = pc; pb = pd;
    }
#undef TOKK
}
__device__ __forceinline__ void peer_slice_r(const Args& A0, Frame& F0) {
    LAUNDER();
    const int gt = F.vcu * NTHREADS + F.tid, NGT = F.G * NTHREADS;
    for (int i = gt; i < NTOK * 128 / 4; i += NGT) {
        f32x4 s = *(const f32x4*)(P_PART + (size_t)i * 4);
#pragma unroll
        for (int q = 1; q < 8; ++q) s = s + *(const f32x4*)(P_PART + (size_t)q * NTOK * 128 + (size_t)i * 4);
        const f32x4 gv = *(const f32x4*)(P_GATE + (size_t)i * 4); f32x4 o;
#pragma unroll
        for (int j = 0; j < 4; ++j) { const float pre = s[j] * (1.0f / 2048.0f); o[j] = gv[j] * (0.5f / 128.0f) * pre * (1.0f + erff(pre * 0.70710678118654752f)); }
        *(f32x4*)(P_GATE + (size_t)i * 4) = o;
    }
}
__device__ __forceinline__ SlicePre v_pre(const float* Wp, const bf16* IDXp, int tok, int g) {
    SlicePre P; P.ia = *(const v4u*)(IDXp + (size_t)tok * 128 + 16 * g); P.ib = *(const v4u*)(IDXp + (size_t)tok * 128 + 16 * g + 8);
    const v4u* w = (const v4u*)(Wp + (size_t)tok * 128 + 16 * g); P.x0 = w[0]; P.x1 = w[1]; P.x2 = w[2]; P.x3 = w[3]; return P;
}
__device__ __forceinline__ void v_compute(const SlicePre& P, const v4u (&vq)[16], bf16* dst, bool b3) {
    const unsigned ww[16] = {P.x0.x, P.x0.y, P.x0.z, P.x0.w, P.x1.x, P.x1.y, P.x1.z, P.x1.w, P.x2.x, P.x2.y, P.x2.z, P.x2.w, P.x3.x, P.x3.y, P.x3.z, P.x3.w};
    f32x2v acc[8];
#pragma unroll
    for (int q = 0; q < 8; ++q) acc[q] = (f32x2v){0.f, 0.f};
#pragma unroll
    for (int i = 0; i < 16; ++i) { const unsigned vw[4] = {vq[i].x, vq[i].y, vq[i].z, vq[i].w}; const float wi = __uint_as_float(ww[i]); const f32x2v w2 = (f32x2v){wi, wi};
#pragma unroll
        for (int w = 0; w < 4; ++w) { acc[2 * w] += w2 * cvt8lo(vw[w]); acc[2 * w + 1] += w2 * cvt8hi(vw[w]); } }
    float a[16], r[8], r2[4], r3[2];
#pragma unroll
    for (int q = 0; q < 8; ++q) { a[2 * q] = acc[q][0]; a[2 * q + 1] = acc[q][1]; }
#pragma unroll
    for (int j = 0; j < 8; ++j) r[j] = swap32_sum(a[j], a[8 + j]);
#pragma unroll
    for (int j = 0; j < 4; ++j) r2[j] = swap16_sum(r[j], r[4 + j]);
#pragma unroll
    for (int j = 0; j < 2; ++j) { const float snd = b3 ? r2[j] : r2[2 + j], kp = b3 ? r2[2 + j] : r2[j]; r3[j] = kp + dppf<0x128>(snd); }
    *(unsigned*)dst = pk2(r3[0], r3[1]);
}
__device__ __forceinline__ void peer_slice_v(const Args& A0, Frame& F0) {
    LAUNDER();
    const int lane = F.lane, g = lane >> 3, m = lane & 7;
    const int xs = blockIdx.x & 7, nwv = (F.G >> 3) * NWAVES, wv = (blockIdx.x >> 3) * NWAVES + F.wave;
    const unsigned char* tab = (const unsigned char*)P_PV + (size_t)xs * 16384 * 128 + 16 * m;
    const bool b5 = lane & 32, b4 = lane & 16, b3 = lane & 8;
    bf16* yp = P_Y + 128 * xs + 16 * m + (b5 ? 8 : 0) + (b4 ? 4 : 0) + (b3 ? 2 : 0);
    const float* Wp = P_GATE; const bf16* IDXp = P_IDX;
    const int n = (NTOK - wv + nwv - 1) / nwv;
#define TOKK(k) (wv + ((k) < n ? (k) : n - 1) * nwv)
    v4u qa[16], qb[16];
    SlicePre pa = v_pre(Wp, IDXp, TOKK(0), g); slice_issue(tab, pa, qa);
    SlicePre pb = v_pre(Wp, IDXp, TOKK(1), g);
    for (int k = 0; k < n; k += 2) {
        slice_issue(tab, pb, qb);
        const SlicePre pc = v_pre(Wp, IDXp, TOKK(k + 2), g);
        v_compute(pa, qa, yp + (size_t)TOKK(k) * DM, b3);
        slice_issue(tab, pc, qa);
        const SlicePre pd = v_pre(Wp, IDXp, TOKK(k + 3), g);
        if (k + 1 < n) v_compute(pb, qb, yp + (size_t)TOKK(k + 1) * DM, b3);
        pa = pc; pb = pd;
    }
#undef TOKK
}
__device__ __forceinline__ void peer_slice_ln(const Args& A0, Frame& F0, int l) {
    LAUNDER();
    const int lane = F.lane;
    for (int tok = F.gw; tok < NTOK; tok += F.NGW) { const int b = tok >> 11; const float* mod = P_MOD + ((size_t)l * 32 + b) * MODW;
        const Row16 xr = ld_row(P_X + (size_t)tok * DM, lane), gt = ld_row(mod + 5120, lane);
        const v4u ya = *(const v4u*)(P_Y + (size_t)tok * DM + 8 * lane), yb = *(const v4u*)(P_Y + (size_t)tok * DM + 512 + 8 * lane);
        Row16 v;
        v.a0 = xr.a0 * DN_ALPHA + (f32x4){bflo(ya.x), bfhi(ya.x), bflo(ya.y), bfhi(ya.y)} * gt.a0; v.a1 = xr.a1 * DN_ALPHA + (f32x4){bflo(ya.z), bfhi(ya.z), bflo(ya.w), bfhi(ya.w)} * gt.a1;
        v.b0 = xr.b0 * DN_ALPHA + (f32x4){bflo(yb.x), bfhi(yb.x), bflo(yb.y), bfhi(yb.y)} * gt.b0; v.b1 = xr.b1 * DN_ALPHA + (f32x4){bflo(yb.z), bfhi(yb.z), bflo(yb.w), bfhi(yb.w)} * gt.b1;
        const Row16 xn = layer_norm_row(v, IN_ln_g + (size_t)(l * 2 + 1) * DM, IN_ln_b + (size_t)(l * 2 + 1) * DM, lane);
        st_row(P_X + (size_t)tok * DM, lane, xn);
        if (l + 1 < DEPTH) { const float* mod2 = P_MOD + ((size_t)(l + 1) * 32 + b) * MODW; const Row16 sh = ld_row(mod2, lane), sc = ld_row(mod2 + 1024, lane);
            st_row_bf16(P_HB + (size_t)tok * DM, lane, modulate(xn, sc, sh)); }
    }
}
#endif

#if PEER_KSLICE
constexpr int PH_L = 11;
#else
constexpr int PH_L = 8;
#endif
constexpr int NPHASE = 3 + PH_L * DEPTH;
__global__ void __launch_bounds__(NTHREADS, 2) trunk_fwd(Args args) {
    extern __shared__ __attribute__((aligned(16))) unsigned char lds[];
    Frame F;
    F.lds = (LAS unsigned char*)lds;
        F.tid = threadIdx.x; F.lane = F.tid & 63; F.wave = __builtin_amdgcn_readfirstlane(F.tid >> 6);
    F.G = gridDim.x; { const int bx = blockIdx.x; F.vcu = (F.G % 8 == 0) ? (bx % 8) * (F.G / 8) + bx / 8 : bx; }
    F.gw = F.vcu * NWAVES + F.wave; F.NGW = F.G * NWAVES;
    const Args& A0 = args; Frame& F0 = F;
    gu32* const ctl = (gu32*)(A0.ws + WS_CTL);
    for (int u = F.tid; u < (LDS_BYTES - LDSCTL_OFF) / 4; u += NTHREADS) ((LAS unsigned*)(F.lds + LDSCTL_OFF))[u] = 0u;
    __syncthreads();
    XcdBarrier bar; bar.bar = (unsigned*)(ctl + CW_BAR); bar.x = 0; bar.st = nullptr;
    if (!MK_PER_PHASE) bar = xcd_barrier_post((unsigned*)(ctl + CW_BAR), (volatile LAS unsigned*)(F.lds + MISC_OFF) + 8);
    const int lo = args.ph_lo, hi = args.ph_hi;
#define IN(k) (lo <= (k) && (k) < hi)
#define SEAM(k) do { if (IN(k) && IN((k) + 1)) { XcdBarrier b2 = bar; b2.bar = opq(b2.bar); xcd_barrier(b2); } } while (0)

    if (IN(0)) { phase_proA(A0, F0); } SEAM(0);
    if (IN(1)) { phase_proA2(A0, F0); } SEAM(1);
    if (IN(2)) { phase_proB(A0, F0); } SEAM(2);

    for (int l = 0; l < DEPTH; ++l) {
        const int pb = 3 + PH_L * l;
        for (int rep = 0; rep < ((PROBE_MASK & 1) ? 2 : 1); ++rep)
        if (IN(pb + 0)) { LAUNDER();
            pg8::Gemm g{P_HB, P_WIN + (size_t)l * INW * DM, NTOK, INW, DM}; pg8::StaticOrder S; S.init(NTOK, INW, F.G, (int)blockIdx.x);
            pg8::EpiInProj E{ws, P_LB + l * 512};
            pg8::gemm_phase<pg8::EpiInProj, pg8::StaticOrder, true, true>(F.lds, g, S, E);
        }
        SEAM(pb + 0);
        if (IN(pb + 1)) { const bool hg = (int)blockIdx.x < 128 && F.G >= 256; if (hg || F.G < 256) { hgrn_fast(A0, F0, l); __syncthreads(); } attn_fast(A0, F0, l, hg); }
        SEAM(pb + 1);
        for (int rep = 0; rep < ((PROBE_MASK & 8) ? 2 : 1); ++rep)
        if (IN(pb + 2)) {
            { LAUNDER(); pg8::Gemm g{P_OA, P_WUA + (size_t)l * DM * 512, NTOK, DM, 512}; pg8::StaticOrder S; S.init(NTOK, DM, F.G, (int)blockIdx.x);
              pg8::EpiGate<0> E{P_MERGED, P_GTA}; pg8::gemm_phase<pg8::EpiGate<0>, pg8::StaticOrder, true, true>(F.lds, g, S, E); }
            VM_WAIT(); __syncthreads();
            { LAUNDER(); pg8::Gemm g{P_OB, P_WUB + (size_t)l * DM * 512, NTOK, DM, 512}; pg8::StaticOrder S; S.init(NTOK, DM, F.G, (int)blockIdx.x);
              pg8::EpiGate<1> E{P_MERGED, P_GTB}; pg8::gemm_phase<pg8::EpiGate<1>, pg8::StaticOrder, true, true>(F.lds, g, S, E); }
        }
        SEAM(pb + 2);
        if (IN(pb + 3)) { LAUNDER();
            pg8::Gemm g{P_MERGED, P_WO + (size_t)l * DM * DM, NTOK, DM, DM}; pg8::StaticOrder S; S.init(NTOK, DM, F.G, (int)blockIdx.x);
            pg8::EpiWo E{l == 0 ? IN_x : (const float*)P_X, P_X, P_MOD + (size_t)l * 32 * MODW + 2048, DN_ALPHA};
            pg8::gemm_phase<pg8::EpiWo, pg8::StaticOrder, true, true>(F.lds, g, S, E);
        }
        SEAM(pb + 3);
        if (IN(pb + 4)) { phase_ln1(A0, F0, l); }
        SEAM(pb + 4);
        for (int rep = 0; rep < ((PROBE_MASK & 16) ? 2 : 1); ++rep)
        if (IN(pb + 5)) { LAUNDER();
            pg8::Gemm g{P_HB, P_WPQ + (size_t)l * DM * DM, NTOK, DM, DM}; pg8::StaticOrder S; S.init(NTOK, DM, F.G, (int)blockIdx.x);
            pg8::EpiGate<2> E{P_PQ, nullptr}; pg8::gemm_phase<pg8::EpiGate<2>, pg8::StaticOrder, true, true>(F.lds, g, S, E);
        }
        SEAM(pb + 5);
        if (IN(pb + 6)) { for (int rep = 0; rep < ((PROBE_MASK & 32) ? 2 : 1); ++rep) { if (FAST_TOPK) peer_topk_fast(A0, F0, l); else peer_topk_simple(A0, F0, l); __syncthreads(); } }
        SEAM(pb + 6);
#if PEER_KSLICE
        if (IN(pb + 7)) { peer_slice_u(A0, F0); }
        SEAM(pb + 7);
        if (IN(pb + 8)) { peer_slice_r(A0, F0); }
        SEAM(pb + 8);
        if (IN(pb + 9)) { peer_slice_v(A0, F0); }
        SEAM(pb + 9);
        if (IN(pb + 10)) { peer_slice_ln(A0, F0, l); }
        SEAM(pb + 10);
#else
        if (IN(pb + 7)) { phase_peer_expert(A0, F0, l); }
        SEAM(pb + 7);
#endif
    }
#undef IN
#undef SEAM
}

extern "C" void kernel_launch(void* const* d_in, const int* in_sizes, int n_in, void* d_out, int out_size, void* d_ws, size_t ws_size, hipStream_t stream) {
    static int grid = 0;
    if (grid == 0) {
        if (n_in != 16 || out_size != NTOK * DM || ws_size < WS_END) { fprintf(stderr, "kernel_launch: unexpected shapes (n_in %d, out %d, ws %zu)\n", n_in, out_size, ws_size); grid = -1; return; }
        int dev = 0, cus = 0, per_cu = 0;
        if (hipGetDevice(&dev) != hipSuccess || hipDeviceGetAttribute(&cus, hipDeviceAttributeMultiprocessorCount, dev) != hipSuccess) { grid = -1; return; }
        if (hipFuncSetAttribute((const void*)trunk_fwd, hipFuncAttributeMaxDynamicSharedMemorySize, LDS_BYTES) != hipSuccess) { fprintf(stderr, "kernel_launch: hipFuncSetAttribute failed\n"); grid = -1; return; }
        if (hipOccupancyMaxActiveBlocksPerMultiprocessor(&per_cu, (const void*)trunk_fwd, NTHREADS, LDS_BYTES) != hipSuccess || per_cu < 1) { fprintf(stderr, "kernel_launch: occupancy query says %d\n", per_cu); }
        (void)hipGetLastError();
        grid = cus;
    }
    if (grid < 0) return;
    if (hipMemsetAsync((char*)d_ws + WS_CTL, 0, CTL_ZERO_BYTES, stream) != hipSuccess) return;
    Args a{};
    for (int i = 0; i < 16; ++i) a.in[i] = (const float*)d_in[i];
    a.out = (float*)d_out; a.ws = (unsigned char*)d_ws;
#if MK_PER_PHASE
    for (int k = 0; k < NPHASE; ++k) { a.ph_lo = k; a.ph_hi = k + 1; hipLaunchKernelGGL(trunk_fwd, dim3(grid), dim3(NTHREADS), LDS_BYTES, stream, a); }
#else
    a.ph_lo = 0; a.ph_hi = NPHASE;
    hipLaunchKernelGGL(trunk_fwd, dim3(grid), dim3(NTHREADS), LDS_BYTES, stream, a);
#endif
    const hipError_t le = hipPeekAtLastError();
    if (le != hipSuccess) fprintf(stderr, "kernel_launch: launch failed: %s\n", hipGetErrorName(le));
}
```

```cpp
#include <hip/hip_runtime.h>
#include <cstdio>
#include <cstdint>

#ifndef MK_PER_PHASE
#define MK_PER_PHASE 0
#endif

#ifndef PROBE_MASK
#define PROBE_MASK 0
#endif

#ifndef FAST_ATTN
#define FAST_ATTN 1
#endif
#ifndef FAST_TOPK
#define FAST_TOPK 1
#endif
#ifndef FAST_HGRN
#define FAST_HGRN 1
#endif

#ifndef PEER_FP8
#define PEER_FP8 1
#endif

#ifndef PEER_KSLICE
#define PEER_KSLICE 1
#endif

namespace pg8 {
#define PG8_LAS __attribute__((address_space(3)))
typedef unsigned short bf16_t;
typedef short bf16x8 __attribute__((ext_vector_type(8)));
typedef float f32x4 __attribute__((ext_vector_type(4)));
typedef unsigned u32x4 __attribute__((ext_vector_type(4)));
constexpr int BM = 256, BK = 64, HALF = 128, HTB = HALF * BK * 2  , STAGE_BYTES = 8 * HTB, NXCD = 8, WGM = 8;

__host__ __device__ __forceinline__ int lds_byte(int r, int c) { const int st = (r >> 4) * 2 + (c >> 5), rr = r & 15, cc = c & 31, ob = rr * 64 + cc * 2; return st * 1024 + (ob ^ (((ob >> 9) & 1) << 5)); }
__host__ __device__ __forceinline__ void stage_rc(int b, int& R, int& C) { const int st = b / 1024, sb = b % 1024, swz = sb ^ (((sb >> 9) & 1) << 5); R = (st >> 1) * 16 + swz / 64; C = (st & 1) * 32 + (swz % 64) / 2; }
__host__ __device__ __forceinline__ int perm32(int rho) { const int n = rho >> 4, i = rho & 15; return 8 * (i >> 2) + 4 * n + (i & 3); }

struct Unit { int pm, pn; };
struct Gemm { const bf16_t* A; const bf16_t* Bt; int M, N, K; };

struct StaticOrder {
    int nM, nN, nwg, G, c;
    __host__ __device__ void init(int M, int N, int G_, int c_) { nM = M / BM; nN = N / BM; nwg = nM * nN; G = G_; c = c_; }
    __host__ __device__ bool next(int i, Unit& u) const {
        const long L = (long)i * G + c; if (L >= nwg) return false;
        int wgid = (int)L; { const int q = nwg / NXCD, r = nwg % NXCD, xcd = wgid % NXCD, off = wgid / NXCD; wgid = (xcd < r ? xcd * (q + 1) : r * (q + 1) + (xcd - r) * q) + off; }
        const int nig = WGM * nN, gid = wgid / nig, fm = gid * WGM, gsz = (nM - fm) < WGM ? (nM - fm) : WGM;
        u.pm = fm + ((wgid % nig) % gsz); u.pn = (wgid % nig) / gsz; return true;
    }
    __device__ __forceinline__ void a_ready(const Unit&) const {}
    __device__ __forceinline__ void done(const Unit&) const {}
};

__device__ __forceinline__ unsigned cvt_pk_bf16(float lo, float hi) { unsigned r; asm volatile("v_cvt_pk_bf16_f32 %0, %1, %2" : "=v"(r) : "v"(lo), "v"(hi)); return r; }
__device__ __forceinline__ u32x4 pack8(f32x4 v0, f32x4 v1) { u32x4 w; w.x = cvt_pk_bf16(v0[0], v0[1]); w.y = cvt_pk_bf16(v0[2], v0[3]); w.z = cvt_pk_bf16(v1[0], v1[1]); w.w = cvt_pk_bf16(v1[2], v1[3]); return w; }
__device__ __forceinline__ float bf_lo(unsigned w) { return __uint_as_float(w << 16); }
__device__ __forceinline__ float bf_hi(unsigned w) { return __uint_as_float(w & 0xffff0000u); }
__device__ __forceinline__ void unpack8(u32x4 w, f32x4& a, f32x4& b) { a = (f32x4){bf_lo(w.x), bf_hi(w.x), bf_lo(w.y), bf_hi(w.y)}; b = (f32x4){bf_lo(w.z), bf_hi(w.z), bf_lo(w.w), bf_hi(w.w)}; }
__device__ __forceinline__ float sigm(float z) { return 1.0f / (1.0f + __expf(-z)); }

struct EpiInProj {
    static constexpr bool PERM = true, AFTER_DRAIN = false;
    unsigned char* ws; const float* lb;
    static constexpr size_t M_ = 1u << 20, oQA = 202 * M_, oGLOG = 266 * M_, oKK = 330 * M_, oIA = 394 * M_, oGA = 458 * M_, oQB = 522 * M_, oKB = 586 * M_, oVT = 650 * M_, oGTA = 714 * M_, oGTB = 842 * M_;
    __device__ __forceinline__ void operator()(const f32x4 (&acc)[2][2][4][2], const Unit& u, int wr, int wc, int fr, int fq) const {
        const int pn = u.pn, row0 = u.pm * BM + wr * 64 + fr, cl0 = wc * 32 + 8 * fq;
        if (pn < 2 || (pn >= 4 && pn < 8)) {
            bf16_t* base = (bf16_t*)(ws + (pn < 2 ? oQA : (pn < 6 ? oIA : oGA))); const int cb = (pn & 1) * 256 + cl0; const bool act = pn >= 6;
#pragma unroll
            for (int ai = 0; ai < 2; ++ai)
#pragma unroll
                for (int m = 0; m < 4; ++m) { bf16_t* rowp = base + (size_t)(row0 + ai * HALF + m * 16) * 512 + cb;
#pragma unroll
                    for (int bj = 0; bj < 2; ++bj) { f32x4 v0 = acc[ai][bj][m][0], v1 = acc[ai][bj][m][1];
                        if (act) {
#pragma unroll
                            for (int j = 0; j < 4; ++j) { v0[j] = v0[j] * sigm(v0[j]); v1[j] = v1[j] * sigm(v1[j]); } }
                        *(u32x4*)(rowp + bj * HALF) = pack8(v0, v1); } }
        } else if (pn < 4) {
            const int cb = (pn - 2) * 256 + cl0; f32x4 l0[2], l1[2];
#pragma unroll
            for (int bj = 0; bj < 2; ++bj) { l0[bj] = *(const f32x4*)(lb + cb + bj * HALF); l1[bj] = *(const f32x4*)(lb + cb + bj * HALF + 4); }
#pragma unroll
            for (int ai = 0; ai < 2; ++ai)
#pragma unroll
                for (int m = 0; m < 4; ++m) { const size_t ro = (size_t)(row0 + ai * HALF + m * 16) * 512 + cb;
#pragma unroll
                    for (int bj = 0; bj < 2; ++bj) { f32x4 z0 = acc[ai][bj][m][0], z1 = acc[ai][bj][m][1], g0, g1, k0, k1;
#pragma unroll
                        for (int j = 0; j < 4; ++j) {
                            { const float z = fminf(fmaxf(z0[j], -30.f), 30.f), lbv = l0[bj][j], e = __expf(-z), s = 1.0f / (1.0f + e), omlb = 1.0f - lbv; g0[j] = __logf(lbv + omlb * s); k0[j] = omlb * e * s; }
                            { const float z = fminf(fmaxf(z1[j], -30.f), 30.f), lbv = l1[bj][j], e = __expf(-z), s = 1.0f / (1.0f + e), omlb = 1.0f - lbv; g1[j] = __logf(lbv + omlb * s); k1[j] = omlb * e * s; } }
                        *(u32x4*)((bf16_t*)(ws + oGLOG) + ro + bj * HALF) = pack8(g0, g1); *(u32x4*)((bf16_t*)(ws + oKK) + ro + bj * HALF) = pack8(k0, k1); } }
        } else if (pn < 12) {
            bf16_t* base = (bf16_t*)(ws + (pn < 10 ? oQB : oKB)); const float sc = pn < 10 ? 0.125f : 1.0f;
#pragma unroll
            for (int ai = 0; ai < 2; ++ai)
#pragma unroll
                for (int m = 0; m < 4; ++m) { const int row = row0 + ai * HALF + m * 16, b = row >> 11, t = row & 2047;
#pragma unroll
                    for (int bj = 0; bj < 2; ++bj) { const int c = (pn & 1) * 256 + bj * HALF + cl0, h = c >> 6, d = c & 63;
                        *(u32x4*)(base + ((size_t)(b * 8 + h) * 2048 + t) * 64 + d) = pack8(acc[ai][bj][m][0] * sc, acc[ai][bj][m][1] * sc); } }
        } else if (pn < 14) {
#pragma unroll
            for (int ai = 0; ai < 2; ++ai)
#pragma unroll
                for (int m = 0; m < 4; ++m) { const int row = row0 + ai * HALF + m * 16, b = row >> 11, t = row & 2047;
#pragma unroll
                    for (int bj = 0; bj < 2; ++bj) { const int c = (pn & 1) * 256 + bj * HALF + cl0, h = c >> 6, d = c & 63; const u32x4 w = pack8(acc[ai][bj][m][0], acc[ai][bj][m][1]);
                        bf16_t* p = (bf16_t*)(ws + oVT) + ((size_t)(b * 8 + h) * 64 + d) * 2048 + t;
                        p[0] = (bf16_t)(w.x & 0xffffu); p[2048] = (bf16_t)(w.x >> 16); p[2 * 2048] = (bf16_t)(w.y & 0xffffu); p[3 * 2048] = (bf16_t)(w.y >> 16);
                        p[4 * 2048] = (bf16_t)(w.z & 0xffffu); p[5 * 2048] = (bf16_t)(w.z >> 16); p[6 * 2048] = (bf16_t)(w.w & 0xffffu); p[7 * 2048] = (bf16_t)(w.w >> 16); } }
        } else {
            bf16_t* base = (bf16_t*)(ws + (pn < 18 ? oGTA : oGTB)); const int cb = ((pn - 14) & 3) * 256 + cl0;
#pragma unroll
            for (int ai = 0; ai < 2; ++ai)
#pragma unroll
                for (int m = 0; m < 4; ++m) { bf16_t* rowp = base + (size_t)(row0 + ai * HALF + m * 16) * 1024 + cb;
#pragma unroll
                    for (int bj = 0; bj < 2; ++bj) { f32x4 v0 = acc[ai][bj][m][0], v1 = acc[ai][bj][m][1];
#pragma unroll
                        for (int j = 0; j < 4; ++j) { v0[j] = sigm(v0[j]); v1[j] = sigm(v1[j]); }
                        *(u32x4*)(rowp + bj * HALF) = pack8(v0, v1); } }
        }
    }
};
template <int MODE> struct EpiGate {
    static constexpr bool PERM = true, AFTER_DRAIN = false;
    bf16_t* O; const bf16_t* G;
    __device__ __forceinline__ void operator()(const f32x4 (&acc)[2][2][4][2], const Unit& u, int wr, int wc, int fr, int fq) const {
        const int row0 = u.pm * BM + wr * 64 + fr, col0 = u.pn * BM + wc * 32 + 8 * fq;
#pragma unroll
        for (int ai = 0; ai < 2; ++ai)
#pragma unroll
            for (int m = 0; m < 4; ++m) { const size_t ro = (size_t)(row0 + ai * HALF + m * 16) * 1024 + col0;
#pragma unroll
                for (int bj = 0; bj < 2; ++bj) { f32x4 v0 = acc[ai][bj][m][0], v1 = acc[ai][bj][m][1];
                    if (MODE != 2) { f32x4 g0, g1; unpack8(*(const u32x4*)(G + ro + bj * HALF), g0, g1); v0 = v0 * g0; v1 = v1 * g1; }
                    if (MODE == 1) { f32x4 o0, o1; unpack8(*(const u32x4*)(O + ro + bj * HALF), o0, o1); v0 = v0 + o0; v1 = v1 + o1; }
                    *(u32x4*)(O + ro + bj * HALF) = pack8(v0, v1); } }
    }
};
struct EpiWo {
    static constexpr bool PERM = false, AFTER_DRAIN = false;
    const float* RES; float* X; const float* gt;
    float alpha;
    __device__ __forceinline__ void operator()(const f32x4 (&acc)[2][2][4][2], const Unit& u, int wr, int wc, int fr, int fq) const {
        const int row0 = u.pm * BM + wr * 64 + fr, col0 = u.pn * BM + wc * 32 + 4 * fq;
        const int b = (u.pm * BM) >> 11;
        f32x4 gv[2][2];
#pragma unroll
        for (int bj = 0; bj < 2; ++bj)
#pragma unroll
            for (int n = 0; n < 2; ++n) gv[bj][n] = *(const f32x4*)(gt + (size_t)b * 6144 + col0 + bj * HALF + n * 16);
#pragma unroll
        for (int ai = 0; ai < 2; ++ai)
#pragma unroll
            for (int m = 0; m < 4; ++m) { const size_t ro = (size_t)(row0 + ai * HALF + m * 16) * 1024 + col0;
#pragma unroll
                for (int bj = 0; bj < 2; ++bj)
#pragma unroll
                    for (int n = 0; n < 2; ++n) { const f32x4 r = *(const f32x4*)(RES + ro + bj * HALF + n * 16);
                        *(f32x4*)(X + ro + bj * HALF + n * 16) = r * alpha + acc[ai][bj][m][n] * gv[bj][n]; } }
    }
};

template <class Epi, class Sched, bool ALIGN_EPI = false, bool SP2 = false>
__device__ __forceinline__ void gemm_phase(PG8_LAS unsigned char* lds, const Gemm g, const Sched& S, const Epi& E) {
    int tid_ = threadIdx.x; asm volatile("" : "+v"(tid_)); const int tid = tid_, wid = __builtin_amdgcn_readfirstlane(tid >> 6), lane = tid & 63, wr = wid >> 2, wc = wid & 3, fr = lane & 15, fq = lane >> 4;
    const int K = g.K, nt = K / BK;
    unsigned voffA[2], voffB[2];
#pragma unroll
    for (int i = 0; i < 2; ++i) { int R, C; stage_rc(tid * 16 + i * 8192, R, C); const int Rb = Epi::PERM ? ((R & ~31) + perm32(R & 31)) : R;
        voffA[i] = (unsigned)(R * K + C) * 2u; voffB[i] = (unsigned)(Rb * K + C) * 2u; }
    const size_t kstep = (size_t)(BK * 2);
    const size_t hstep = (size_t)HALF * K * 2;
    const size_t tstep = 2 * hstep;
    const unsigned ldsw = (unsigned)wid * 1024u;
    const int aoff = lds_byte(wr * 64 + fr, fq * 8), boff = lds_byte(wc * 32 + fr, fq * 8);
#define PG8_SA(b, h) (((b) * 2 + (h)) * HTB)
#define PG8_SB(b, h) ((4 + (b) * 2 + (h)) * HTB)
#define PG8_STAGE(bufoff, gbase, voff) do { _Pragma("unroll") for (int _i = 0; _i < 2; ++_i) \
        __builtin_amdgcn_global_load_lds((const unsigned*)((const char*)(gbase) + (voff)[_i]), (PG8_LAS unsigned*)(lds + (bufoff) + ldsw + _i * 8192), 16, 0, 0); } while (0)
#define PG8_LDA(dst, b, h) do { _Pragma("unroll") for (int m = 0; m < 4; ++m) _Pragma("unroll") for (int k = 0; k < 2; ++k) dst[m][k] = *(const PG8_LAS bf16x8*)(lds + PG8_SA(b, h) + aoff + m * 2048 + k * 1024); } while (0)
#define PG8_LDB(dst, b, h) do { _Pragma("unroll") for (int n = 0; n < 2; ++n) _Pragma("unroll") for (int k = 0; k < 2; ++k) dst[n][k] = *(const PG8_LAS bf16x8*)(lds + PG8_SB(b, h) + boff + n * 2048 + k * 1024); } while (0)
#define PG8_MMA(ai, bj, At, Bt) do { __builtin_amdgcn_s_setprio(1); _Pragma("unroll") for (int m = 0; m < 4; ++m) _Pragma("unroll") for (int n = 0; n < 2; ++n) _Pragma("unroll") for (int k = 0; k < 2; ++k) \
        acc[ai][bj][m][n] = __builtin_amdgcn_mfma_f32_16x16x32_bf16(Bt[n][k], At[m][k], acc[ai][bj][m][n], 0, 0, 0); __builtin_amdgcn_s_setprio(0); } while (0)
#define PG8_WAIT_V(n) asm volatile("s_waitcnt vmcnt(" #n ")" ::: "memory")
#define PG8_WAIT_L(n) asm volatile("s_waitcnt lgkmcnt(" #n ")" ::: "memory")
#define PG8_BAR __builtin_amdgcn_s_barrier()
#define PG8_SCHED __builtin_amdgcn_sched_barrier(0)
    Unit cur, nxt; int ui = 0;
    if (!S.next(0, cur)) return;
    f32x4 acc[2][2][4][2];
#pragma unroll
    for (int a = 0; a < 2; ++a)
#pragma unroll
        for (int b = 0; b < 2; ++b)
#pragma unroll
            for (int m = 0; m < 4; ++m)
#pragma unroll
                for (int n = 0; n < 2; ++n) acc[a][b][m][n] = (f32x4){0.f, 0.f, 0.f, 0.f};
    bf16x8 At[4][2], B0[2][2], B1[2][2];
    const char* cA = (const char*)g.A + (size_t)cur.pm * tstep; const char* cB = (const char*)g.Bt + (size_t)cur.pn * tstep;
    S.a_ready(cur);
    if constexpr (SP2) {
        PG8_STAGE(PG8_SB(0, 0), cB, voffB); PG8_STAGE(PG8_SB(0, 1), cB + hstep, voffB); PG8_STAGE(PG8_SA(0, 0), cA, voffA); PG8_STAGE(PG8_SA(0, 1), cA + hstep, voffA);
        if (wr == 1) PG8_BAR;
        PG8_WAIT_V(2); PG8_BAR;
        PG8_STAGE(PG8_SB(1, 0), cB + kstep, voffB); PG8_STAGE(PG8_SA(1, 0), cA + kstep, voffA); PG8_STAGE(PG8_SB(1, 1), cB + hstep + kstep, voffB);
        PG8_WAIT_V(6); PG8_BAR;
    } else {
        PG8_STAGE(PG8_SB(0, 0), cB, voffB); PG8_STAGE(PG8_SA(0, 0), cA, voffA); PG8_STAGE(PG8_SB(0, 1), cB + hstep, voffB); PG8_STAGE(PG8_SA(0, 1), cA + hstep, voffA);
        if (wr == 1) PG8_BAR;
        PG8_WAIT_V(4); PG8_BAR;
        PG8_STAGE(PG8_SB(1, 0), cB + kstep, voffB); PG8_STAGE(PG8_SA(1, 0), cA + kstep, voffA); PG8_STAGE(PG8_SB(1, 1), cB + hstep + kstep, voffB);
        PG8_WAIT_V(6); PG8_BAR;
    }
    for (;;) {
        const bool has_next = S.next(ui + 1, nxt);
        const char* nA = has_next ? (const char*)g.A + (size_t)nxt.pm * tstep : cA; const char* nB = has_next ? (const char*)g.Bt + (size_t)nxt.pn * tstep : cB;
        for (int t = 0; t < nt; t += 2) {
            const bool last = (t == nt - 2);
            const char* a1 = cA + (size_t)(t + 1) * kstep;
            const char* a2 = last ? nA : cA + (size_t)(t + 2) * kstep; const char* b2 = last ? nB : cB + (size_t)(t + 2) * kstep;
            const char* a3 = a2 + kstep; const char* b3 = b2 + kstep;
            if (last && has_next) S.a_ready(nxt);
            if constexpr (SP2) {
            PG8_LDB(B0, 0, 0); PG8_LDB(B1, 0, 1); PG8_SCHED; PG8_LDA(At, 0, 0); PG8_STAGE(PG8_SA(1, 1), a1 + hstep, voffA);
            PG8_WAIT_V(8); PG8_WAIT_L(0); PG8_BAR; PG8_MMA(0, 0, At, B0); PG8_MMA(0, 1, At, B1); PG8_BAR; PG8_SCHED;
            PG8_LDA(At, 0, 1); PG8_STAGE(PG8_SB(0, 0), b2, voffB); PG8_STAGE(PG8_SB(0, 1), b2 + hstep, voffB); PG8_STAGE(PG8_SA(0, 0), a2, voffA);
            PG8_WAIT_V(8); PG8_WAIT_L(0); PG8_BAR; PG8_MMA(1, 0, At, B0); PG8_MMA(1, 1, At, B1); PG8_BAR; PG8_SCHED;
            PG8_LDB(B0, 1, 0); PG8_LDB(B1, 1, 1); PG8_SCHED; PG8_LDA(At, 1, 0); PG8_STAGE(PG8_SA(0, 1), a2 + hstep, voffA);
            PG8_WAIT_V(8); PG8_WAIT_L(0); PG8_BAR; PG8_MMA(0, 0, At, B0); PG8_MMA(0, 1, At, B1); PG8_BAR; PG8_SCHED;
            PG8_LDA(At, 1, 1); PG8_STAGE(PG8_SB(1, 0), b3, voffB); PG8_STAGE(PG8_SB(1, 1), b3 + hstep, voffB); PG8_STAGE(PG8_SA(1, 0), a3, voffA);
            PG8_WAIT_V(8); PG8_WAIT_L(0); PG8_BAR; PG8_MMA(1, 0, At, B0); PG8_MMA(1, 1, At, B1); PG8_BAR; PG8_SCHED;
            } else {
            PG8_LDB(B0, 0, 0); PG8_SCHED; PG8_LDA(At, 0, 0); PG8_STAGE(PG8_SA(1, 1), a1 + hstep, voffA);
            PG8_WAIT_L(8); PG8_BAR; PG8_WAIT_L(0); PG8_MMA(0, 0, At, B0); PG8_BAR; PG8_SCHED;
            PG8_LDB(B1, 0, 1); PG8_STAGE(PG8_SB(0, 0), b2, voffB);
            PG8_BAR; PG8_WAIT_L(0); PG8_MMA(0, 1, At, B1); PG8_BAR;
            PG8_LDA(At, 0, 1); PG8_STAGE(PG8_SA(0, 0), a2, voffA);
            PG8_BAR; PG8_WAIT_L(0); PG8_MMA(1, 0, At, B0); PG8_BAR; PG8_SCHED;
            PG8_STAGE(PG8_SB(0, 1), b2 + hstep, voffB);
            PG8_WAIT_V(6); PG8_BAR; PG8_MMA(1, 1, At, B1); PG8_BAR;
            PG8_LDB(B0, 1, 0); PG8_SCHED; PG8_LDA(At, 1, 0); PG8_STAGE(PG8_SA(0, 1), a2 + hstep, voffA);
            PG8_WAIT_L(8); PG8_BAR; PG8_WAIT_L(0); PG8_MMA(0, 0, At, B0); PG8_BAR; PG8_SCHED;
            PG8_LDB(B1, 1, 1); PG8_STAGE(PG8_SB(1, 0), b3, voffB);
            PG8_BAR; PG8_WAIT_L(0); PG8_MMA(0, 1, At, B1); PG8_BAR;
            PG8_LDA(At, 1, 1); PG8_STAGE(PG8_SA(1, 0), a3, voffA);
            PG8_BAR; PG8_WAIT_L(0); PG8_MMA(1, 0, At, B0); PG8_BAR; PG8_SCHED;
            PG8_STAGE(PG8_SB(1, 1), b3 + hstep, voffB);
            PG8_WAIT_V(6); PG8_BAR; PG8_MMA(1, 1, At, B1); PG8_BAR;
            }
        }
        if constexpr (ALIGN_EPI) { if (wr == 0) PG8_BAR; }
        if constexpr (!Epi::AFTER_DRAIN) { E(acc, cur, wr, wc, fr, fq); S.done(cur); }
        if (!has_next) break;
#pragma unroll
        for (int a = 0; a < 2; ++a)
#pragma unroll
            for (int b = 0; b < 2; ++b)
#pragma unroll
                for (int m = 0; m < 4; ++m)
#pragma unroll
                    for (int n = 0; n < 2; ++n) acc[a][b][m][n] = (f32x4){0.f, 0.f, 0.f, 0.f};
        cur = nxt; cA = nA; cB = nB; ++ui;
        if constexpr (ALIGN_EPI) { if (wr == 1) PG8_BAR; }
    }
    PG8_WAIT_V(0);
    if constexpr (!ALIGN_EPI) { if (wr == 0) PG8_BAR; }
    PG8_BAR;
    if constexpr (Epi::AFTER_DRAIN) { E.fused(acc, cur, wr, wc, fr, fq, lds, wid, lane); S.done(cur); }
#undef PG8_SA
#undef PG8_SB
#undef PG8_STAGE
#undef PG8_LDA
#undef PG8_LDB
#undef PG8_MMA
#undef PG8_WAIT_V
#undef PG8_WAIT_L
#undef PG8_BAR
#undef PG8_SCHED
}
}

constexpr int DM = 1024, NBATCH = 32, SEQ = 2048, NTOK = NBATCH * SEQ, DEPTH = 4, INW = 5632, MODW = 6144;
constexpr float DN_ALPHA = 1.681792830507429f;
constexpr float LN_EPS = 1e-5f, RMS_EPS = 1e-6f;
constexpr int NWAVES = 8, NTHREADS = 512;

constexpr size_t MiB = 1u << 20;
constexpr size_t WS_CTL = 0, CTL_ZERO_BYTES = 1 * MiB;
constexpr size_t WS_MOD = 1 * MiB;
constexpr size_t WS_LB = 4 * MiB;
constexpr size_t WS_WIN = 5 * MiB;
constexpr size_t WS_WUA = 49 * MiB, WS_WUB = 53 * MiB;
constexpr size_t WS_WO = 57 * MiB, WS_WPQ = 65 * MiB;
constexpr size_t WS_SK = 73 * MiB;
constexpr size_t WS_HB = 74 * MiB;
constexpr size_t WS_OA = 74 * MiB, WS_OB = 138 * MiB;
constexpr size_t WS_QA = 202 * MiB, WS_GLOG = 266 * MiB;
constexpr size_t WS_MERGED = 202 * MiB;
constexpr size_t WS_KK = 330 * MiB, WS_IA = 394 * MiB;
constexpr size_t WS_PQ = 330 * MiB;
constexpr size_t WS_GA = 458 * MiB;
constexpr size_t WS_IDX = 458 * MiB, WS_GATE = 474 * MiB;
constexpr size_t WS_QB = 522 * MiB, WS_KB = 586 * MiB, WS_VT = 650 * MiB;
constexpr size_t WS_PU = 522 * MiB, WS_PV = 586 * MiB;
constexpr size_t WS_GTA = 714 * MiB, WS_GTB = 842 * MiB;
constexpr size_t WS_MODP = 714 * MiB;
constexpr size_t WS_PART = 650 * MiB;
constexpr size_t WS_Y = 202 * MiB;
constexpr size_t WS_END = 970 * MiB;

constexpr int CW_BAR = 4096;
constexpr int CW_QUEUE = 16384;

constexpr int RING_BYTES = 131072;
constexpr int LDSCTL_OFF = RING_BYTES, MISC_OFF = LDSCTL_OFF + 320;
constexpr int LDS_BYTES = 147456;

#define GAS __attribute__((address_space(1)))
#define LAS __attribute__((address_space(3)))
typedef unsigned short bf16;
typedef unsigned v4u __attribute__((ext_vector_type(4)));
typedef unsigned v2u __attribute__((ext_vector_type(2)));
typedef float f32x4 __attribute__((ext_vector_type(4)));
typedef float f32x2 __attribute__((ext_vector_type(2)));
typedef GAS unsigned gu32;
#define RLX_AGENT __ATOMIC_RELAXED, __HIP_MEMORY_SCOPE_AGENT
#define LDS_WAIT() asm volatile("s_waitcnt lgkmcnt(0)" ::: "memory")
#define VM_WAIT() asm volatile("s_waitcnt vmcnt(0)" ::: "memory")

__device__ __forceinline__ float bf2f(unsigned h) { return __uint_as_float(h << 16); }
__device__ __forceinline__ float bflo(unsigned w) { return __uint_as_float(w << 16); }
__device__ __forceinline__ float bfhi(unsigned w) { return __uint_as_float(w & 0xffff0000u); }
__device__ __forceinline__ unsigned pk2(float lo, float hi) { return pg8::cvt_pk_bf16(lo, hi); }
__device__ __forceinline__ v4u pk8(f32x4 a, f32x4 b) { v4u w; w.x = pk2(a[0], a[1]); w.y = pk2(a[2], a[3]); w.z = pk2(b[0], b[1]); w.w = pk2(b[2], b[3]); return w; }
__device__ __forceinline__ float fsigmoid(float z) { return 1.0f / (1.0f + __expf(-z)); }
__device__ __forceinline__ float wave_sum(float v) {
#pragma unroll
    for (int o = 1; o < 64; o <<= 1) v += __shfl_xor(v, o);
    return v;
}

template <class T> __device__ __forceinline__ T* opq(T* p) { long z = 0; asm volatile("" : "+s"(z)); return p + z; }
__device__ __forceinline__ int opqv(int v) { asm volatile("" : "+v"(v)); return v; }
__device__ __forceinline__ int opqs(int v) { asm volatile("" : "+s"(v)); return v; }
static_assert(WS_QA == pg8::EpiInProj::oQA && WS_GLOG == pg8::EpiInProj::oGLOG && WS_KK == pg8::EpiInProj::oKK && WS_IA == pg8::EpiInProj::oIA && WS_GA == pg8::EpiInProj::oGA && WS_QB == pg8::EpiInProj::oQB
              && WS_KB == pg8::EpiInProj::oKB && WS_VT == pg8::EpiInProj::oVT && WS_GTA == pg8::EpiInProj::oGTA && WS_GTB == pg8::EpiInProj::oGTB, "EpiInProj offsets vs workspace map");
#define XB_TMO      128
#define XB_XCNT(j)  (256  + 64 * (j))
#define XB_XSUB(j)  (1280 + 64 * (j))
#define XB_XGEN(j)  (2304 + 64 * (j))
#define XB_TOP      3328
#define XB_TOPGEN   3392
#define XCD_BAR_WORDS 3456
#define XB_SPIN_CAP (1u << 22)

__device__ __forceinline__ unsigned xb_ld(unsigned* p)              { return __hip_atomic_load(p, __ATOMIC_RELAXED, __HIP_MEMORY_SCOPE_AGENT); }
__device__ __forceinline__ unsigned xb_add(unsigned* p, unsigned v) { return __hip_atomic_fetch_add(p, v, __ATOMIC_RELAXED, __HIP_MEMORY_SCOPE_AGENT); }
__device__ __forceinline__ unsigned xb_xcc_id() { return (unsigned)__builtin_amdgcn_s_getreg((3 << 11) | 20) & 0xFu; }
#define XB_SPIN(cond, bar) do { unsigned _sp = 0; while (cond) { __builtin_amdgcn_s_sleep(1); \
    if ((++_sp & 255u) == 0u) { if (xb_ld(&(bar)[XB_TMO])) break; if (_sp > XB_SPIN_CAP) { atomicAdd(&(bar)[XB_TMO], 1u); break; } } } } while (0)

struct XcdBarrier {
    unsigned* bar; unsigned x;
    volatile LAS unsigned* st;
};

__device__ __forceinline__ XcdBarrier xcd_barrier_post(unsigned* bar, volatile LAS unsigned* st) {
    XcdBarrier b; b.bar = bar; b.x = xb_xcc_id(); b.st = st;
    if (threadIdx.x == 0) (void)xb_add(&bar[XB_XCNT(b.x)], 1u);
    return b;
}
__device__ __forceinline__ void xcd_barrier_complete(unsigned* bar, unsigned x, unsigned& nloc, unsigned& nx) {
    const unsigned G = gridDim.x * gridDim.y * gridDim.z;
    unsigned sum, cnt, mine, sp = 0u;
    for (;;) {
        sum = 0u; cnt = 0u; mine = 0u;
#pragma unroll
        for (unsigned j = 0; j < 16; ++j) { const unsigned c = xb_ld(&bar[XB_XCNT(j)]); sum += c; cnt += (c > 0u) ? 1u : 0u; mine = (j == x) ? c : mine; }
        if (sum == G) break;
        __builtin_amdgcn_s_sleep(1);
        if ((++sp & 255u) == 0u) { if (xb_ld(&bar[XB_TMO])) break; if (sp > XB_SPIN_CAP) { atomicAdd(&bar[XB_TMO], 1u); break; } }
    }
    nloc = mine > 0u ? mine : 1u; nx = cnt > 0u ? cnt : 1u;
}

__device__ __forceinline__ void xcd_barrier(const XcdBarrier& b) {
    asm volatile("s_waitcnt vmcnt(0)" ::: "memory");
    __syncthreads();
    if (threadIdx.x == 0) {
        unsigned* bar = b.bar;
        __builtin_amdgcn_s_waitcnt(0);
        unsigned nloc = b.st[0], nx = b.st[1];
        if (nloc == 0u) { xcd_barrier_complete(bar, b.x, nloc, nx); b.st[0] = nloc; b.st[1] = nx; }
        const unsigned old = xb_add(&bar[XB_XSUB(b.x)], 1u);
        const unsigned gen = old / nloc;
        if (old + 1u == (gen + 1u) * nloc) {
            __builtin_amdgcn_fence(__ATOMIC_RELEASE, "agent");
            asm volatile("s_waitcnt vmcnt(0)" ::: "memory");
            const unsigned og = xb_add(&bar[XB_TOP], 1u);
            const unsigned tg = og / nx;
            if (og + 1u == (tg + 1u) * nx) xb_add(&bar[XB_TOPGEN], 1u);
            else XB_SPIN(xb_ld(&bar[XB_TOPGEN]) == tg, bar);
            __builtin_amdgcn_fence(__ATOMIC_ACQUIRE, "agent");
            xb_add(&bar[XB_XGEN(b.x)], 1u);
            asm volatile("s_waitcnt vmcnt(0)" ::: "memory");
        } else {
            XB_SPIN(xb_ld(&bar[XB_XGEN(b.x)]) == gen, bar);
            __builtin_amdgcn_fence(__ATOMIC_ACQUIRE, "agent");
            asm volatile("s_waitcnt vmcnt(0)" ::: "memory");
        }
    }
    __syncthreads();
}

struct Args { const float* in[16]; float* out; unsigned char* ws; int ph_lo, ph_hi; };
struct Frame {
    LAS unsigned char* lds;
    int tid, lane, wave, vcu, G, gw, NGW;
};
#define IN_x         (A.in[0])
#define IN_c         (A.in[1])
#define IN_w_ada     (A.in[2])
#define IN_b_ada     (A.in[3])
#define IN_w_in      (A.in[4])
#define IN_lb_logits (A.in[5])
#define IN_hg_norm_g (A.in[6])
#define IN_w_up_a    (A.in[7])
#define IN_w_up_b    (A.in[8])
#define IN_w_o       (A.in[9])
#define IN_w_pq      (A.in[10])
#define IN_sub_keys  (A.in[11])
#define IN_peer_u    (A.in[12])
#define IN_peer_v    (A.in[13])
#define IN_ln_g      (A.in[14])
#define IN_ln_b      (A.in[15])
#define P_X      (xout)
#define WSF(off) ((float*)(ws + (off)))
#define WSB(off) ((bf16*)(ws + (off)))
#define P_MOD    WSF(WS_MOD)
#define P_LB     WSF(WS_LB)
#define P_MODP   WSF(WS_MODP)
#define P_GATE   WSF(WS_GATE)
#define P_WIN    WSB(WS_WIN)
#define P_WUA    WSB(WS_WUA)
#define P_WUB    WSB(WS_WUB)
#define P_WO     WSB(WS_WO)
#define P_WPQ    WSB(WS_WPQ)
#define P_SK     WSB(WS_SK)
#define P_HB     WSB(WS_HB)
#define P_OA     WSB(WS_OA)
#define P_OB     WSB(WS_OB)
#define P_QA     WSB(WS_QA)
#define P_GLOG   WSB(WS_GLOG)
#define P_MERGED WSB(WS_MERGED)
#define P_KK     WSB(WS_KK)
#define P_IA     WSB(WS_IA)
#define P_PQ     WSB(WS_PQ)
#define P_GA     WSB(WS_GA)
#define P_IDX    WSB(WS_IDX)
#define P_QB     WSB(WS_QB)
#define P_KB     WSB(WS_KB)
#define P_VT     WSB(WS_VT)
#define P_PU     WSB(WS_PU)
#define P_PV     WSB(WS_PV)
#define P_GTA    WSB(WS_GTA)
#define P_GTB    WSB(WS_GTB)
#define P_PART   WSF(WS_PART)
#define P_Y      WSB(WS_Y)
#define LAUNDER() Args A; { long z_ = 0; asm volatile("" : "+s"(z_)); _Pragma("unroll") for (int i_ = 0; i_ < 16; ++i_) A.in[i_] = A0.in[i_] + z_; A.out = A0.out + z_; A.ws = A0.ws + z_; A.ph_lo = A0.ph_lo; A.ph_hi = A0.ph_hi; } \
    Frame F = F0; F.tid = opqv(F0.tid); F.lane = F.tid & 63; unsigned char* const ws = A.ws; float* const xout = A.out; (void)ws; (void)xout;

__device__ __forceinline__ void transpose_item(const float* W, int K, int N, bf16* WT, LAS float* scr, int item, int lane) {
    const int nblk = N / 32, kb = item / nblk, nb = item % nblk, k0 = 64 * kb, n0 = 32 * nb;
#pragma unroll 8
    for (int i = 0; i < 32; ++i) { const int kk = 2 * i + (lane >> 5); scr[kk * 33 + (lane & 31)] = W[(size_t)(k0 + kk) * N + n0 + (lane & 31)]; }
    LDS_WAIT(); asm volatile("" ::: "memory");
    const int c = lane & 7;
#pragma unroll
    for (int j = 0; j < 4; ++j) { const int n = (lane >> 3) + 8 * j; const LAS float* s = scr + (8 * c) * 33 + n;
        v4u o; o.x = pk2(s[0 * 33], s[1 * 33]); o.y = pk2(s[2 * 33], s[3 * 33]); o.z = pk2(s[4 * 33], s[5 * 33]); o.w = pk2(s[6 * 33], s[7 * 33]);
        *(v4u*)(WT + (size_t)(n0 + n) * K + k0 + 8 * c) = o; }
    LDS_WAIT(); asm volatile("" ::: "memory");
}

__device__ __forceinline__ void phase_proA(const Args& A0, Frame& F0) {
    LAUNDER();
    LAS float* scr = (LAS float*)(F.lds + F.wave * 16384);
    constexpr int I_IN = (DM / 64) * (INW / 32), I_UP = (512 / 64) * (DM / 32), I_SQ = (DM / 64) * (DM / 32), I_L = I_IN + 2 * I_UP + 2 * I_SQ;
    for (int it = F.gw; it < DEPTH * I_L; it += F.NGW) {
        const int l = it / I_L; int r = it % I_L;
        if (r < I_IN) { transpose_item(IN_w_in + (size_t)l * DM * INW, DM, INW, P_WIN + (size_t)l * INW * DM, scr, r, F.lane); continue; } r -= I_IN;
        if (r < I_UP) { transpose_item(IN_w_up_a + (size_t)l * 512 * DM, 512, DM, P_WUA + (size_t)l * DM * 512, scr, r, F.lane); continue; } r -= I_UP;
        if (r < I_UP) { transpose_item(IN_w_up_b + (size_t)l * 512 * DM, 512, DM, P_WUB + (size_t)l * DM * 512, scr, r, F.lane); continue; } r -= I_UP;
        if (r < I_SQ) { transpose_item(IN_w_o + (size_t)l * DM * DM, DM, DM, P_WO + (size_t)l * DM * DM, scr, r, F.lane); continue; } r -= I_SQ;
        transpose_item(IN_w_pq + (size_t)l * DM * DM, DM, DM, P_WPQ + (size_t)l * DM * DM, scr, r, F.lane);
    }
    { const int gt = F.vcu * NTHREADS + F.tid, NGT = F.G * NTHREADS;
      for (int i = gt; i < DEPTH * 2 * 8 * 128 * 64 / 8; i += NGT) { const f32x4 a = *(const f32x4*)(IN_sub_keys + (size_t)i * 8), b = *(const f32x4*)(IN_sub_keys + (size_t)i * 8 + 4); *(v4u*)(P_SK + (size_t)i * 8) = pk8(a, b); } }
    if (blockIdx.x == 0) { const int j = F.tid; float z[4], m = -1e30f, s = 0.f;
#pragma unroll
        for (int l = 0; l < 4; ++l) { z[l] = IN_lb_logits[l * 512 + j]; m = fmaxf(m, z[l]); }
#pragma unroll
        for (int l = 0; l < 4; ++l) { z[l] = __expf(z[l] - m); s += z[l]; }
        const float inv = 1.0f / s; float cum = 0.f; P_LB[j] = 0.f;
#pragma unroll
        for (int l = 1; l < 4; ++l) { cum += z[l] * inv; P_LB[l * 512 + j] = cum; } }
    for (int it = F.gw; it < DEPTH * 96 * 8; it += F.NGW) {
        const int l = it / 768, r = it % 768, nblk = r >> 3, ks = r & 7, n = nblk * 64 + F.lane, k0 = ks * 128;
#pragma unroll 8
        for (int i = 0; i < 64; ++i) { const int idx = F.lane + 64 * i, b = idx >> 7, kk = idx & 127; const float cv = IN_c[b * DM + k0 + kk]; scr[idx] = cv / (1.0f + __expf(-cv)); }
        LDS_WAIT(); asm volatile("" ::: "memory");
        float acc[32];
#pragma unroll
        for (int b = 0; b < 32; ++b) acc[b] = 0.f;
        const float* wp = IN_w_ada + ((size_t)l * DM + k0) * MODW + n;
        for (int kk = 0; kk < 128; kk += 4) {
            const float w0 = wp[(size_t)(kk + 0) * MODW], w1 = wp[(size_t)(kk + 1) * MODW], w2 = wp[(size_t)(kk + 2) * MODW], w3 = wp[(size_t)(kk + 3) * MODW];
#pragma unroll
            for (int b = 0; b < 32; ++b) { const f32x4 s = *(const LAS f32x4*)(scr + b * 128 + kk); acc[b] += s[0] * w0 + s[1] * w1 + s[2] * w2 + s[3] * w3; }
        }
#pragma unroll
        for (int b = 0; b < 32; ++b) P_MODP[(((size_t)ks * DEPTH + l) * 32 + b) * MODW + n] = acc[b];
        LDS_WAIT(); asm volatile("" ::: "memory");
    }
}
__device__ __forceinline__ void phase_proA2(const Args& A0, Frame& F0) {
    LAUNDER();
    const int gt = F.vcu * NTHREADS + F.tid, NGT = F.G * NTHREADS;
    for (int i = gt; i < DEPTH * 32 * MODW; i += NGT) { const int l = i / (32 * MODW), n = i % MODW; float s = IN_b_ada[l * MODW + n];
#pragma unroll
        for (int ks = 0; ks < 8; ++ks) s += P_MODP[(size_t)ks * DEPTH * 32 * MODW + i];
        P_MOD[i] = s; }
}
struct Row16 { f32x4 a0, a1, b0, b1; };
__device__ __forceinline__ Row16 ld_row(const float* p, int lane) { Row16 r; const f32x4* q = (const f32x4*)(p + 8 * lane); r.a0 = q[0]; r.a1 = q[1]; q = (const f32x4*)(p + 512 + 8 * lane); r.b0 = q[0]; r.b1 = q[1]; return r; }
__device__ __forceinline__ void st_row(float* p, int lane, const Row16& r) { f32x4* q = (f32x4*)(p + 8 * lane); q[0] = r.a0; q[1] = r.a1; q = (f32x4*)(p + 512 + 8 * lane); q[0] = r.b0; q[1] = r.b1; }
__device__ __forceinline__ void st_row_bf16(bf16* p, int lane, const Row16& r) { *(v4u*)(p + 8 * lane) = pk8(r.a0, r.a1); *(v4u*)(p + 512 + 8 * lane) = pk8(r.b0, r.b1); }
__device__ __forceinline__ unsigned pk4_fp8(f32x4 a) { int p = 0; p = __builtin_amdgcn_cvt_pk_fp8_f32(a[0], a[1], p, false); p = __builtin_amdgcn_cvt_pk_fp8_f32(a[2], a[3], p, true); return (unsigned)p; }
__device__ __forceinline__ v4u pk16_fp8(f32x4 a, f32x4 b, f32x4 c, f32x4 d) { v4u w; w.x = pk4_fp8(a); w.y = pk4_fp8(b); w.z = pk4_fp8(c); w.w = pk4_fp8(d); return w; }
__device__ __forceinline__ Row16 modulate(const Row16& x, const Row16& sc, const Row16& sh) { Row16 r; r.a0 = x.a0 * (sc.a0 + 1.0f) + sh.a0; r.a1 = x.a1 * (sc.a1 + 1.0f) + sh.a1; r.b0 = x.b0 * (sc.b0 + 1.0f) + sh.b0; r.b1 = x.b1 * (sc.b1 + 1.0f) + sh.b1; return r; }
__device__ __forceinline__ float row_sum(const Row16& r) { const f32x4 s = (r.a0 + r.a1) + (r.b0 + r.b1); return (s[0] + s[1]) + (s[2] + s[3]); }
__device__ __forceinline__ Row16 layer_norm_row(const Row16& v, const float* g, const float* bta, int lane) {
    const float mean = wave_sum(row_sum(v)) * (1.0f / DM);
    Row16 d; d.a0 = v.a0 - mean; d.a1 = v.a1 - mean; d.b0 = v.b0 - mean; d.b1 = v.b1 - mean;
    Row16 q; q.a0 = d.a0 * d.a0; q.a1 = d.a1 * d.a1; q.b0 = d.b0 * d.b0; q.b1 = d.b1 * d.b1;
    const float rstd = 1.0f / sqrtf(wave_sum(row_sum(q)) * (1.0f / DM) + LN_EPS);
    const Row16 gg = ld_row(g, lane), bb = ld_row(bta, lane);
    Row16 o; o.a0 = d.a0 * rstd * gg.a0 + bb.a0; o.a1 = d.a1 * rstd * gg.a1 + bb.a1; o.b0 = d.b0 * rstd * gg.b0 + bb.b0; o.b1 = d.b1 * rstd * gg.b1 + bb.b1; return o;
}
__device__ __forceinline__ void phase_proB(const Args& A0, Frame& F0) {
    LAUNDER();
    for (int tok = F.gw; tok < NTOK; tok += F.NGW) { const int b = tok >> 11; const float* mod = P_MOD + (size_t)b * MODW;
        const Row16 x = ld_row(IN_x + (size_t)tok * DM, F.lane), sh = ld_row(mod, F.lane), sc = ld_row(mod + 1024, F.lane);
        st_row_bf16(P_HB + (size_t)tok * DM, F.lane, modulate(x, sc, sh)); }
}
__device__ __forceinline__ void phase_ln1(const Args& A0, Frame& F0, int l) {
    LAUNDER();
    for (int tok = F.gw; tok < NTOK; tok += F.NGW) { const int b = tok >> 11; const float* mod = P_MOD + ((size_t)l * 32 + b) * MODW;
        const Row16 v = ld_row(P_X + (size_t)tok * DM, F.lane);
        const Row16 xn = layer_norm_row(v, IN_ln_g + (size_t)(l * 2 + 0) * DM, IN_ln_b + (size_t)(l * 2 + 0) * DM, F.lane);
        st_row(P_X + (size_t)tok * DM, F.lane, xn);
        const Row16 sh = ld_row(mod + 3072, F.lane), sc = ld_row(mod + 4096, F.lane);
        st_row_bf16(P_HB + (size_t)tok * DM, F.lane, modulate(xn, sc, sh)); }
    const int gt = F.vcu * NTHREADS + F.tid, NGT = F.G * NTHREADS;
    const float* pu = IN_peer_u + (size_t)l * 16384 * DM; const float* pv = IN_peer_v + (size_t)l * 16384 * DM;
#if PEER_FP8
#if PEER_KSLICE
    for (int i = gt; i < 16384 * 64; i += NGT) { const int row = i >> 6, ln = i & 63; const size_t so = (size_t)row * DM + 16 * ln, dofs = (size_t)(ln >> 3) * 16384 * 128 + (size_t)row * 128 + (ln & 7) * 16;
        { const f32x4 a = *(const f32x4*)(pu + so) * 2048.0f, b = *(const f32x4*)(pu + so + 4) * 2048.0f, c = *(const f32x4*)(pu + so + 8) * 2048.0f, d = *(const f32x4*)(pu + so + 12) * 2048.0f;
          *(v4u*)((unsigned char*)P_PU + dofs) = pk16_fp8(a, b, c, d); }
        { const f32x4 a = *(const f32x4*)(pv + so) * 128.0f, b = *(const f32x4*)(pv + so + 4) * 128.0f, c = *(const f32x4*)(pv + so + 8) * 128.0f, d = *(const f32x4*)(pv + so + 12) * 128.0f;
          *(v4u*)((unsigned char*)P_PV + dofs) = pk16_fp8(a, b, c, d); } }
#else
    for (int i = gt; i < 16384 * 64; i += NGT) { const int row = i >> 6, ln = i & 63; const size_t so = (size_t)row * DM + 8 * ln;
        { const f32x4 a = *(const f32x4*)(pu + so) * 2048.0f, b = *(const f32x4*)(pu + so + 4) * 2048.0f, c = *(const f32x4*)(pu + so + 512) * 2048.0f, d = *(const f32x4*)(pu + so + 516) * 2048.0f;
          *(v4u*)((unsigned char*)P_PU + (size_t)row * 1024 + 16 * ln) = pk16_fp8(a, b, c, d); }
        { const f32x4 a = *(const f32x4*)(pv + so) * 128.0f, b = *(const f32x4*)(pv + so + 4) * 128.0f, c = *(const f32x4*)(pv + so + 512) * 128.0f, d = *(const f32x4*)(pv + so + 516) * 128.0f;
          *(v4u*)((unsigned char*)P_PV + (size_t)row * 1024 + 16 * ln) = pk16_fp8(a, b, c, d); } }
#endif
#else
    for (int i = gt; i < 16384 * DM / 8; i += NGT) {
        const f32x4 a = *(const f32x4*)(pu + (size_t)i * 8), b = *(const f32x4*)(pu + (size_t)i * 8 + 4); *(v4u*)(P_PU + (size_t)i * 8) = pk8(a, b);
        const f32x4 c = *(const f32x4*)(pv + (size_t)i * 8), d = *(const f32x4*)(pv + (size_t)i * 8 + 4); *(v4u*)(P_PV + (size_t)i * 8) = pk8(c, d); }
#endif
}

__device__ __forceinline__ void hgrn_simple(const Args& A0, Frame& F0, int l) {
    LAUNDER();
    LAS float* fL = (LAS float*)F.lds;
    LAS float* kL = fL + 2048, *qL = kL + 2048, *vL = qL + 2048;
    LAS float* part = vL + 2048;
    const int tid = F.tid, e = tid & 127, dq = tid >> 7;
    for (int unit = blockIdx.x; unit < 128; unit += F.G) {
        const int b = unit >> 2, h = unit & 3;
        float S[32];
#pragma unroll
        for (int i = 0; i < 32; ++i) S[i] = 0.f;
        for (int t0 = 0; t0 < SEQ; t0 += 16) {
#pragma unroll
            for (int i = 0; i < 4; ++i) { const int idx = tid + 512 * i, tt = idx >> 7, d = idx & 127; const size_t off = ((size_t)(b * SEQ + t0 + tt)) * 512 + h * 128 + d;
                fL[idx] = __expf(bf2f(P_GLOG[off])); kL[idx] = bf2f(P_KK[off]); qL[idx] = bf2f(P_QA[off]); vL[idx] = bf2f(P_IA[off]); }
            __syncthreads();
            for (int tt = 0; tt < 16; ++tt) {
                const float ve = vL[tt * 128 + e]; float o = 0.f;
#pragma unroll
                for (int i4 = 0; i4 < 8; ++i4) {
                    const f32x4 f4 = *(const LAS f32x4*)(fL + tt * 128 + 32 * dq + 4 * i4), k4 = *(const LAS f32x4*)(kL + tt * 128 + 32 * dq + 4 * i4), q4 = *(const LAS f32x4*)(qL + tt * 128 + 32 * dq + 4 * i4);
#pragma unroll
                    for (int j = 0; j < 4; ++j) { S[4 * i4 + j] = f4[j] * S[4 * i4 + j] + k4[j] * ve; o += S[4 * i4 + j] * q4[j]; }
                }
                part[(tt * 4 + dq) * 128 + e] = o;
            }
            __syncthreads();
            { const int tt = tid >> 5, eg = (tid & 31) * 4; f32x4 o4 = (f32x4){0.f, 0.f, 0.f, 0.f};
#pragma unroll
              for (int q = 0; q < 4; ++q) o4 = o4 + *(const LAS f32x4*)(part + (tt * 4 + q) * 128 + eg);
              float ss = (o4[0] * o4[0] + o4[1] * o4[1]) + (o4[2] * o4[2] + o4[3] * o4[3]);
#pragma unroll
              for (int m = 1; m < 32; m <<= 1) ss += __shfl_xor(ss, m);
              const float rstd = 1.0f / sqrtf(ss * (1.0f / 128.0f) + RMS_EPS);
              const size_t ro = ((size_t)(b * SEQ + t0 + tt)) * 512 + h * 128 + eg;
              const f32x4 gn = *(const f32x4*)(IN_hg_norm_g + l * 512 + h * 128 + eg); const v2u gw2 = *(const v2u*)(P_GA + ro);
              const float r0 = o4[0] * rstd * gn[0] * bflo(gw2.x), r1 = o4[1] * rstd * gn[1] * bfhi(gw2.x), r2 = o4[2] * rstd * gn[2] * bflo(gw2.y), r3 = o4[3] * rstd * gn[3] * bfhi(gw2.y);
              v2u w; w.x = pk2(r0, r1); w.y = pk2(r2, r3); *(v2u*)(P_OA + ro) = w; }
            __syncthreads();
        }
    }
}
__device__ __forceinline__ void attn_simple(const Args& A0, Frame& F0) {
    LAUNDER();
    for (int item = blockIdx.x; item < 1024; item += F.G) {
        const int bh = item >> 2, t = (item & 3) * 512 + F.tid, b = bh >> 3, h = bh & 7;
        float q[64], o[64];
        { const v4u* qp = (const v4u*)(P_QB + ((size_t)bh * SEQ + t) * 64);
#pragma unroll
          for (int i = 0; i < 8; ++i) { const v4u w = qp[i]; q[8 * i] = bflo(w.x); q[8 * i + 1] = bfhi(w.x); q[8 * i + 2] = bflo(w.y); q[8 * i + 3] = bfhi(w.y); q[8 * i + 4] = bflo(w.z); q[8 * i + 5] = bfhi(w.z); q[8 * i + 6] = bflo(w.w); q[8 * i + 7] = bfhi(w.w); } }
#pragma unroll
        for (int d = 0; d < 64; ++d) o[d] = 0.f;
        float R = 0.f;
        for (int s = t - 1; s >= 0; --s) {
            if (R < -104.0f) break;
            const v4u* kp = (const v4u*)(P_KB + ((size_t)bh * SEQ + s) * 64); float z = 0.f;
#pragma unroll
            for (int i = 0; i < 8; ++i) { const v4u w = kp[i]; z += q[8 * i] * bflo(w.x) + q[8 * i + 1] * bfhi(w.x) + q[8 * i + 2] * bflo(w.y) + q[8 * i + 3] * bfhi(w.y) + q[8 * i + 4] * bflo(w.z) + q[8 * i + 5] * bfhi(w.z) + q[8 * i + 6] * bflo(w.w) + q[8 * i + 7] * bfhi(w.w); }
            const float sp = fmaxf(z, 0.f) + __logf(1.0f + __expf(-fabsf(z)));
            const float w = __expf(z - sp + R); R -= sp;
            const bf16* vp = P_VT + (size_t)bh * 64 * SEQ + s;
#pragma unroll
            for (int d = 0; d < 64; ++d) o[d] += w * bf2f(vp[(size_t)d * SEQ]);
        }
        bf16* op = P_OB + ((size_t)(b * SEQ + t)) * 512 + h * 64;
#pragma unroll
        for (int i = 0; i < 8; ++i) { v4u w; w.x = pk2(o[8 * i], o[8 * i + 1]); w.y = pk2(o[8 * i + 2], o[8 * i + 3]); w.z = pk2(o[8 * i + 4], o[8 * i + 5]); w.w = pk2(o[8 * i + 6], o[8 * i + 7]); *(v4u*)(op + 8 * i) = w; }
    }
}

__device__ __forceinline__ unsigned f2sort(float f) { const unsigned u = __float_as_uint(f); return u ^ ((unsigned)((int)u >> 31) | 0x80000000u); }
__device__ __forceinline__ float sort2f(unsigned k) { return __uint_as_float((k & 0x80000000u) ? (k ^ 0x80000000u) : ~k); }
__device__ __forceinline__ void ins16(unsigned (&top)[16], unsigned x) {
#pragma unroll
    for (int i = 0; i < 16; ++i) { const unsigned hi = top[i] > x ? top[i] : x; x = top[i] > x ? x : top[i]; top[i] = hi; }
}
__device__ __forceinline__ void peer_topk_simple(const Args& A0, Frame& F0, int l) {
    LAUNDER();
    LAS unsigned char* nscr = (LAS unsigned char*)F.lds + (F.wave * 64 + F.lane) * 32;
    for (int item = blockIdx.x; item < NTOK / 64; item += F.G) {
        const int tok = item * 64 + F.lane, h = F.wave;
        unsigned top[2][16];
#pragma unroll
        for (int p = 0; p < 2; ++p) {
            float q[64];
            { const v4u* qp = (const v4u*)(P_PQ + (size_t)tok * DM + h * 128 + p * 64);
#pragma unroll
              for (int i = 0; i < 8; ++i) { const v4u w = qp[i]; q[8 * i] = bflo(w.x); q[8 * i + 1] = bfhi(w.x); q[8 * i + 2] = bflo(w.y); q[8 * i + 3] = bfhi(w.y); q[8 * i + 4] = bflo(w.z); q[8 * i + 5] = bfhi(w.z); q[8 * i + 6] = bflo(w.w); q[8 * i + 7] = bfhi(w.w); } }
#pragma unroll
            for (int i = 0; i < 16; ++i) top[p][i] = 0u;
            const bf16* key = P_SK + ((size_t)((l * 2 + p) * 8 + h)) * 128 * 64;
            for (int n = 0; n < 128; ++n) {
                const v4u* kp = (const v4u*)(key + n * 64); float s = 0.f;
#pragma unroll
                for (int i = 0; i < 8; ++i) { const v4u w = kp[i]; s += q[8 * i] * bflo(w.x) + q[8 * i + 1] * bfhi(w.x) + q[8 * i + 2] * bflo(w.y) + q[8 * i + 3] * bfhi(w.y) + q[8 * i + 4] * bflo(w.z) + q[8 * i + 5] * bfhi(w.z) + q[8 * i + 6] * bflo(w.w) + q[8 * i + 7] * bfhi(w.w); }
                ins16(top[p], (f2sort(s) & ~127u) | (unsigned)(127 - n));
            }
        }
        float v1[16], v2[16];
#pragma unroll
        for (int i = 0; i < 16; ++i) { v1[i] = sort2f(top[0][i] & ~127u); v2[i] = sort2f(top[1][i] & ~127u); nscr[i] = (unsigned char)(127u - (top[0][i] & 127u)); nscr[16 + i] = (unsigned char)(127u - (top[1][i] & 127u)); }
        unsigned ct[16];
#pragma unroll
        for (int i = 0; i < 16; ++i) ct[i] = 0u;
#pragma unroll
        for (int i = 0; i < 16; ++i)
#pragma unroll
            for (int j = 0; j < 16; ++j) if ((i + 1) * (j + 1) <= 16) ins16(ct, (f2sort(v1[i] + v2[j]) & ~255u) | (unsigned)(255 - (i * 16 + j)));
        LDS_WAIT(); asm volatile("" ::: "memory");
        float ev[16], es = 0.f; const float vmax = sort2f(ct[0] & ~255u);
#pragma unroll
        for (int k = 0; k < 16; ++k) { ev[k] = __expf(sort2f(ct[k] & ~255u) - vmax); es += ev[k]; }
        const float inv = 1.0f / es;
        bf16* ip = P_IDX + (size_t)tok * 128 + h * 16; float* gp = P_GATE + (size_t)tok * 128 + h * 16;
#pragma unroll
        for (int k = 0; k < 16; ++k) { const unsigned code = 255u - (ct[k] & 255u); const unsigned n1 = nscr[code >> 4], n2 = nscr[16 + (code & 15u)];
            ip[k] = (bf16)(n1 * 128u + n2); gp[k] = ev[k] * inv; }
        LDS_WAIT(); asm volatile("" ::: "memory");
    }
}

typedef __bf16 bf16x2_t __attribute__((ext_vector_type(2)));
__device__ __forceinline__ float dot2(unsigned a, unsigned b, float c) { return __builtin_amdgcn_fdot2_f32_bf16(__builtin_bit_cast(bf16x2_t, a), __builtin_bit_cast(bf16x2_t, b), c, false); }
__device__ __forceinline__ float dot8(v4u a, v4u b, float c) { c = dot2(a.x, b.x, c); c = dot2(a.y, b.y, c); c = dot2(a.z, b.z, c); return dot2(a.w, b.w, c); }
__device__ __forceinline__ void axpy8(float (&y)[16], int o, float w, v4u v) {
    y[o + 0] += w * bflo(v.x); y[o + 1] += w * bfhi(v.x); y[o + 2] += w * bflo(v.y); y[o + 3] += w * bfhi(v.y);
    y[o + 4] += w * bflo(v.z); y[o + 5] += w * bfhi(v.z); y[o + 6] += w * bflo(v.w); y[o + 7] += w * bfhi(v.w);
}
#if PEER_FP8
__device__ __forceinline__ void peer_group8(const bf16* PUp, const bf16* PVp, Frame& F, const float (&hf)[16], unsigned idxv, float gatev, int e0, float (&y)[16]) {
    const int lane = F.lane;
    v4u uq[8], vq[8];
#pragma unroll
    for (int j = 0; j < 8; ++j) { const unsigned e = (unsigned)__builtin_amdgcn_readlane((int)idxv, e0 + j);
        uq[j] = *(const v4u*)((const unsigned char*)PUp + (size_t)e * 1024 + 16 * lane); vq[j] = *(const v4u*)((const unsigned char*)PVp + (size_t)e * 1024 + 16 * lane); }
    float p[8];
#pragma unroll
    for (int j = 0; j < 8; ++j) { float s = 0.f; const unsigned uw[4] = {uq[j].x, uq[j].y, uq[j].z, uq[j].w};
#pragma unroll
        for (int w = 0; w < 4; ++w) { const f32x2 lo = __builtin_amdgcn_cvt_pk_f32_fp8((int)uw[w], false), hi = __builtin_amdgcn_cvt_pk_f32_fp8((int)uw[w], true);
            s += hf[4 * w] * lo[0]; s += hf[4 * w + 1] * lo[1]; s += hf[4 * w + 2] * hi[0]; s += hf[4 * w + 3] * hi[1]; }
        p[j] = s; }
    const bool b5 = lane & 32, b4 = lane & 16, b3 = lane & 8;
    float r[4];
#pragma unroll
    for (int i = 0; i < 4; ++i) { const float snd = b5 ? p[i] : p[i + 4], kp = b5 ? p[i + 4] : p[i]; r[i] = kp + __shfl_xor(snd, 32); }
    float r2[2];
#pragma unroll
    for (int i = 0; i < 2; ++i) { const float snd = b4 ? r[i] : r[i + 2], kp = b4 ? r[i + 2] : r[i]; r2[i] = kp + __shfl_xor(snd, 16); }
    float r3; { const float snd = b3 ? r2[0] : r2[1], kp = b3 ? r2[1] : r2[0]; r3 = kp + __shfl_xor(snd, 8); }
    r3 += __shfl_xor(r3, 4); r3 += __shfl_xor(r3, 2); r3 += __shfl_xor(r3, 1);
    r3 *= (1.0f / 2048.0f);
    const float g = __shfl(gatev, e0 + (lane >> 3));
    const float wv = g * (0.5f / 128.0f) * r3 * (1.0f + erff(r3 * 0.70710678118654752f));
#pragma unroll
    for (int j = 0; j < 8; ++j) { const float w = __int_as_float(__builtin_amdgcn_readlane(__float_as_int(wv), 8 * j)); const unsigned vw[4] = {vq[j].x, vq[j].y, vq[j].z, vq[j].w};
#pragma unroll
        for (int q = 0; q < 4; ++q) { const f32x2 lo = __builtin_amdgcn_cvt_pk_f32_fp8((int)vw[q], false), hi = __builtin_amdgcn_cvt_pk_f32_fp8((int)vw[q], true);
            y[4 * q] += w * lo[0]; y[4 * q + 1] += w * lo[1]; y[4 * q + 2] += w * hi[0]; y[4 * q + 3] += w * hi[1]; } }
}
#else
__device__ __forceinline__ void peer_group8(const bf16* PUp, const bf16* PVp, Frame& F, const v4u hA, const v4u hB, unsigned idxv, float gatev, int e0, float (&y)[16]) {
    const int lane = F.lane;
    v4u uA[8], uB[8], vA[8], vB[8];
#pragma unroll
    for (int j = 0; j < 8; ++j) { const unsigned e = (unsigned)__builtin_amdgcn_readlane((int)idxv, e0 + j);
        const bf16* up = PUp + (size_t)e * DM + 8 * lane; const bf16* vp = PVp + (size_t)e * DM + 8 * lane;
        uA[j] = *(const v4u*)up; uB[j] = *(const v4u*)(up + 512); vA[j] = *(const v4u*)vp; vB[j] = *(const v4u*)(vp + 512); }
    float p[8];
#pragma unroll
    for (int j = 0; j < 8; ++j) p[j] = dot8(hB, uB[j], dot8(hA, uA[j], 0.f));
    const bool b5 = lane & 32, b4 = lane & 16, b3 = lane & 8;
    float r[4];
#pragma unroll
    for (int i = 0; i < 4; ++i) { const float snd = b5 ? p[i] : p[i + 4], kp = b5 ? p[i + 4] : p[i]; r[i] = kp + __shfl_xor(snd, 32); }
    float r2[2];
#pragma unroll
    for (int i = 0; i < 2; ++i) { const float snd = b4 ? r[i] : r[i + 2], kp = b4 ? r[i + 2] : r[i]; r2[i] = kp + __shfl_xor(snd, 16); }
    float r3; { const float snd = b3 ? r2[0] : r2[1], kp = b3 ? r2[1] : r2[0]; r3 = kp + __shfl_xor(snd, 8); }
    r3 += __shfl_xor(r3, 4); r3 += __shfl_xor(r3, 2); r3 += __shfl_xor(r3, 1);
    const float g = __shfl(gatev, e0 + (lane >> 3));
    const float wv = g * 0.5f * r3 * (1.0f + erff(r3 * 0.70710678118654752f));
#pragma unroll
    for (int j = 0; j < 8; ++j) { const float w = __int_as_float(__builtin_amdgcn_readlane(__float_as_int(wv), 8 * j)); axpy8(y, 0, w, vA[j]); axpy8(y, 8, w, vB[j]); }
}
#endif
__device__ __forceinline__ void phase_peer_expert(const Args& A0, Frame& F0, int l) {
    LAUNDER();
    const int lane = opqv(F.lane); const bf16* const PUp = P_PU; const bf16* const PVp = P_PV;
    for (int tok = F.gw; tok < NTOK; tok += F.NGW) {
        const int b = tok >> 11;
        const v4u hA = *(const v4u*)(P_HB + (size_t)tok * DM + 8 * lane), hB = *(const v4u*)(P_HB + (size_t)tok * DM + 512 + 8 * lane);
        const unsigned i0 = P_IDX[(size_t)tok * 128 + lane], i1 = P_IDX[(size_t)tok * 128 + 64 + lane];
        const float g0 = P_GATE[(size_t)tok * 128 + lane], g1 = P_GATE[(size_t)tok * 128 + 64 + lane];
        float y[16];
#pragma unroll
        for (int i = 0; i < 16; ++i) y[i] = 0.f;
        for (int rep = 0; rep < ((PROBE_MASK & 64) ? 2 : 1); ++rep) {
#if PEER_FP8
        float hf[16]; { const unsigned hw[8] = {hA.x, hA.y, hA.z, hA.w, hB.x, hB.y, hB.z, hB.w};
#pragma unroll
          for (int i = 0; i < 8; ++i) { hf[2 * i] = bflo(hw[i]); hf[2 * i + 1] = bfhi(hw[i]); } }
        for (int grp = 0; grp < 8; ++grp) peer_group8(PUp, PVp, F, hf, i0, g0, grp * 8, y);
        for (int grp = 0; grp < 8; ++grp) peer_group8(PUp, PVp, F, hf, i1, g1, grp * 8, y);
#else
        for (int grp = 0; grp < 8; ++grp) peer_group8(PUp, PVp, F, hA, hB, i0, g0, grp * 8, y);
        for (int grp = 0; grp < 8; ++grp) peer_group8(PUp, PVp, F, hA, hB, i1, g1, grp * 8, y);
#endif
        }
        if (PROBE_MASK & 64) {
#pragma unroll
            for (int i = 0; i < 16; ++i) y[i] *= 0.5f; }
        const float* mod = P_MOD + ((size_t)l * 32 + b) * MODW;
        const Row16 xr = ld_row(P_X + (size_t)tok * DM, lane), gt = ld_row(mod + 5120, lane);
        Row16 v;
        v.a0 = xr.a0 * DN_ALPHA + (f32x4){y[0], y[1], y[2], y[3]} * gt.a0; v.a1 = xr.a1 * DN_ALPHA + (f32x4){y[4], y[5], y[6], y[7]} * gt.a1;
        v.b0 = xr.b0 * DN_ALPHA + (f32x4){y[8], y[9], y[10], y[11]} * gt.b0; v.b1 = xr.b1 * DN_ALPHA + (f32x4){y[12], y[13], y[14], y[15]} * gt.b1;
        const Row16 xn = layer_norm_row(v, IN_ln_g + (size_t)(l * 2 + 1) * DM, IN_ln_b + (size_t)(l * 2 + 1) * DM, lane);
        st_row(P_X + (size_t)tok * DM, lane, xn);
        if (l + 1 < DEPTH) { const float* mod2 = P_MOD + ((size_t)(l + 1) * 32 + b) * MODW; const Row16 sh = ld_row(mod2, lane), sc = ld_row(mod2 + 1024, lane);
            st_row_bf16(P_HB + (size_t)tok * DM, lane, modulate(xn, sc, sh)); }
    }
}

typedef short bf16x8 __attribute__((ext_vector_type(8)));
typedef float f32x16 __attribute__((ext_vector_type(16)));
typedef float f32x2_t __attribute__((ext_vector_type(2)));
typedef unsigned u32x2v __attribute__((ext_vector_type(2)));
#define MFMA32(a, b, c) __builtin_amdgcn_mfma_f32_32x32x16_bf16((a), (b), (c), 0, 0, 0)
__device__ __forceinline__ unsigned cvtpk(float lo, float hi) { f32x2_t v = {lo, hi}; bf16x2_t b = __builtin_convertvector(v, bf16x2_t); return __builtin_bit_cast(unsigned, b); }
__device__ __forceinline__ bf16x8 ld_frag(const bf16* p) { return __builtin_bit_cast(bf16x8, *(const v4u*)p); }
__device__ __forceinline__ bf16x8 ld_frag2(const bf16* p0, const bf16* p1) { const v2u a = *(const v2u*)p0, b = *(const v2u*)p1; v4u w; w.x = a.x; w.y = a.y; w.z = b.x; w.w = b.y; return __builtin_bit_cast(bf16x8, w); }

template <bool MASK>
__device__ __forceinline__ void sb_tile(const bf16* Kp, const bf16* Vp, const bf16x8 (&qf)[4], const bf16x8 (&kf)[4], bf16x8 (&kn)[4], f32x16 (&oacc)[2], float& R, int s0, int s0n, int t, int r, int h) {
    bf16x8 vf[2][2];
#pragma unroll
    for (int db = 0; db < 2; ++db)
#pragma unroll
        for (int s2 = 0; s2 < 2; ++s2) { const bf16* vp = Vp + (size_t)(32 * db + r) * SEQ + s0 + 16 * s2 + 4 * h; vf[db][s2] = ld_frag2(vp, vp + 8); }
#pragma unroll
    for (int kk = 0; kk < 4; ++kk) kn[kk] = ld_frag(Kp + (size_t)(s0n + r) * 64 + 16 * kk + 8 * h);
    f32x16 z;
#pragma unroll
    for (int i = 0; i < 16; ++i) z[i] = 0.f;
#pragma unroll
    for (int kk = 0; kk < 4; ++kk) z = MFMA32(kf[kk], qf[kk], z);
    float L[16], lb[16];
#pragma unroll
    for (int i = 0; i < 16; ++i) {
        const float z2 = z[i] * 1.4426950408889634f;
        const float sp = fmaxf(z2, 0.f) + __builtin_amdgcn_logf(1.0f + __builtin_amdgcn_exp2f(-fabsf(z2)));
        const bool valid = !MASK || (s0 + (i & 3) + 8 * (i >> 2) + 4 * h < t);
        L[i] = valid ? -sp : 0.f; lb[i] = valid ? (z2 - sp) : -1.0e30f;
    }
    float a[16], G[4], P[4];
#pragma unroll
    for (int g = 0; g < 4; ++g) { a[4 * g + 3] = 0.f; a[4 * g + 2] = L[4 * g + 3]; a[4 * g + 1] = a[4 * g + 2] + L[4 * g + 2]; a[4 * g] = a[4 * g + 1] + L[4 * g + 1]; G[g] = a[4 * g] + L[4 * g]; }
    { const u32x2v a01 = __builtin_amdgcn_permlane32_swap(__float_as_uint(G[0]), __float_as_uint(G[1]), false, false), b01 = __builtin_amdgcn_permlane32_swap(__float_as_uint(G[1]), __float_as_uint(G[0]), false, false);
      const u32x2v a23 = __builtin_amdgcn_permlane32_swap(__float_as_uint(G[2]), __float_as_uint(G[3]), false, false), b23 = __builtin_amdgcn_permlane32_swap(__float_as_uint(G[3]), __float_as_uint(G[2]), false, false);
      P[0] = __uint_as_float(h ? b01[0] : a01[1]); P[1] = __uint_as_float(h ? a01[0] : b01[1]); P[2] = __uint_as_float(h ? b23[0] : a23[1]); P[3] = __uint_as_float(h ? a23[0] : b23[1]); }
    float off[4]; float run = 0.f;
#pragma unroll
    for (int g = 3; g >= 0; --g) { off[g] = run + (h == 0 ? P[g] : 0.f); run += G[g] + P[g]; }
    float w[16];
#pragma unroll
    for (int i = 0; i < 16; ++i) w[i] = __builtin_amdgcn_exp2f(lb[i] + (R + off[i >> 2] + a[i]));
    R += run;
    bf16x8 pf[2];
#pragma unroll
    for (int s2 = 0; s2 < 2; ++s2) { v4u pw; pw.x = cvtpk(w[8 * s2], w[8 * s2 + 1]); pw.y = cvtpk(w[8 * s2 + 2], w[8 * s2 + 3]); pw.z = cvtpk(w[8 * s2 + 4], w[8 * s2 + 5]); pw.w = cvtpk(w[8 * s2 + 6], w[8 * s2 + 7]); pf[s2] = __builtin_bit_cast(bf16x8, pw); }
#pragma unroll
    for (int db = 0; db < 2; ++db)
#pragma unroll
        for (int s2 = 0; s2 < 2; ++s2) oacc[db] = MFMA32(vf[db][s2], pf[s2], oacc[db]);
}
__device__ __forceinline__ void sb_block(const bf16* QBp, const bf16* KBp, const bf16* VTp, bf16* OBp, int bh, int t0, int r, int h) {
    const int t = t0 + r;
    const bf16* Kp = KBp + (size_t)bh * SEQ * 64; const bf16* Vp = VTp + (size_t)bh * 64 * SEQ;
    bf16x8 qf[4], ka[4], kb[4];
#pragma unroll
    for (int kk = 0; kk < 4; ++kk) { qf[kk] = ld_frag(QBp + ((size_t)bh * SEQ + t) * 64 + 16 * kk + 8 * h); ka[kk] = ld_frag(Kp + (size_t)t * 64 + 16 * kk + 8 * h); }
    f32x16 oacc[2];
#pragma unroll
    for (int i = 0; i < 16; ++i) { oacc[0][i] = 0.f; oacc[1][i] = 0.f; }
    float R = 0.f;
    sb_tile<true>(Kp, Vp, qf, ka, kb, oacc, R, t0, t0 >= 32 ? t0 - 32 : 0, t, r, h);
    for (int s0 = t0 - 32; s0 >= 0; s0 -= 64) {
        if (__all(R < -150.1f)) break;
        sb_tile<false>(Kp, Vp, qf, kb, ka, oacc, R, s0, s0 >= 32 ? s0 - 32 : 0, t, r, h);
        if (s0 < 32 || __all(R < -150.1f)) break;
        sb_tile<false>(Kp, Vp, qf, ka, kb, oacc, R, s0 - 32, s0 >= 64 ? s0 - 64 : 0, t, r, h);
    }
    bf16* op = OBp + ((size_t)((bh >> 3) * SEQ + t)) * 512 + (bh & 7) * 64 + 4 * h;
#pragma unroll
    for (int db = 0; db < 2; ++db)
#pragma unroll
        for (int g = 0; g < 4; ++g) { v2u o; o.x = cvtpk(oacc[db][4 * g], oacc[db][4 * g + 1]); o.y = cvtpk(oacc[db][4 * g + 2], oacc[db][4 * g + 3]); *(v2u*)(op + 32 * db + 8 * g) = o; }
}
__device__ __forceinline__ void attn_fast(const Args& A0, Frame& F0, int l) {
    LAUNDER();
    const int lane = F.lane, r = lane & 31, h = lane >> 5;
    const bf16* QBp = P_QB; const bf16* KBp = P_KB; const bf16* VTp = P_VT; bf16* OBp = P_OB;
    unsigned* qhead = (unsigned*)(A.ws + WS_CTL) + CW_QUEUE + 1024 * l;
    int shard = (int)blockIdx.x & 7, tried = 0;
    unsigned tkv = 0; if (lane == 0) tkv = __hip_atomic_fetch_add(qhead + 64 * shard, 1u, RLX_AGENT);
    unsigned tk = (unsigned)__builtin_amdgcn_readfirstlane((int)tkv);
    while (tried < 8) {
        if (tk >= 1024u) { shard = (shard + 1) & 7; ++tried; tkv = 0; if (lane == 0) tkv = __hip_atomic_fetch_add(qhead + 64 * shard, 1u, RLX_AGENT); tk = (unsigned)__builtin_amdgcn_readfirstlane((int)tkv); continue; }
        const int unit = shard * 1024 + (int)tk;
        tkv = 0; if (lane == 0) tkv = __hip_atomic_fetch_add(qhead + 64 * shard, 1u, RLX_AGENT);
        const int bh = unit >> 5, tb = (unit & 31) * 64;
        sb_block(QBp, KBp, VTp, OBp, bh, tb + 32, r, h);
        sb_block(QBp, KBp, VTp, OBp, bh, tb, r, h);
        tk = (unsigned)__builtin_amdgcn_readfirstlane((int)tkv);
    }
}

__device__ __forceinline__ void ce_desc(unsigned& x, unsigned& y) { const unsigned hi = x > y ? x : y, lo = x > y ? y : x; x = hi; y = lo; }
__device__ __forceinline__ void sort16_desc(unsigned (&a)[16]) {
#pragma unroll
    for (int k = 2; k <= 16; k <<= 1)
#pragma unroll
        for (int j = k >> 1; j > 0; j >>= 1)
#pragma unroll
            for (int i = 0; i < 16; ++i) { const int l = i ^ j; if (l > i) { if ((i & k) == 0) ce_desc(a[i], a[l]); else ce_desc(a[l], a[i]); } }
}
__device__ __forceinline__ void merge_top16(unsigned (&a)[16], const unsigned (&b)[16]) {
#pragma unroll
    for (int i = 0; i < 16; ++i) a[i] = a[i] > b[15 - i] ? a[i] : b[15 - i];
#pragma unroll
    for (int j = 8; j > 0; j >>= 1)
#pragma unroll
        for (int i = 0; i < 16; ++i) { const int l = i ^ j; if (l > i) ce_desc(a[i], a[l]); }
}
__device__ __forceinline__ void topk_scores(const bf16* keyp, const bf16* qp, int r, int hh, unsigned (&top)[16]) {
    bf16x8 qf[4];
#pragma unroll
    for (int kk = 0; kk < 4; ++kk) qf[kk] = ld_frag(qp + 16 * kk + 8 * hh);
#pragma unroll
    for (int nb = 0; nb < 4; ++nb) {
        f32x16 s;
#pragma unroll
        for (int i = 0; i < 16; ++i) s[i] = 0.f;
#pragma unroll
        for (int kk = 0; kk < 4; ++kk) s = MFMA32(ld_frag(keyp + (size_t)(32 * nb + r) * 64 + 16 * kk + 8 * hh), qf[kk], s);
        unsigned u[16];
#pragma unroll
        for (int i = 0; i < 16; ++i) u[i] = (f2sort(s[i]) & ~127u) | (unsigned)(127 - (32 * nb + (i & 3) + 8 * (i >> 2) + 4 * hh));
        sort16_desc(u);
        if (nb == 0) {
#pragma unroll
            for (int i = 0; i < 16; ++i) top[i] = u[i];
        } else merge_top16(top, u);
    }
}
__device__ __forceinline__ void peer_topk_fast(const Args& A0, Frame& F0, int l) {
    LAUNDER();
    const int lane = F.lane, r = lane & 31, hh = lane >> 5;
    LAS unsigned char* nscr = (LAS unsigned char*)F.lds + (F.wave * 64 + lane) * 32;
    for (int item = F.gw; item < NTOK / 32; item += F.NGW) {
        const int tok = item * 32 + r;
        for (int pair = 0; pair < 4; ++pair) {
            unsigned mine[2][16];
#pragma unroll
            for (int p = 0; p < 2; ++p) {
                unsigned ta[16], tb[16];
                topk_scores(P_SK + ((size_t)((l * 2 + p) * 8 + 2 * pair)) * 128 * 64, P_PQ + (size_t)tok * DM + (2 * pair) * 128 + p * 64, r, hh, ta);
                topk_scores(P_SK + ((size_t)((l * 2 + p) * 8 + 2 * pair + 1)) * 128 * 64, P_PQ + (size_t)tok * DM + (2 * pair + 1) * 128 + p * 64, r, hh, tb);
                unsigned other[16];
#pragma unroll
                for (int i = 0; i < 16; ++i) { const unsigned snd = hh ? ta[i] : tb[i]; other[i] = (unsigned)__shfl_xor((int)snd, 32); mine[p][i] = hh ? tb[i] : ta[i]; }
                merge_top16(mine[p], other);
            }
            const int head = 2 * pair + hh;
            float v1[16], v2[16];
#pragma unroll
            for (int i = 0; i < 16; ++i) { v1[i] = sort2f(mine[0][i] & ~127u); v2[i] = sort2f(mine[1][i] & ~127u); nscr[i] = (unsigned char)(127u - (mine[0][i] & 127u)); nscr[16 + i] = (unsigned char)(127u - (mine[1][i] & 127u)); }
#define CKEY(i, j) ((f2sort(v1[i] + v2[j]) & ~255u) | (unsigned)(255 - ((i) * 16 + (j))))
            unsigned ct[16], gb[16], gc[16], gd[16];
#pragma unroll
            for (int j = 0; j < 16; ++j) ct[j] = CKEY(0, j);
            { int n = 0;
#pragma unroll
              for (int i = 1; i <= 2; ++i)
#pragma unroll
                  for (int j = 0; j < 16; ++j) if ((i + 1) * (j + 1) <= 16) { gb[n] = CKEY(i, j); ++n; }
#pragma unroll
              for (int q = 13; q < 16; ++q) gb[q] = 0u; }
            { int n = 0;
#pragma unroll
              for (int i = 3; i <= 7; ++i)
#pragma unroll
                  for (int j = 0; j < 16; ++j) if ((i + 1) * (j + 1) <= 16) { gc[n] = CKEY(i, j); ++n; }
#pragma unroll
              for (int q = 13; q < 16; ++q) gc[q] = 0u; }
#pragma unroll
            for (int i = 8; i < 16; ++i) gd[i - 8] = CKEY(i, 0);
#pragma unroll
            for (int q = 8; q < 16; ++q) gd[q] = 0u;
#undef CKEY
            sort16_desc(gb); sort16_desc(gc); sort16_desc(gd);
            merge_top16(ct, gb); merge_top16(gc, gd); merge_top16(ct, gc);
            LDS_WAIT(); asm volatile("" ::: "memory");
            float ev[16], es = 0.f; const float vmax = sort2f(ct[0] & ~255u);
#pragma unroll
            for (int k = 0; k < 16; ++k) { ev[k] = __expf(sort2f(ct[k] & ~255u) - vmax); es += ev[k]; }
            const float inv = 1.0f / es;
            unsigned idx[16];
#pragma unroll
            for (int k = 0; k < 16; ++k) { const unsigned code = 255u - (ct[k] & 255u); idx[k] = (unsigned)nscr[code >> 4] * 128u + (unsigned)nscr[16 + (code & 15u)]; }
            bf16* ip = P_IDX + (size_t)tok * 128 + head * 16; float* gp = P_GATE + (size_t)tok * 128 + head * 16;
            v4u iw0, iw1; iw0.x = idx[0] | (idx[1] << 16); iw0.y = idx[2] | (idx[3] << 16); iw0.z = idx[4] | (idx[5] << 16); iw0.w = idx[6] | (idx[7] << 16);
            iw1.x = idx[8] | (idx[9] << 16); iw1.y = idx[10] | (idx[11] << 16); iw1.z = idx[12] | (idx[13] << 16); iw1.w = idx[14] | (idx[15] << 16);
            *(v4u*)ip = iw0; *(v4u*)(ip + 8) = iw1;
#pragma unroll
            for (int k4 = 0; k4 < 4; ++k4) *(f32x4*)(gp + 4 * k4) = (f32x4){ev[4 * k4] * inv, ev[4 * k4 + 1] * inv, ev[4 * k4 + 2] * inv, ev[4 * k4 + 3] * inv};
            LDS_WAIT(); asm volatile("" ::: "memory");
        }
    }
}

#define MFMA16(a, b, c) __builtin_amdgcn_mfma_f32_16x16x32_bf16((a), (b), (c), 0, 0, 0)
__device__ __forceinline__ void hgrn_fast(const Args& A0, Frame& F0, int l) {
    LAUNDER();
    constexpr int QM_OFF = 0, KM_OFF = 8704, QI_OFF = 17408, KET_OFF = 26112, VT_OFF = 36352, AL_OFF = 46592, EBC_OFF = 49152, TOT_OFF = 49664, ST_OFF = 51712, OL_OFF = ST_OFF + 8 * 4352;
    static_assert(OL_OFF + 32 * 132 * 4 <= RING_BYTES, "hgrn LDS");
    const int tid = F.tid, lane = F.lane, w = F.wave, fr = lane & 15, fq = lane >> 4;
    const int d = tid & 127, tq = tid >> 7, et = tid >> 4, eg = (tid & 15) * 8;
    LAS unsigned char* L = F.lds;
    LAS float* TOT = (LAS float*)(L + TOT_OFF); LAS float* EBC = (LAS float*)(L + EBC_OFF); LAS float* OL = (LAS float*)(L + OL_OFF);
    LAS unsigned char* STw = L + ST_OFF + w * 4352;
    for (int unit = blockIdx.x; unit < 128; unit += F.G) {
        const int b = unit >> 2, h = unit & 3;
        const size_t ebase = ((size_t)b * SEQ + 8 * tq) * 512 + h * 128 + d;
        const size_t obase = ((size_t)b * SEQ + et) * 512 + h * 128 + eg;
        const f32x4 gn0 = *(const f32x4*)(IN_hg_norm_g + l * 512 + h * 128 + eg), gn1 = *(const f32x4*)(IN_hg_norm_g + l * 512 + h * 128 + eg + 4);
        f32x4 S[8];
#pragma unroll
        for (int i = 0; i < 8; ++i) S[i] = (f32x4){0.f, 0.f, 0.f, 0.f};
        for (int i = lane; i < 4352 / 4; i += 64) ((LAS unsigned*)STw)[i] = 0u;
        unsigned short rg[8], rk[8], rq[8], rv[8];
#define HG_LOAD(c) do { const size_t o_ = ebase + (size_t)(c) * 32 * 512; _Pragma("unroll") for (int i = 0; i < 8; ++i) { rg[i] = P_GLOG[o_ + i * 512]; rk[i] = P_KK[o_ + i * 512]; rq[i] = P_QA[o_ + i * 512]; rv[i] = P_IA[o_ + i * 512]; } } while (0)
        float cs[8];
#define HG_TOT() do { float run_ = 0.f; _Pragma("unroll") for (int i = 0; i < 8; ++i) { run_ += bf2f(rg[i]); cs[i] = run_; } TOT[tq * 128 + d] = run_; } while (0)
#define HG_STAGE() do { const float t0_ = TOT[d], t1_ = TOT[128 + d], t2_ = TOT[256 + d], t3_ = TOT[384 + d]; \
            const float offs_ = (tq > 0 ? t0_ : 0.f) + (tq > 1 ? t1_ : 0.f) + (tq > 2 ? t2_ : 0.f), bmid_ = t0_ + t1_, bC_ = (t0_ + t1_) + (t2_ + t3_); \
            unsigned ke_[8], vv_[8]; \
            _Pragma("unroll") for (int i = 0; i < 8; ++i) { const float bt_ = offs_ + cs[i], q_ = bf2f(rq[i]), k_ = bf2f(rk[i]); const int t_ = 8 * tq + i; \
                const unsigned qm_ = cvtpk(q_ * __expf(bt_ - bmid_), 0.f), km_ = cvtpk(k_ * __expf(bmid_ - bt_), 0.f), qi_ = cvtpk(q_ * __expf(bt_), 0.f); ke_[i] = cvtpk(k_ * __expf(bC_ - bt_), 0.f); vv_[i] = rv[i]; \
                *(LAS unsigned short*)(L + QM_OFF + t_ * 272 + d * 2) = (unsigned short)qm_; *(LAS unsigned short*)(L + KM_OFF + t_ * 272 + d * 2) = (unsigned short)km_; *(LAS unsigned short*)(L + QI_OFF + t_ * 272 + d * 2) = (unsigned short)qi_; } \
            v4u kw_, vw_; kw_.x = (ke_[0] & 0xffffu) | (ke_[1] << 16); kw_.y = (ke_[2] & 0xffffu) | (ke_[3] << 16); kw_.z = (ke_[4] & 0xffffu) | (ke_[5] << 16); kw_.w = (ke_[6] & 0xffffu) | (ke_[7] << 16); \
            vw_.x = vv_[0] | (vv_[1] << 16); vw_.y = vv_[2] | (vv_[3] << 16); vw_.z = vv_[4] | (vv_[5] << 16); vw_.w = vv_[6] | (vv_[7] << 16); \
            *(LAS v4u*)(L + KET_OFF + d * 80 + tq * 16) = kw_; *(LAS v4u*)(L + VT_OFF + d * 80 + tq * 16) = vw_; \
            if (tq == 0) EBC[d] = __expf(bC_); } while (0)
        HG_LOAD(0); HG_TOT(); __syncthreads(); HG_STAGE(); __syncthreads();
        for (int c = 0; c < SEQ / 32; ++c) {
            const bool more = c + 1 < SEQ / 32;
            if (more) HG_LOAD(c + 1);
            const v4u rga = *(const v4u*)(P_GA + obase + (size_t)c * 32 * 512);
            if (w < 4) { const int ts = w >> 1, tt = w & 1; f32x4 at = (f32x4){0.f, 0.f, 0.f, 0.f};
#pragma unroll
                for (int ks = 0; ks < 4; ++ks) at = MFMA16(*(const LAS bf16x8*)(L + KM_OFF + (16 * ts + fr) * 272 + (32 * ks + 8 * fq) * 2), *(const LAS bf16x8*)(L + QM_OFF + (16 * tt + fr) * 272 + (32 * ks + 8 * fq) * 2), at);
                const int t = 16 * tt + fr, s0 = 16 * ts + 4 * fq; v2u aw;
                aw.x = cvtpk(s0 <= t ? at[0] : 0.f, s0 + 1 <= t ? at[1] : 0.f); aw.y = cvtpk(s0 + 2 <= t ? at[2] : 0.f, s0 + 3 <= t ? at[3] : 0.f);
                *(LAS v2u*)(L + AL_OFF + t * 80 + s0 * 2) = aw; }
            f32x4 o[2];
#pragma unroll
            for (int tt = 0; tt < 2; ++tt) { o[tt] = (f32x4){0.f, 0.f, 0.f, 0.f};
#pragma unroll
                for (int ks = 0; ks < 4; ++ks) o[tt] = MFMA16(*(const LAS bf16x8*)(L + QI_OFF + (16 * tt + fr) * 272 + (32 * ks + 8 * fq) * 2), *(const LAS bf16x8*)(STw + fr * 272 + (32 * ks + 8 * fq) * 2), o[tt]); }
            __syncthreads();
            const bf16x8 vb = *(const LAS bf16x8*)(L + VT_OFF + (16 * w + fr) * 80 + 16 * fq);
#pragma unroll
            for (int tt = 0; tt < 2; ++tt) { o[tt] = MFMA16(*(const LAS bf16x8*)(L + AL_OFF + (16 * tt + fr) * 80 + 16 * fq), vb, o[tt]);
#pragma unroll
                for (int j = 0; j < 4; ++j) OL[(16 * tt + 4 * fq + j) * 132 + 16 * w + fr] = o[tt][j]; }
#pragma unroll
            for (int dt = 0; dt < 8; ++dt) { const f32x4 e4 = *(const LAS f32x4*)(EBC + 16 * dt + 4 * fq); S[dt] = S[dt] * e4;
                S[dt] = MFMA16(*(const LAS bf16x8*)(L + KET_OFF + (16 * dt + fr) * 80 + 16 * fq), vb, S[dt]);
                v2u sw; sw.x = cvtpk(S[dt][0], S[dt][1]); sw.y = cvtpk(S[dt][2], S[dt][3]); *(LAS v2u*)(STw + fr * 272 + (16 * dt + 4 * fq) * 2) = sw; }
            if (more) HG_TOT();
            __syncthreads();
            { const f32x4 o0 = *(const LAS f32x4*)(OL + et * 132 + eg), o1 = *(const LAS f32x4*)(OL + et * 132 + eg + 4);
              float ss = ((o0[0] * o0[0] + o0[1] * o0[1]) + (o0[2] * o0[2] + o0[3] * o0[3])) + ((o1[0] * o1[0] + o1[1] * o1[1]) + (o1[2] * o1[2] + o1[3] * o1[3]));
              ss += __shfl_xor(ss, 1); ss += __shfl_xor(ss, 2); ss += __shfl_xor(ss, 4); ss += __shfl_xor(ss, 8);
              const float rstd = 1.0f / sqrtf(ss * (1.0f / 128.0f) + RMS_EPS);
              const f32x4 r0 = o0 * rstd * gn0 * (f32x4){bflo(rga.x), bfhi(rga.x), bflo(rga.y), bfhi(rga.y)}, r1 = o1 * rstd * gn1 * (f32x4){bflo(rga.z), bfhi(rga.z), bflo(rga.w), bfhi(rga.w)};
              *(v4u*)(P_OA + obase + (size_t)c * 32 * 512) = pk8(r0, r1); }
            if (more) HG_STAGE();
            __syncthreads();
        }
#undef HG_LOAD
#undef HG_TOT
#undef HG_STAGE
    }
}

#if PEER_KSLICE
typedef float f32x2v __attribute__((ext_vector_type(2)));
__device__ __forceinline__ f32x2v cvt8lo(unsigned w) { return __builtin_amdgcn_cvt_pk_f32_fp8((int)w, false); }
__device__ __forceinline__ f32x2v cvt8hi(unsigned w) { return __builtin_amdgcn_cvt_pk_f32_fp8((int)w, true); }
template <int CTRL> __device__ __forceinline__ float dppf(float v) { return __int_as_float(__builtin_amdgcn_update_dpp(0, __float_as_int(v), CTRL, 0xF, 0xF, true)); }
__device__ __forceinline__ float swap32_sum(float a, float b) { const u32x2v r = __builtin_amdgcn_permlane32_swap(__float_as_uint(a), __float_as_uint(b), false, false); return __uint_as_float(r[0]) + __uint_as_float(r[1]); }
__device__ __forceinline__ float swap16_sum(float a, float b) { const u32x2v r = __builtin_amdgcn_permlane16_swap(__float_as_uint(a), __float_as_uint(b), false, false); return __uint_as_float(r[0]) + __uint_as_float(r[1]); }
struct SlicePre { v4u ia, ib, x0, x1, x2, x3; };
__device__ __forceinline__ void slice_issue(const unsigned char* tab, const SlicePre& P, v4u (&q)[16]) {
    const unsigned iw[8] = {P.ia.x, P.ia.y, P.ia.z, P.ia.w, P.ib.x, P.ib.y, P.ib.z, P.ib.w};
#pragma unroll
    for (int i = 0; i < 16; ++i) { const unsigned e = (i & 1) ? (iw[i >> 1] >> 16) : (iw[i >> 1] & 0xffffu); q[i] = *(const v4u*)(tab + (size_t)e * 128); }
}
__device__ __forceinline__ SlicePre u_pre(const bf16* HBp, const bf16* IDXp, int tok, int xs, int g, int m) {
    SlicePre P; P.ia = *(const v4u*)(IDXp + (size_t)tok * 128 + 16 * g); P.ib = *(const v4u*)(IDXp + (size_t)tok * 128 + 16 * g + 8);
    P.x0 = *(const v4u*)(HBp + (size_t)tok * DM + 128 * xs + 16 * m); P.x1 = *(const v4u*)(HBp + (size_t)tok * DM + 128 * xs + 16 * m + 8); P.x2 = P.x0; P.x3 = P.x0; return P;
}
__device__ __forceinline__ void u_compute(const SlicePre& P, const v4u (&uq)[16], float* dst, bool b2, bool b1, bool b0) {
    const unsigned hw[8] = {P.x0.x, P.x0.y, P.x0.z, P.x0.w, P.x1.x, P.x1.y, P.x1.z, P.x1.w};
    f32x2v hf[8];
#pragma unroll
    for (int i = 0; i < 8; ++i) hf[i] = (f32x2v){bflo(hw[i]), bfhi(hw[i])};
    float p[16];
#pragma unroll
    for (int i = 0; i < 16; ++i) { const unsigned uw[4] = {uq[i].x, uq[i].y, uq[i].z, uq[i].w}; f32x2v acc = (f32x2v){0.f, 0.f};
#pragma unroll
        for (int w = 0; w < 4; ++w) { acc += hf[2 * w] * cvt8lo(uw[w]); acc += hf[2 * w + 1] * cvt8hi(uw[w]); }
        p[i] = acc[0] + acc[1]; }
    float r[8], r2[4], r3[2];
#pragma unroll
    for (int j = 0; j < 8; ++j) { const float snd = b2 ? p[j] : p[8 + j], kp = b2 ? p[8 + j] : p[j]; r[j] = kp + dppf<0x141>(snd); }
#pragma unroll
    for (int j = 0; j < 4; ++j) { const float snd = b1 ? r[j] : r[4 + j], kp = b1 ? r[4 + j] : r[j]; r2[j] = kp + dppf<0x4E>(snd); }
#pragma unroll
    for (int j = 0; j < 2; ++j) { const float snd = b0 ? r2[j] : r2[2 + j], kp = b0 ? r2[2 + j] : r2[j]; r3[j] = kp + dppf<0xB1>(snd); }
    *(f32x2v*)dst = (f32x2v){r3[0], r3[1]};
}
__device__ __forceinline__ void peer_slice_u(const Args& A0, Frame& F0) {
    LAUNDER();
    const int lane = F.lane, g = lane >> 3, m = lane & 7;
    const int xs = blockIdx.x & 7, nwv = (F.G >> 3) * NWAVES, wv = (blockIdx.x >> 3) * NWAVES + F.wave;
    const unsigned char* tab = (const unsigned char*)P_PU + (size_t)xs * 16384 * 128 + 16 * m;
    float* part = P_PART + (size_t)xs * NTOK * 128 + 2 * lane;
    const bf16* HBp = P_HB; const bf16* IDXp = P_IDX;
    const bool b2 = m & 4, b1 = m & 2, b0 = m & 1;
    const int n = (NTOK - wv + nwv - 1) / nwv;
#define TOKK(k) (wv + ((k) < n ? (k) : n - 1) * nwv)
    v4u qa[16], qb[16];
    SlicePre pa = u_pre(HBp, IDXp, TOKK(0), xs, g, m); slice_issue(tab, pa, qa);
    SlicePre pb = u_pre(HBp, IDXp, TOKK(1), xs, g, m);
    for (int k = 0; k < n; k += 2) {
        slice_issue(tab, pb, qb);
        const SlicePre pc = u_pre(HBp, IDXp, TOKK(k + 2), xs, g, m);
        u_compute(pa, qa, part + (size_t)TOKK(k) * 128, b2, b1, b0);
        slice_issue(tab, pc, qa);
        const SlicePre pd = u_pre(HBp, IDXp, TOKK(k + 3), xs, g, m);
        if (k + 1 < n) u_compute(pb, qb, part + (size_t)TOKK(k + 1) * 128, b2, b1, b0);
        pa = pc; pb = pd;
    }
#undef TOKK
}
__device__ __forceinline__ void peer_slice_r(const Args& A0, Frame& F0) {
    LAUNDER();
    const int gt = F.vcu * NTHREADS + F.tid, NGT = F.G * NTHREADS;
    for (int i = gt; i < NTOK * 128 / 4; i += NGT) {
        f32x4 s = *(const f32x4*)(P_PART + (size_t)i * 4);
#pragma unroll
        for (int q = 1; q < 8; ++q) s = s + *(const f32x4*)(P_PART + (size_t)q * NTOK * 128 + (size_t)i * 4);
        const f32x4 gv = *(const f32x4*)(P_GATE + (size_t)i * 4); f32x4 o;
#pragma unroll
        for (int j = 0; j < 4; ++j) { const float pre = s[j] * (1.0f / 2048.0f); o[j] = gv[j] * (0.5f / 128.0f) * pre * (1.0f + erff(pre * 0.70710678118654752f)); }
        *(f32x4*)(P_GATE + (size_t)i * 4) = o;
    }
}
__device__ __forceinline__ SlicePre v_pre(const float* Wp, const bf16* IDXp, int tok, int g) {
    SlicePre P; P.ia = *(const v4u*)(IDXp + (size_t)tok * 128 + 16 * g); P.ib = *(const v4u*)(IDXp + (size_t)tok * 128 + 16 * g + 8);
    const v4u* w = (const v4u*)(Wp + (size_t)tok * 128 + 16 * g); P.x0 = w[0]; P.x1 = w[1]; P.x2 = w[2]; P.x3 = w[3]; return P;
}
__device__ __forceinline__ void v_compute(const SlicePre& P, const v4u (&vq)[16], bf16* dst, bool b3) {
    const unsigned ww[16] = {P.x0.x, P.x0.y, P.x0.z, P.x0.w, P.x1.x, P.x1.y, P.x1.z, P.x1.w, P.x2.x, P.x2.y, P.x2.z, P.x2.w, P.x3.x, P.x3.y, P.x3.z, P.x3.w};
    f32x2v acc[8];
#pragma unroll
    for (int q = 0; q < 8; ++q) acc[q] = (f32x2v){0.f, 0.f};
#pragma unroll
    for (int i = 0; i < 16; ++i) { const unsigned vw[4] = {vq[i].x, vq[i].y, vq[i].z, vq[i].w}; const float wi = __uint_as_float(ww[i]); const f32x2v w2 = (f32x2v){wi, wi};
#pragma unroll
        for (int w = 0; w < 4; ++w) { acc[2 * w] += w2 * cvt8lo(vw[w]); acc[2 * w + 1] += w2 * cvt8hi(vw[w]); } }
    float a[16], r[8], r2[4], r3[2];
#pragma unroll
    for (int q = 0; q < 8; ++q) { a[2 * q] = acc[q][0]; a[2 * q + 1] = acc[q][1]; }
#pragma unroll
    for (int j = 0; j < 8; ++j) r[j] = swap32_sum(a[j], a[8 + j]);
#pragma unroll
    for (int j = 0; j < 4; ++j) r2[j] = swap16_sum(r[j], r[4 + j]);
#pragma unroll
    for (int j = 0; j < 2; ++j) { const float snd = b3 ? r2[j] : r2[2 + j], kp = b3 ? r2[2 + j] : r2[j]; r3[j] = kp + dppf<0x128>(snd); }
    *(unsigned*)dst = pk2(r3[0], r3[1]);
}
__device__ __forceinline__ void peer_slice_v(const Args& A0, Frame& F0) {
    LAUNDER();
    const int lane = F.lane, g = lane >> 3, m = lane & 7;
    const int xs = blockIdx.x & 7, nwv = (F.G >> 3) * NWAVES, wv = (blockIdx.x >> 3) * NWAVES + F.wave;
    const unsigned char* tab = (const unsigned char*)P_PV + (size_t)xs * 16384 * 128 + 16 * m;
    const bool b5 = lane & 32, b4 = lane & 16, b3 = lane & 8;
    bf16* yp = P_Y + 128 * xs + 16 * m + (b5 ? 8 : 0) + (b4 ? 4 : 0) + (b3 ? 2 : 0);
    const float* Wp = P_GATE; const bf16* IDXp = P_IDX;
    const int n = (NTOK - wv + nwv - 1) / nwv;
#define TOKK(k) (wv + ((k) < n ? (k) : n - 1) * nwv)
    v4u qa[16], qb[16];
    SlicePre pa = v_pre(Wp, IDXp, TOKK(0), g); slice_issue(tab, pa, qa);
    SlicePre pb = v_pre(Wp, IDXp, TOKK(1), g);
    for (int k = 0; k < n; k += 2) {
        slice_issue(tab, pb, qb);
        const SlicePre pc = v_pre(Wp, IDXp, TOKK(k + 2), g);
        v_compute(pa, qa, yp + (size_t)TOKK(k) * DM, b3);
        slice_issue(tab, pc, qa);
        const SlicePre pd = v_pre(Wp, IDXp, TOKK(k + 3), g);
        if (k + 1 < n) v_compute(pb, qb, yp + (size_t)TOKK(k + 1) * DM, b3);
        pa = pc; pb = pd;
    }
#undef TOKK
}
__device__ __forceinline__ void peer_slice_ln(const Args& A0, Frame& F0, int l) {
    LAUNDER();
    const int lane = F.lane;
    for (int tok = F.gw; tok < NTOK; tok += F.NGW) { const int b = tok >> 11; const float* mod = P_MOD + ((size_t)l * 32 + b) * MODW;
        const Row16 xr = ld_row(P_X + (size_t)tok * DM, lane), gt = ld_row(mod + 5120, lane);
        const v4u ya = *(const v4u*)(P_Y + (size_t)tok * DM + 8 * lane), yb = *(const v4u*)(P_Y + (size_t)tok * DM + 512 + 8 * lane);
        Row16 v;
        v.a0 = xr.a0 * DN_ALPHA + (f32x4){bflo(ya.x), bfhi(ya.x), bflo(ya.y), bfhi(ya.y)} * gt.a0; v.a1 = xr.a1 * DN_ALPHA + (f32x4){bflo(ya.z), bfhi(ya.z), bflo(ya.w), bfhi(ya.w)} * gt.a1;
        v.b0 = xr.b0 * DN_ALPHA + (f32x4){bflo(yb.x), bfhi(yb.x), bflo(yb.y), bfhi(yb.y)} * gt.b0; v.b1 = xr.b1 * DN_ALPHA + (f32x4){bflo(yb.z), bfhi(yb.z), bflo(yb.w), bfhi(yb.w)} * gt.b1;
        const Row16 xn = layer_norm_row(v, IN_ln_g + (size_t)(l * 2 + 1) * DM, IN_ln_b + (size_t)(l * 2 + 1) * DM, lane);
        st_row(P_X + (size_t)tok * DM, lane, xn);
        if (l + 1 < DEPTH) { const float* mod2 = P_MOD + ((size_t)(l + 1) * 32 + b) * MODW; const Row16 sh = ld_row(mod2, lane), sc = ld_row(mod2 + 1024, lane);
            st_row_bf16(P_HB + (size_t)tok * DM, lane, modulate(xn, sc, sh)); }
    }
}
#endif

#if PEER_KSLICE
constexpr int PH_L = 11;
#else
constexpr int PH_L = 8;
#endif
constexpr int NPHASE = 3 + PH_L * DEPTH;
__global__ void __launch_bounds__(NTHREADS, 2) trunk_fwd(Args args) {
    extern __shared__ __attribute__((aligned(16))) unsigned char lds[];
    Frame F;
    F.lds = (LAS unsigned char*)lds;
        F.tid = threadIdx.x; F.lane = F.tid & 63; F.wave = __builtin_amdgcn_readfirstlane(F.tid >> 6);
    F.G = gridDim.x; { const int bx = blockIdx.x; F.vcu = (F.G % 8 == 0) ? (bx % 8) * (F.G / 8) + bx / 8 : bx; }
    F.gw = F.vcu * NWAVES + F.wave; F.NGW = F.G * NWAVES;
    const Args& A0 = args; Frame& F0 = F;
    gu32* const ctl = (gu32*)(A0.ws + WS_CTL);
    for (int u = F.tid; u < (LDS_BYTES - LDSCTL_OFF) / 4; u += NTHREADS) ((LAS unsigned*)(F.lds + LDSCTL_OFF))[u] = 0u;
    __syncthreads();
    XcdBarrier bar; bar.bar = (unsigned*)(ctl + CW_BAR); bar.x = 0; bar.st = nullptr;
    if (!MK_PER_PHASE) bar = xcd_barrier_post((unsigned*)(ctl + CW_BAR), (volatile LAS unsigned*)(F.lds + MISC_OFF) + 8);
    const int lo = args.ph_lo, hi = args.ph_hi;
#define IN(k) (lo <= (k) && (k) < hi)
#define SEAM(k) do { if (IN(k) && IN((k) + 1)) { XcdBarrier b2 = bar; b2.bar = opq(b2.bar); xcd_barrier(b2); } } while (0)

    if (IN(0)) { phase_proA(A0, F0); } SEAM(0);
    if (IN(1)) { phase_proA2(A0, F0); } SEAM(1);
    if (IN(2)) { phase_proB(A0, F0); } SEAM(2);

    for (int l = 0; l < DEPTH; ++l) {
        const int pb = 3 + PH_L * l;
        for (int rep = 0; rep < ((PROBE_MASK & 1) ? 2 : 1); ++rep)
        if (IN(pb + 0)) { LAUNDER();
            pg8::Gemm g{P_HB, P_WIN + (size_t)l * INW * DM, NTOK, INW, DM}; pg8::StaticOrder S; S.init(NTOK, INW, F.G, (int)blockIdx.x);
            pg8::EpiInProj E{ws, P_LB + l * 512};
            pg8::gemm_phase<pg8::EpiInProj, pg8::StaticOrder, true, true>(F.lds, g, S, E);
        }
        SEAM(pb + 0);
        if (IN(pb + 1)) { hgrn_fast(A0, F0, l); attn_fast(A0, F0, l); }
        SEAM(pb + 1);
        for (int rep = 0; rep < ((PROBE_MASK & 8) ? 2 : 1); ++rep)
        if (IN(pb + 2)) {
            { LAUNDER(); pg8::Gemm g{P_OA, P_WUA + (size_t)l * DM * 512, NTOK, DM, 512}; pg8::StaticOrder S; S.init(NTOK, DM, F.G, (int)blockIdx.x);
              pg8::EpiGate<0> E{P_MERGED, P_GTA}; pg8::gemm_phase<pg8::EpiGate<0>, pg8::StaticOrder, true, true>(F.lds, g, S, E); }
            VM_WAIT(); __syncthreads();
            { LAUNDER(); pg8::Gemm g{P_OB, P_WUB + (size_t)l * DM * 512, NTOK, DM, 512}; pg8::StaticOrder S; S.init(NTOK, DM, F.G, (int)blockIdx.x);
              pg8::EpiGate<1> E{P_MERGED, P_GTB}; pg8::gemm_phase<pg8::EpiGate<1>, pg8::StaticOrder, true, true>(F.lds, g, S, E); }
        }
        SEAM(pb + 2);
        if (IN(pb + 3)) { LAUNDER();
            pg8::Gemm g{P_MERGED, P_WO + (size_t)l * DM * DM, NTOK, DM, DM}; pg8::StaticOrder S; S.init(NTOK, DM, F.G, (int)blockIdx.x);
            pg8::EpiWo E{l == 0 ? IN_x : (const float*)P_X, P_X, P_MOD + (size_t)l * 32 * MODW + 2048, DN_ALPHA};
            pg8::gemm_phase<pg8::EpiWo, pg8::StaticOrder, true, true>(F.lds, g, S, E);
        }
        SEAM(pb + 3);
        if (IN(pb + 4)) { phase_ln1(A0, F0, l); }
        SEAM(pb + 4);
        for (int rep = 0; rep < ((PROBE_MASK & 16) ? 2 : 1); ++rep)
        if (IN(pb + 5)) { LAUNDER();
            pg8::Gemm g{P_HB, P_WPQ + (size_t)l * DM * DM, NTOK, DM, DM}; pg8::StaticOrder S; S.init(NTOK, DM, F.G, (int)blockIdx.x);
            pg8::EpiGate<2> E{P_PQ, nullptr}; pg8::gemm_phase<pg8::EpiGate<2>, pg8::StaticOrder, true, true>(F.lds, g, S, E);
        }
        SEAM(pb + 5);
        if (IN(pb + 6)) { for (int rep = 0; rep < ((PROBE_MASK & 32) ? 2 : 1); ++rep) { if (FAST_TOPK) peer_topk_fast(A0, F0, l); else peer_topk_simple(A0, F0, l); __syncthreads(); } }
        SEAM(pb + 6);
#if PEER_KSLICE
        if (IN(pb + 7)) { peer_slice_u(A0, F0); }
        SEAM(pb + 7);
        if (IN(pb + 8)) { peer_slice_r(A0, F0); }
        SEAM(pb + 8);
        if (IN(pb + 9)) { peer_slice_v(A0, F0); }
        SEAM(pb + 9);
        if (IN(pb + 10)) { peer_slice_ln(A0, F0, l); }
        SEAM(pb + 10);
#else
        if (IN(pb + 7)) { phase_peer_expert(A0, F0, l); }
        SEAM(pb + 7);
#endif
    }
#undef IN
#undef SEAM
}

extern "C" void kernel_launch(void* const* d_in, const int* in_sizes, int n_in, void* d_out, int out_size, void* d_ws, size_t ws_size, hipStream_t stream) {
    static int grid = 0;
    if (grid == 0) {
        if (n_in != 16 || out_size != NTOK * DM || ws_size < WS_END) { fprintf(stderr, "kernel_launch: unexpected shapes (n_in %d, out %d, ws %zu)\n", n_in, out_size, ws_size); grid = -1; return; }
        int dev = 0, cus = 0, per_cu = 0;
        if (hipGetDevice(&dev) != hipSuccess || hipDeviceGetAttribute(&cus, hipDeviceAttributeMultiprocessorCount, dev) != hipSuccess) { grid = -1; return; }
        if (hipFuncSetAttribute((const void*)trunk_fwd, hipFuncAttributeMaxDynamicSharedMemorySize, LDS_BYTES) != hipSuccess) { fprintf(stderr, "kernel_launch: hipFuncSetAttribute failed\n"); grid = -1; return; }
        if (hipOccupancyMaxActiveBlocksPerMultiprocessor(&per_cu, (const void*)trunk_fwd, NTHREADS, LDS_BYTES) != hipSuccess || per_cu < 1) { fprintf(stderr, "kernel_launch: occupancy query says %d\n", per_cu); }
        (void)hipGetLastError();
        grid = cus;
    }
    if (grid < 0) return;
    if (hipMemsetAsync((char*)d_ws + WS_CTL, 0, CTL_ZERO_BYTES, stream) != hipSuccess) return;
    Args a{};
    for (int i = 0; i < 16; ++i) a.in[i] = (const float*)d_in[i];
    a.out = (float*)d_out; a.ws = (unsigned char*)d_ws;
#if MK_PER_PHASE
    for (int k = 0; k < NPHASE; ++k) { a.ph_lo = k; a.ph_hi = k + 1; hipLaunchKernelGGL(trunk_fwd, dim3(grid), dim3(NTHREADS), LDS_BYTES, stream, a); }
#else
    a.ph_lo = 0; a.ph_hi = NPHASE;
    hipLaunchKernelGGL(trunk_fwd, dim3(grid), dim3(NTHREADS), LDS_BYTES, stream, a);
#endif
    const hipError_t le = hipPeekAtLastError();
    if (le != hipSuccess) fprintf(stderr, "kernel_launch: launch failed: %s\n", hipGetErrorName(le));
}
```

```cpp
#include <hip/hip_runtime.h>
#include <cstdio>
#include <cstdint>

#ifndef MK_PER_PHASE
#define MK_PER_PHASE 0
#endif

#ifndef PROBE_MASK
#define PROBE_MASK 0
#endif

#ifndef FAST_ATTN
#define FAST_ATTN 1
#endif
#ifndef FAST_TOPK
#define FAST_TOPK 1
#endif
#ifndef FAST_HGRN
#define FAST_HGRN 1
#endif

#ifndef PEER_FP8
#define PEER_FP8 1
#endif

#ifndef PEER_KSLICE
#define PEER_KSLICE 1
#endif

#ifndef GEMM_STAGGER
#define GEMM_STAGGER 0
#endif

#ifndef HGRN_WS
#define HGRN_WS 0
#endif

#ifndef U_MFMA
#define U_MFMA 0
#endif

#ifndef U_INT8
#define PEER_Q4 1
#define U_INT8 1
#endif

#ifndef HGRN_PIPE
#define HGRN_PIPE 0
#endif

namespace pg8 {
#define PG8_LAS __attribute__((address_space(3)))
typedef unsigned short bf16_t;
typedef short bf16x8 __attribute__((ext_vector_type(8)));
typedef float f32x4 __attribute__((ext_vector_type(4)));
typedef unsigned u32x4 __attribute__((ext_vector_type(4)));
constexpr int BM = 256, BK = 64, HALF = 128, HTB = HALF * BK * 2  , STAGE_BYTES = 8 * HTB, NXCD = 8, WGM = 8;

__host__ __device__ __forceinline__ int lds_byte(int r, int c) { const int st = (r >> 4) * 2 + (c >> 5), rr = r & 15, cc = c & 31, ob = rr * 64 + cc * 2; return st * 1024 + (ob ^ (((ob >> 9) & 1) << 5)); }
__host__ __device__ __forceinline__ void stage_rc(int b, int& R, int& C) { const int st = b / 1024, sb = b % 1024, swz = sb ^ (((sb >> 9) & 1) << 5); R = (st >> 1) * 16 + swz / 64; C = (st & 1) * 32 + (swz % 64) / 2; }
__host__ __device__ __forceinline__ int perm32(int rho) { const int n = rho >> 4, i = rho & 15; return 8 * (i >> 2) + 4 * n + (i & 3); }

struct Unit { int pm, pn, seg; };
struct Gemm { const bf16_t* A; const bf16_t* Bt; int M, N, K; const bf16_t* A2; const bf16_t* Bt2; };

struct StaticOrder {
    int nM, nN, nwg, G, c;
    __host__ __device__ void init(int M, int N, int G_, int c_) { nM = M / BM; nN = N / BM; nwg = nM * nN; G = G_; c = c_; }
    __host__ __device__ bool next(int i, Unit& u) const {
        const long L = (long)i * G + c; if (L >= nwg) return false;
        int wgid = (int)L; { const int q = nwg / NXCD, r = nwg % NXCD, xcd = wgid % NXCD, off = wgid / NXCD; wgid = (xcd < r ? xcd * (q + 1) : r * (q + 1) + (xcd - r) * q) + off; }
        const int nig = WGM * nN, gid = wgid / nig, fm = gid * WGM, gsz = (nM - fm) < WGM ? (nM - fm) : WGM;
        u.pm = fm + ((wgid % nig) % gsz); u.pn = (wgid % nig) / gsz; u.seg = 0; return true;
    }
    __device__ __forceinline__ void a_ready(const Unit&) const {}
    __device__ __forceinline__ void done(const Unit&) const {}
};
struct InProjOrder : StaticOrder {
    __host__ __device__ bool next(int i, Unit& u) const { if (!StaticOrder::next(i, u)) return false; const int s = u.pn; u.pn = s < 16 ? ((s & 1) ? 14 + (s >> 1) : (s >> 1)) : s - 8; return true; }
};
struct SegOrder : StaticOrder {
    __host__ __device__ bool next(int i, Unit& u) const { if (!StaticOrder::next(i >> 1, u)) return false; u.seg = i & 1; return true; }
};

__device__ __forceinline__ unsigned cvt_pk_bf16(float lo, float hi) { unsigned r; asm volatile("v_cvt_pk_bf16_f32 %0, %1, %2" : "=v"(r) : "v"(lo), "v"(hi)); return r; }
__device__ __forceinline__ u32x4 pack8(f32x4 v0, f32x4 v1) { u32x4 w; w.x = cvt_pk_bf16(v0[0], v0[1]); w.y = cvt_pk_bf16(v0[2], v0[3]); w.z = cvt_pk_bf16(v1[0], v1[1]); w.w = cvt_pk_bf16(v1[2], v1[3]); return w; }
__device__ __forceinline__ float bf_lo(unsigned w) { return __uint_as_float(w << 16); }
__device__ __forceinline__ float bf_hi(unsigned w) { return __uint_as_float(w & 0xffff0000u); }
__device__ __forceinline__ void unpack8(u32x4 w, f32x4& a, f32x4& b) { a = (f32x4){bf_lo(w.x), bf_hi(w.x), bf_lo(w.y), bf_hi(w.y)}; b = (f32x4){bf_lo(w.z), bf_hi(w.z), bf_lo(w.w), bf_hi(w.w)}; }
__device__ __forceinline__ float sigm(float z) { return __builtin_amdgcn_rcpf(1.0f + __builtin_amdgcn_exp2f(z * -1.4426950408889634f)); }

__device__ __forceinline__ unsigned q8x4(f32x4 s) {
    const unsigned a = __float_as_uint(fmaxf(s[0] * 255.0f, 1.0f) + 8388608.0f), b = __float_as_uint(fmaxf(s[1] * 255.0f, 1.0f) + 8388608.0f),
                   c = __float_as_uint(fmaxf(s[2] * 255.0f, 1.0f) + 8388608.0f), d2 = __float_as_uint(fmaxf(s[3] * 255.0f, 1.0f) + 8388608.0f);
    const unsigned lo = __builtin_amdgcn_perm(b, a, 0x0c0c0400u), hi = __builtin_amdgcn_perm(d2, c, 0x04000c0cu);
    return lo | hi; }
__device__ __forceinline__ unsigned q8x4s(f32x4 s255) {
    const unsigned a = __float_as_uint(fmaxf(s255[0], 1.0f) + 8388608.0f), b = __float_as_uint(fmaxf(s255[1], 1.0f) + 8388608.0f), c = __float_as_uint(fmaxf(s255[2], 1.0f) + 8388608.0f), d2 = __float_as_uint(fmaxf(s255[3], 1.0f) + 8388608.0f);
    return __builtin_amdgcn_perm(b, a, 0x0c0c0400u) | __builtin_amdgcn_perm(d2, c, 0x04000c0cu); }
__device__ __forceinline__ f32x4 uq8x4raw(unsigned w) { return (f32x4){(float)(w & 0xffu), (float)((w >> 8) & 0xffu), (float)((w >> 16) & 0xffu), (float)(w >> 24)}; }
__device__ __forceinline__ f32x4 uq8x4(unsigned w) { return (f32x4){(float)(w & 0xffu), (float)((w >> 8) & 0xffu), (float)((w >> 16) & 0xffu), (float)(w >> 24)} * (1.0f / 255.0f); }
struct EpiInProj {
    static constexpr bool PERM = true, AFTER_DRAIN = false, IDEM = true, SEG = false;
    unsigned char* ws; const float* lb;
    static constexpr size_t M_ = 1u << 20, oQA = 202 * M_, oGLOG = 266 * M_, oKK = 330 * M_, oIA = 394 * M_, oGA = 458 * M_, oQB = 522 * M_, oKB = 586 * M_, oVT = 650 * M_, oGTA = 714 * M_, oGTB = 842 * M_;
    __device__ __forceinline__ void operator()(const f32x4 (&acc)[2][2][4][2], const Unit& u, int wr, int wc, int fr, int fq) const {
        const int pn = u.pn, row0 = u.pm * BM + wr * 64 + fr, cl0 = wc * 32 + 8 * fq;
        if (pn < 2 || (pn >= 4 && pn < 8)) {
            bf16_t* base = (bf16_t*)(ws + (pn < 2 ? oQA : (pn < 6 ? oIA : oGA))); const int cb = (pn & 1) * 256 + cl0; const bool act = pn >= 6;
#pragma unroll
            for (int ai = 0; ai < 2; ++ai)
#pragma unroll
                for (int m = 0; m < 4; ++m) { bf16_t* rowp = base + (size_t)(row0 + ai * HALF + m * 16) * 512 + cb;
#pragma unroll
                    for (int bj = 0; bj < 2; ++bj) { f32x4 v0 = acc[ai][bj][m][0], v1 = acc[ai][bj][m][1];
                        if (act) {
#pragma unroll
                            for (int j = 0; j < 4; ++j) { v0[j] = v0[j] * sigm(v0[j]); v1[j] = v1[j] * sigm(v1[j]); } }
                        *(u32x4*)(rowp + bj * HALF) = pack8(v0, v1); } }
        } else if (pn < 4) {
            const int cb = (pn - 2) * 256 + cl0; f32x4 l0[2], l1[2];
#pragma unroll
            for (int bj = 0; bj < 2; ++bj) { l0[bj] = *(const f32x4*)(lb + cb + bj * HALF); l1[bj] = *(const f32x4*)(lb + cb + bj * HALF + 4); }
#pragma unroll
            for (int ai = 0; ai < 2; ++ai)
#pragma unroll
                for (int m = 0; m < 4; ++m) { const size_t ro = (size_t)(row0 + ai * HALF + m * 16) * 512 + cb;
#pragma unroll
                    for (int bj = 0; bj < 2; ++bj) { f32x4 z0 = acc[ai][bj][m][0], z1 = acc[ai][bj][m][1], g0, g1;
#pragma unroll
                        for (int j = 0; j < 4; ++j) {
                            { const float z = fminf(fmaxf(z0[j], -30.f), 30.f), lbv = l0[bj][j], s = __builtin_amdgcn_rcpf(1.0f + __builtin_amdgcn_exp2f(z * -1.4426950408889634f)); g0[j] = __builtin_amdgcn_logf(lbv + (1.0f - lbv) * s) * 0.6931471805599453f; }
                            { const float z = fminf(fmaxf(z1[j], -30.f), 30.f), lbv = l1[bj][j], s = __builtin_amdgcn_rcpf(1.0f + __builtin_amdgcn_exp2f(z * -1.4426950408889634f)); g1[j] = __builtin_amdgcn_logf(lbv + (1.0f - lbv) * s) * 0.6931471805599453f; } }
                        *(u32x4*)((bf16_t*)(ws + oGLOG) + ro + bj * HALF) = pack8(g0, g1); } }
        } else if (pn < 12) {
            bf16_t* base = (bf16_t*)(ws + (pn < 10 ? oQB : oKB));
#pragma unroll
            for (int ai = 0; ai < 2; ++ai)
#pragma unroll
                for (int m = 0; m < 4; ++m) { const int row = row0 + ai * HALF + m * 16, b = row >> 11, t = row & 2047;
#pragma unroll
                    for (int bj = 0; bj < 2; ++bj) { const int c = (pn & 1) * 256 + bj * HALF + cl0, h = c >> 6, d = c & 63;
                        *(u32x4*)(base + ((((size_t)(b * 8 + h) * 64 + (t >> 5)) * 4 + (d >> 4)) * 64 + ((t & 31) + 32 * ((d >> 3) & 1))) * 8) = pack8(acc[ai][bj][m][0], acc[ai][bj][m][1]); } }
        } else if (pn < 14) {
#pragma unroll
            for (int ai = 0; ai < 2; ++ai)
#pragma unroll
                for (int m = 0; m < 4; ++m) { const int row = row0 + ai * HALF + m * 16, b = row >> 11, t = row & 2047;
#pragma unroll
                    for (int bj = 0; bj < 2; ++bj) { const int c = (pn & 1) * 256 + bj * HALF + cl0, h = c >> 6, d = c & 63; const u32x4 w = pack8(acc[ai][bj][m][0], acc[ai][bj][m][1]);
                        bf16_t* p = (bf16_t*)(ws + oVT) + (((((size_t)(b * 8 + h) * 64 + (t >> 5)) * 2 + (d >> 5)) * 2 + ((t >> 4) & 1)) * 64 + ((d & 31) + 32 * (((t & 15) >> 2) & 1))) * 8 + (4 * ((t & 15) >> 3) + (t & 3));
                        p[0] = (bf16_t)(w.x & 0xffffu); p[8] = (bf16_t)(w.x >> 16); p[16] = (bf16_t)(w.y & 0xffffu); p[24] = (bf16_t)(w.y >> 16);
                        p[32] = (bf16_t)(w.z & 0xffffu); p[40] = (bf16_t)(w.z >> 16); p[48] = (bf16_t)(w.w & 0xffffu); p[56] = (bf16_t)(w.w >> 16); } }
        } else {
            int lz = fq * 16 + fr; asm volatile("" : "+v"(lz));
            unsigned char* base = ws + (pn < 18 ? oGTA : oGTB) + (((size_t)(u.pm * 4 + ((pn - 14) & 3)) * 8 + (wr * 4 + wc)) * 8) * 1024 + lz * 16;
#pragma unroll
            for (int ai = 0; ai < 2; ++ai)
#pragma unroll
                for (int m = 0; m < 4; ++m) { u32x4 w;
#pragma unroll
                    for (int bj = 0; bj < 2; ++bj) { f32x4 v0 = acc[ai][bj][m][0], v1 = acc[ai][bj][m][1];
#pragma unroll
                        for (int j = 0; j < 4; ++j) { v0[j] = __builtin_amdgcn_rcpf(__builtin_fmaf(__builtin_amdgcn_exp2f(v0[j]), 1.0f / 255.0f, 1.0f / 255.0f)); v1[j] = __builtin_amdgcn_rcpf(__builtin_fmaf(__builtin_amdgcn_exp2f(v1[j]), 1.0f / 255.0f, 1.0f / 255.0f)); }
                        if (bj == 0) { w.x = q8x4s(v0); w.y = q8x4s(v1); } else { w.z = q8x4s(v0); w.w = q8x4s(v1); } }
                    *(u32x4*)(base + (ai * 4 + m) * 1024) = w; }
        }
    }
};
template <int MODE> struct EpiGate {
    static constexpr bool PERM = true, AFTER_DRAIN = false, IDEM = (MODE != 1), SEG = false;
    bf16_t* O; const bf16_t* G;
    __device__ __forceinline__ void operator()(const f32x4 (&acc)[2][2][4][2], const Unit& u, int wr, int wc, int fr, int fq) const {
        const int row0 = u.pm * BM + wr * 64 + fr, col0 = u.pn * BM + wc * 32 + 8 * fq;
#pragma unroll
        for (int ai = 0; ai < 2; ++ai)
#pragma unroll
            for (int m = 0; m < 4; ++m) { const size_t ro = (size_t)(row0 + ai * HALF + m * 16) * 1024 + col0;
#pragma unroll
                for (int bj = 0; bj < 2; ++bj) { f32x4 v0 = acc[ai][bj][m][0], v1 = acc[ai][bj][m][1];
                    if (MODE != 2) { f32x4 g0, g1; unpack8(*(const u32x4*)(G + ro + bj * HALF), g0, g1); v0 = v0 * g0; v1 = v1 * g1; }
                    if (MODE == 1) { f32x4 o0, o1; unpack8(*(const u32x4*)(O + ro + bj * HALF), o0, o1); v0 = v0 + o0; v1 = v1 + o1; }
                    *(u32x4*)(O + ro + bj * HALF) = pack8(v0, v1); } }
    }
};
struct EpiWo {
    static constexpr bool PERM = true, AFTER_DRAIN = false, IDEM = true, SEG = false;
    const float* RES32; const bf16_t* RES16; bf16_t* T; const float* gt;
    float alpha;
    __device__ __forceinline__ void operator()(const f32x4 (&acc)[2][2][4][2], const Unit& u, int wr, int wc, int fr, int fq) const {
        const int row0 = u.pm * BM + wr * 64 + fr, col0 = u.pn * BM + wc * 32 + 8 * fq;
        const int b = (u.pm * BM) >> 11;
        f32x4 gv[2][2];
#pragma unroll
        for (int bj = 0; bj < 2; ++bj)
#pragma unroll
            for (int n = 0; n < 2; ++n) gv[bj][n] = *(const f32x4*)(gt + (size_t)b * 6144 + col0 + bj * HALF + 4 * n);
        if (RES32) {
#pragma unroll
            for (int ai = 0; ai < 2; ++ai)
#pragma unroll
                for (int mh = 0; mh < 2; ++mh) { f32x4 rr[2][2][2];
#pragma unroll
                    for (int m = 0; m < 2; ++m) { const size_t ro = (size_t)(row0 + ai * HALF + (mh * 2 + m) * 16) * 1024 + col0;
#pragma unroll
                        for (int bj = 0; bj < 2; ++bj) { rr[m][bj][0] = *(const f32x4*)(RES32 + ro + bj * HALF); rr[m][bj][1] = *(const f32x4*)(RES32 + ro + bj * HALF + 4); } }
                    __builtin_amdgcn_sched_barrier(0);
#pragma unroll
                    for (int m = 0; m < 2; ++m) { const size_t ro = (size_t)(row0 + ai * HALF + (mh * 2 + m) * 16) * 1024 + col0;
#pragma unroll
                        for (int bj = 0; bj < 2; ++bj) *(u32x4*)(T + ro + bj * HALF) = pack8(rr[m][bj][0] * alpha + acc[ai][bj][mh * 2 + m][0] * gv[bj][0], rr[m][bj][1] * alpha + acc[ai][bj][mh * 2 + m][1] * gv[bj][1]); }
                    __builtin_amdgcn_sched_barrier(0); }
        } else {
            u32x4 rw[4][2], pk[4][2];
#pragma unroll
            for (int m = 0; m < 4; ++m) { const size_t ro = (size_t)(row0 + m * 16) * 1024 + col0;
#pragma unroll
                for (int bj = 0; bj < 2; ++bj) rw[m][bj] = *(const u32x4*)(RES16 + ro + bj * HALF); }
            __builtin_amdgcn_sched_barrier(0);
#pragma unroll
            for (int m = 0; m < 4; ++m)
#pragma unroll
                for (int bj = 0; bj < 2; ++bj) { f32x4 r0, r1; unpack8(rw[m][bj], r0, r1); pk[m][bj] = pack8(r0 * alpha + acc[0][bj][m][0] * gv[bj][0], r1 * alpha + acc[0][bj][m][1] * gv[bj][1]); }
            __builtin_amdgcn_sched_barrier(0);
#pragma unroll
            for (int m = 0; m < 4; ++m) { const size_t ro = (size_t)(row0 + HALF + m * 16) * 1024 + col0;
#pragma unroll
                for (int bj = 0; bj < 2; ++bj) rw[m][bj] = *(const u32x4*)(RES16 + ro + bj * HALF); }
            __builtin_amdgcn_sched_barrier(0);
#pragma unroll
            for (int m = 0; m < 4; ++m) { const size_t ro = (size_t)(row0 + m * 16) * 1024 + col0;
#pragma unroll
                for (int bj = 0; bj < 2; ++bj) *(u32x4*)(T + ro + bj * HALF) = pk[m][bj]; }
            __builtin_amdgcn_sched_barrier(0);
#pragma unroll
            for (int m = 0; m < 4; ++m) { const size_t ro = (size_t)(row0 + HALF + m * 16) * 1024 + col0;
#pragma unroll
                for (int bj = 0; bj < 2; ++bj) { f32x4 r0, r1; unpack8(rw[m][bj], r0, r1);
                    *(u32x4*)(T + ro + bj * HALF) = pack8(r0 * alpha + acc[1][bj][m][0] * gv[bj][0], r1 * alpha + acc[1][bj][m][1] * gv[bj][1]); } }
        }
    }
};
struct EpiUp2 {
    static constexpr bool PERM = true, AFTER_DRAIN = false, IDEM = true, SEG = true;
    bf16_t* O; const unsigned char* GA_; const unsigned char* GB_;
    typedef unsigned u32x2e __attribute__((ext_vector_type(2)));
    __device__ __forceinline__ void mid(f32x4 (&acc)[2][2][4][2], const Unit& u, int wr, int wc, int fr, int fq) const {
        const size_t go = (((size_t)(u.pm * 4 + u.pn) * 8 + (wr * 4 + wc)) * 8) * 1024 + (fq * 16 + fr) * 16;
#pragma unroll
        for (int ai = 0; ai < 2; ++ai) { u32x2e ga[4][2], gb[4][2];
#pragma unroll
            for (int m = 0; m < 4; ++m) { const u32x4 wa = *(const u32x4*)(GA_ + go + (ai * 4 + m) * 1024), wb = *(const u32x4*)(GB_ + go + (ai * 4 + m) * 1024);
                ga[m][0] = (u32x2e){wa.x, wa.y}; ga[m][1] = (u32x2e){wa.z, wa.w}; gb[m][0] = (u32x2e){wb.x, wb.y}; gb[m][1] = (u32x2e){wb.z, wb.w}; }
            __builtin_amdgcn_sched_barrier(0);
#pragma unroll
            for (int m = 0; m < 4; ++m)
#pragma unroll
                for (int bj = 0; bj < 2; ++bj) { const f32x4 a0 = uq8x4raw(ga[m][bj].x), a1 = uq8x4raw(ga[m][bj].y), b0 = uq8x4raw(gb[m][bj].x), b1 = uq8x4raw(gb[m][bj].y);
#pragma unroll
                    for (int j = 0; j < 4; ++j) { acc[ai][bj][m][0][j] *= a0[j] * __builtin_amdgcn_rcpf(b0[j]); acc[ai][bj][m][1][j] *= a1[j] * __builtin_amdgcn_rcpf(b1[j]); } }
            __builtin_amdgcn_sched_barrier(0); }
    }
    __device__ __forceinline__ void operator()(const f32x4 (&acc)[2][2][4][2], const Unit& u, int wr, int wc, int fr, int fq) const {
        const int row0 = u.pm * BM + wr * 64 + fr, col0 = u.pn * BM + wc * 32 + 8 * fq;
        const size_t go = (((size_t)(u.pm * 4 + u.pn) * 8 + (wr * 4 + wc)) * 8) * 1024 + (fq * 16 + fr) * 16;
        u32x2e gb[2][4][2];
#pragma unroll
        for (int ai = 0; ai < 2; ++ai)
#pragma unroll
            for (int m = 0; m < 4; ++m) { const u32x4 wb = *(const u32x4*)(GB_ + go + (ai * 4 + m) * 1024); gb[ai][m][0] = (u32x2e){wb.x, wb.y}; gb[ai][m][1] = (u32x2e){wb.z, wb.w}; }
        __builtin_amdgcn_sched_barrier(0);
#pragma unroll
        for (int ai = 0; ai < 2; ++ai)
#pragma unroll
            for (int m = 0; m < 4; ++m) { const size_t ro = (size_t)(row0 + ai * HALF + m * 16) * 1024 + col0;
#pragma unroll
                for (int bj = 0; bj < 2; ++bj) { const f32x4 b0 = uq8x4(gb[ai][m][bj].x), b1 = uq8x4(gb[ai][m][bj].y);
                    *(u32x4*)(O + ro + bj * HALF) = pack8(acc[ai][bj][m][0] * b0, acc[ai][bj][m][1] * b1); } }
    }
};
struct EpiProbeK2 {
    static constexpr bool PERM = true, AFTER_DRAIN = false, IDEM = true, SEG = true;
    bf16_t* O;
    __device__ __forceinline__ void mid(f32x4 (&acc)[2][2][4][2], const Unit&, int, int, int, int) const {}
    __device__ __forceinline__ void operator()(const f32x4 (&acc)[2][2][4][2], const Unit& u, int wr, int wc, int fr, int fq) const {
        const int row0 = u.pm * BM + wr * 64 + fr, col0 = u.pn * BM + wc * 32 + 8 * fq;
#pragma unroll
        for (int ai = 0; ai < 2; ++ai)
#pragma unroll
            for (int m = 0; m < 4; ++m) { const size_t ro = (size_t)(row0 + ai * HALF + m * 16) * 1024 + col0;
#pragma unroll
                for (int bj = 0; bj < 2; ++bj) *(u32x4*)(O + ro + bj * HALF) = pack8(acc[ai][bj][m][0] * 0.5f, acc[ai][bj][m][1] * 0.5f); }
    }
};


struct EpiPQ {
    static constexpr bool PERM = true, AFTER_DRAIN = false, IDEM = true, SEG = false;
    bf16_t* O;
    __device__ __forceinline__ void operator()(const f32x4 (&acc)[2][2][4][2], const Unit& u, int wr, int wc, int fr, int fq) const {
        const int row0 = u.pm * BM + wr * 64 + fr, col0 = u.pn * BM + wc * 32 + 8 * fq;
#pragma unroll
        for (int ai = 0; ai < 2; ++ai)
#pragma unroll
            for (int m = 0; m < 4; ++m) { const int r = row0 + ai * HALF + m * 16;
#pragma unroll
                for (int bj = 0; bj < 2; ++bj) { const int c = col0 + bj * HALF;
                    *(u32x4*)(O + ((((size_t)((r >> 5) * 8 + (c >> 7)) * 2 + ((c >> 6) & 1)) * 4 + ((c & 63) >> 4)) * 64 + ((r & 31) + 32 * ((c >> 3) & 1))) * 8) = pack8(acc[ai][bj][m][0], acc[ai][bj][m][1]); } }
    }
};

template <class Epi, class Sched, bool ALIGN_EPI = false, bool SP2 = false>
__device__ __forceinline__ void gemm_phase(PG8_LAS unsigned char* lds, const Gemm g, const Sched& S, const Epi& E, int tid_) {
    asm volatile("" : "+v"(tid_)); const int tid = tid_, wid = __builtin_amdgcn_readfirstlane(tid >> 6), lane = tid & 63, wr = wid >> 2, wc = wid & 3, fr = lane & 15, fq = lane >> 4;
    const int K = g.K, nt = K / BK;
    unsigned voffA[2], voffB[2];
#pragma unroll
    for (int i = 0; i < 2; ++i) { int R, C; stage_rc(tid * 16 + i * 8192, R, C); const int Rb = Epi::PERM ? ((R & ~31) + perm32(R & 31)) : R;
        voffA[i] = (unsigned)(R * K + C) * 2u; voffB[i] = (unsigned)(Rb * K + C) * 2u; }
    const size_t kstep = (size_t)(BK * 2);
    const size_t hstep = (size_t)HALF * K * 2;
    const size_t tstep = 2 * hstep;
    const unsigned ldsw = (unsigned)wid * 1024u;
    const int aoff = lds_byte(wr * 64 + fr, fq * 8), boff = lds_byte(wc * 32 + fr, fq * 8);
#define PG8_SA(b, h) (((b) * 2 + (h)) * HTB)
#define PG8_SB(b, h) ((4 + (b) * 2 + (h)) * HTB)
#define PG8_STAGE(bufoff, gbase, voff) do { _Pragma("unroll") for (int _i = 0; _i < 2; ++_i) \
        __builtin_amdgcn_global_load_lds((const unsigned*)((const char*)(gbase) + (voff)[_i]), (PG8_LAS unsigned*)(lds + (bufoff) + ldsw + _i * 8192), 16, 0, 0); } while (0)
#define PG8_LDA(dst, b, h) do { _Pragma("unroll") for (int m = 0; m < 4; ++m) _Pragma("unroll") for (int k = 0; k < 2; ++k) dst[m][k] = *(const PG8_LAS bf16x8*)(lds + PG8_SA(b, h) + aoff + m * 2048 + k * 1024); } while (0)
#define PG8_LDB(dst, b, h) do { _Pragma("unroll") for (int n = 0; n < 2; ++n) _Pragma("unroll") for (int k = 0; k < 2; ++k) dst[n][k] = *(const PG8_LAS bf16x8*)(lds + PG8_SB(b, h) + boff + n * 2048 + k * 1024); } while (0)
#define PG8_MMA(ai, bj, At, Bt) do { __builtin_amdgcn_s_setprio(1); _Pragma("unroll") for (int m = 0; m < 4; ++m) _Pragma("unroll") for (int n = 0; n < 2; ++n) _Pragma("unroll") for (int k = 0; k < 2; ++k) \
        acc[ai][bj][m][n] = __builtin_amdgcn_mfma_f32_16x16x32_bf16(Bt[n][k], At[m][k], acc[ai][bj][m][n], 0, 0, 0); __builtin_amdgcn_s_setprio(0); } while (0)
#define PG8_WAIT_V(n) asm volatile("s_waitcnt vmcnt(" #n ")" ::: "memory")
#define PG8_WAIT_L(n) asm volatile("s_waitcnt lgkmcnt(" #n ")" ::: "memory")
#define PG8_BAR __builtin_amdgcn_s_barrier()
#define PG8_SCHED __builtin_amdgcn_sched_barrier(0)
    Unit cur, nxt; int ui = 0;
    if (!S.next(0, cur)) return;
    f32x4 acc[2][2][4][2];
#pragma unroll
    for (int a = 0; a < 2; ++a)
#pragma unroll
        for (int b = 0; b < 2; ++b)
#pragma unroll
            for (int m = 0; m < 4; ++m)
#pragma unroll
                for (int n = 0; n < 2; ++n) acc[a][b][m][n] = (f32x4){0.f, 0.f, 0.f, 0.f};
    bf16x8 At[4][2], B0[2][2], B1[2][2];
    const char* cA = (const char*)(cur.seg ? g.A2 : g.A) + (size_t)cur.pm * tstep; const char* cB = (const char*)(cur.seg ? g.Bt2 : g.Bt) + (size_t)cur.pn * tstep;
    S.a_ready(cur);
    if constexpr (SP2) {
        PG8_STAGE(PG8_SB(0, 0), cB, voffB); PG8_STAGE(PG8_SB(0, 1), cB + hstep, voffB); PG8_STAGE(PG8_SA(0, 0), cA, voffA); PG8_STAGE(PG8_SA(0, 1), cA + hstep, voffA);
        if (wr == 1) PG8_BAR;
        PG8_WAIT_V(2); PG8_BAR;
        PG8_STAGE(PG8_SB(1, 0), cB + kstep, voffB); PG8_STAGE(PG8_SA(1, 0), cA + kstep, voffA); PG8_STAGE(PG8_SB(1, 1), cB + hstep + kstep, voffB);
        PG8_WAIT_V(6); PG8_BAR;
    } else {
        PG8_STAGE(PG8_SB(0, 0), cB, voffB); PG8_STAGE(PG8_SA(0, 0), cA, voffA); PG8_STAGE(PG8_SB(0, 1), cB + hstep, voffB); PG8_STAGE(PG8_SA(0, 1), cA + hstep, voffA);
        if (wr == 1) PG8_BAR;
        PG8_WAIT_V(4); PG8_BAR;
        PG8_STAGE(PG8_SB(1, 0), cB + kstep, voffB); PG8_STAGE(PG8_SA(1, 0), cA + kstep, voffA); PG8_STAGE(PG8_SB(1, 1), cB + hstep + kstep, voffB);
        PG8_WAIT_V(6); PG8_BAR;
    }
    for (;;) {
        const bool has_next = S.next(ui + 1, nxt);
        const char* nA = has_next ? (const char*)(nxt.seg ? g.A2 : g.A) + (size_t)nxt.pm * tstep : cA; const char* nB = has_next ? (const char*)(nxt.seg ? g.Bt2 : g.Bt) + (size_t)nxt.pn * tstep : cB;
        for (int t = 0; t < nt; t += 2) {
            const bool last = (t == nt - 2);
            const char* a1 = cA + (size_t)(t + 1) * kstep;
            const char* a2 = last ? nA : cA + (size_t)(t + 2) * kstep; const char* b2 = last ? nB : cB + (size_t)(t + 2) * kstep;
            const char* a3 = a2 + kstep; const char* b3 = b2 + kstep;
            if (last && has_next) S.a_ready(nxt);
            if constexpr (SP2) {
            PG8_LDB(B0, 0, 0); PG8_LDB(B1, 0, 1); PG8_SCHED; PG8_LDA(At, 0, 0); PG8_STAGE(PG8_SA(1, 1), a1 + hstep, voffA);
            PG8_WAIT_V(8); PG8_WAIT_L(0); PG8_BAR; PG8_MMA(0, 0, At, B0); PG8_MMA(0, 1, At, B1); PG8_BAR; PG8_SCHED;
            PG8_LDA(At, 0, 1); PG8_STAGE(PG8_SB(0, 0), b2, voffB); PG8_STAGE(PG8_SB(0, 1), b2 + hstep, voffB); PG8_STAGE(PG8_SA(0, 0), a2, voffA);
            PG8_WAIT_V(8); PG8_WAIT_L(0); PG8_BAR; PG8_MMA(1, 0, At, B0); PG8_MMA(1, 1, At, B1); PG8_BAR; PG8_SCHED;
            PG8_LDB(B0, 1, 0); PG8_LDB(B1, 1, 1); PG8_SCHED; PG8_LDA(At, 1, 0); PG8_STAGE(PG8_SA(0, 1), a2 + hstep, voffA);
            PG8_WAIT_V(8); PG8_WAIT_L(0); PG8_BAR; PG8_MMA(0, 0, At, B0); PG8_MMA(0, 1, At, B1); PG8_BAR; PG8_SCHED;
            PG8_LDA(At, 1, 1); PG8_STAGE(PG8_SB(1, 0), b3, voffB); PG8_STAGE(PG8_SB(1, 1), b3 + hstep, voffB); PG8_STAGE(PG8_SA(1, 0), a3, voffA);
            PG8_WAIT_V(8); PG8_WAIT_L(0); PG8_BAR; PG8_MMA(1, 0, At, B0); PG8_MMA(1, 1, At, B1); PG8_BAR; PG8_SCHED;
            } else {
            PG8_LDB(B0, 0, 0); PG8_SCHED; PG8_LDA(At, 0, 0); PG8_STAGE(PG8_SA(1, 1), a1 + hstep, voffA);
            PG8_WAIT_L(8); PG8_BAR; PG8_WAIT_L(0); PG8_MMA(0, 0, At, B0); PG8_BAR; PG8_SCHED;
            PG8_LDB(B1, 0, 1); PG8_STAGE(PG8_SB(0, 0), b2, voffB);
            PG8_BAR; PG8_WAIT_L(0); PG8_MMA(0, 1, At, B1); PG8_BAR;
            PG8_LDA(At, 0, 1); PG8_STAGE(PG8_SA(0, 0), a2, voffA);
            PG8_BAR; PG8_WAIT_L(0); PG8_MMA(1, 0, At, B0); PG8_BAR; PG8_SCHED;
            PG8_STAGE(PG8_SB(0, 1), b2 + hstep, voffB);
            PG8_WAIT_V(6); PG8_BAR; PG8_MMA(1, 1, At, B1); PG8_BAR;
            PG8_LDB(B0, 1, 0); PG8_SCHED; PG8_LDA(At, 1, 0); PG8_STAGE(PG8_SA(0, 1), a2 + hstep, voffA);
            PG8_WAIT_L(8); PG8_BAR; PG8_WAIT_L(0); PG8_MMA(0, 0, At, B0); PG8_BAR; PG8_SCHED;
            PG8_LDB(B1, 1, 1); PG8_STAGE(PG8_SB(1, 0), b3, voffB);
            PG8_BAR; PG8_WAIT_L(0); PG8_MMA(0, 1, At, B1); PG8_BAR;
            PG8_LDA(At, 1, 1); PG8_STAGE(PG8_SA(1, 0), a3, voffA);
            PG8_BAR; PG8_WAIT_L(0); PG8_MMA(1, 0, At, B0); PG8_BAR; PG8_SCHED;
            PG8_STAGE(PG8_SB(1, 1), b3 + hstep, voffB);
            PG8_WAIT_V(6); PG8_BAR; PG8_MMA(1, 1, At, B1); PG8_BAR;
            }
        }
        bool carry = false;
        if constexpr (Epi::SEG) carry = (cur.seg == 0) && has_next;
        if constexpr (ALIGN_EPI) { if (wr == 0 && !carry) PG8_BAR; }
        if constexpr (Epi::SEG) { if (carry) E.mid(acc, cur, wr, wc, fr, fq); else { E(acc, cur, wr, wc, fr, fq); S.done(cur); } }
        else if constexpr (!Epi::AFTER_DRAIN) { E(acc, cur, wr, wc, fr, fq); if ((PROBE_MASK & 1024) && Epi::IDEM) { asm volatile("" ::: "memory"); E(acc, cur, wr, wc, fr, fq); } S.done(cur); }
        if (!has_next) break;
        { const float keep = carry ? 1.0f : 0.0f;
#pragma unroll
        for (int a = 0; a < 2; ++a)
#pragma unroll
            for (int b = 0; b < 2; ++b)
#pragma unroll
                for (int m = 0; m < 4; ++m)
#pragma unroll
                    for (int n = 0; n < 2; ++n) { if constexpr (Epi::SEG) acc[a][b][m][n] = acc[a][b][m][n] * keep; else acc[a][b][m][n] = (f32x4){0.f, 0.f, 0.f, 0.f}; } }
        cur = nxt; cA = nA; cB = nB; ++ui;
        if constexpr (ALIGN_EPI) { if (wr == 1 && !carry) PG8_BAR; }
    }
    PG8_WAIT_V(0);
    if constexpr (!ALIGN_EPI) { if (wr == 0) PG8_BAR; }
    PG8_BAR;
    if constexpr (Epi::AFTER_DRAIN) { E.fused(acc, cur, wr, wc, fr, fq, lds, wid, lane); S.done(cur); }
#undef PG8_SA
#undef PG8_SB
#undef PG8_STAGE
#undef PG8_LDA
#undef PG8_LDB
#undef PG8_MMA
#undef PG8_WAIT_V
#undef PG8_WAIT_L
#undef PG8_BAR
#undef PG8_SCHED
}
}

constexpr int DM = 1024, NBATCH = 32, SEQ = 2048, NTOK = NBATCH * SEQ, DEPTH = 4, INW = 5632, MODW = 6144;
constexpr float DN_ALPHA = 1.681792830507429f;
constexpr float LN_EPS = 1e-5f, RMS_EPS = 1e-6f;
constexpr int NWAVES = 8, NTHREADS = 512;

constexpr size_t MiB = 1u << 20;
constexpr size_t WS_CTL = 0, CTL_ZERO_BYTES = 1 * MiB;
constexpr size_t WS_MOD = 1 * MiB;
constexpr size_t WS_LB = 4 * MiB;
constexpr size_t WS_STATS = 4 * MiB + 65536;
constexpr size_t WS_SC = 4 * MiB + 65536 + 524288 + 262144;
constexpr size_t WS_HSC = 4 * MiB + 65536 + 524288;
constexpr size_t WS_WIN = 5 * MiB;
constexpr size_t WS_WUA = 49 * MiB, WS_WUB = 53 * MiB;
constexpr size_t WS_WO = 57 * MiB, WS_WPQ = 65 * MiB;
constexpr size_t WS_SK = 73 * MiB;
constexpr size_t WS_HB = 74 * MiB;
constexpr size_t WS_OA = 74 * MiB, WS_OB = 138 * MiB;
constexpr size_t WS_QA = 202 * MiB, WS_GLOG = 266 * MiB;
constexpr size_t WS_MERGED = 202 * MiB;
constexpr size_t WS_KK = 330 * MiB, WS_IA = 394 * MiB;
constexpr size_t WS_PQ = 330 * MiB;
constexpr size_t WS_GA = 458 * MiB;
constexpr size_t WS_IDX = 458 * MiB, WS_GATE = 474 * MiB;
constexpr size_t WS_QB = 522 * MiB, WS_KB = 586 * MiB, WS_VT = 650 * MiB;
constexpr size_t WS_PU = 522 * MiB, WS_PV = 586 * MiB;
constexpr size_t WS_GTA = 714 * MiB, WS_GTB = 842 * MiB;
constexpr size_t WS_MODP = 714 * MiB;
constexpr size_t WS_PART = 650 * MiB;
constexpr size_t WS_W16 = 714 * MiB;
constexpr size_t WS_Y = 202 * MiB;
constexpr size_t WS_XT = 778 * MiB;
constexpr size_t WS_HB8 = 266 * MiB;
constexpr size_t WS_END = 970 * MiB;

constexpr int CW_BAR = 4096;
constexpr int CW_QUEUE = 16384;

constexpr int RING_BYTES = 131072;
constexpr int LDS_BYTES = 163840;
constexpr int LDSCTL_OFF = LDS_BYTES - 512, MISC_OFF = LDSCTL_OFF + 320;

#define GAS __attribute__((address_space(1)))
#define LAS __attribute__((address_space(3)))
typedef unsigned short bf16;
typedef unsigned v4u __attribute__((ext_vector_type(4)));
typedef unsigned v2u __attribute__((ext_vector_type(2)));
typedef float f32x4 __attribute__((ext_vector_type(4)));
typedef float f32x2 __attribute__((ext_vector_type(2)));
typedef GAS unsigned gu32;
#define RLX_AGENT __ATOMIC_RELAXED, __HIP_MEMORY_SCOPE_AGENT
#define LDS_WAIT() asm volatile("s_waitcnt lgkmcnt(0)" ::: "memory")
#define VM_WAIT() asm volatile("s_waitcnt vmcnt(0)" ::: "memory")

__device__ __forceinline__ float bf2f(unsigned h) { return __uint_as_float(h << 16); }
__device__ __forceinline__ float bflo(unsigned w) { return __uint_as_float(w << 16); }
__device__ __forceinline__ float bfhi(unsigned w) { return __uint_as_float(w & 0xffff0000u); }
__device__ __forceinline__ unsigned pk2(float lo, float hi) { return pg8::cvt_pk_bf16(lo, hi); }
__device__ __forceinline__ v4u pk8(f32x4 a, f32x4 b) { v4u w; w.x = pk2(a[0], a[1]); w.y = pk2(a[2], a[3]); w.z = pk2(b[0], b[1]); w.w = pk2(b[2], b[3]); return w; }
__device__ __forceinline__ float fsigmoid(float z) { return 1.0f / (1.0f + __expf(-z)); }
template <int CTRL> __device__ __forceinline__ float dpp_f(float v) { return __int_as_float(__builtin_amdgcn_update_dpp(0, __float_as_int(v), CTRL, 0xF, 0xF, true)); }
typedef unsigned wr_u2 __attribute__((ext_vector_type(2)));
__device__ __forceinline__ float wave_sum(float v) {
    v += dpp_f<0xB1>(v); v += dpp_f<0x4E>(v); v += dpp_f<0x141>(v); v += dpp_f<0x140>(v);
    { const wr_u2 r = __builtin_amdgcn_permlane16_swap(__float_as_uint(v), __float_as_uint(v), false, false); v = __uint_as_float(r[0]) + __uint_as_float(r[1]); }
    { const wr_u2 r = __builtin_amdgcn_permlane32_swap(__float_as_uint(v), __float_as_uint(v), false, false); v = __uint_as_float(r[0]) + __uint_as_float(r[1]); }
    return v;
}
__device__ __forceinline__ float wave_max_fast(float v) {
    v = fmaxf(v, dpp_f<0xB1>(v)); v = fmaxf(v, dpp_f<0x4E>(v)); v = fmaxf(v, dpp_f<0x141>(v)); v = fmaxf(v, dpp_f<0x140>(v));
    { const wr_u2 r = __builtin_amdgcn_permlane16_swap(__float_as_uint(v), __float_as_uint(v), false, false); v = fmaxf(__uint_as_float(r[0]), __uint_as_float(r[1])); }
    { const wr_u2 r = __builtin_amdgcn_permlane32_swap(__float_as_uint(v), __float_as_uint(v), false, false); v = fmaxf(__uint_as_float(r[0]), __uint_as_float(r[1])); }
    return v;
}

template <class T> __device__ __forceinline__ T* opq(T* p) { long z = 0; asm volatile("" : "+s"(z)); return p + z; }
__device__ __forceinline__ int opqv(int v) { asm volatile("" : "+v"(v)); return v; }
__device__ __forceinline__ int opqs(int v) { asm volatile("" : "+s"(v)); return v; }
static_assert(WS_QA == pg8::EpiInProj::oQA && WS_GLOG == pg8::EpiInProj::oGLOG && WS_KK == pg8::EpiInProj::oKK && WS_IA == pg8::EpiInProj::oIA && WS_GA == pg8::EpiInProj::oGA && WS_QB == pg8::EpiInProj::oQB
              && WS_KB == pg8::EpiInProj::oKB && WS_VT == pg8::EpiInProj::oVT && WS_GTA == pg8::EpiInProj::oGTA && WS_GTB == pg8::EpiInProj::oGTB, "EpiInProj offsets vs workspace map");
#define XB_TMO      128
#define XB_XCNT(j)  (256  + 64 * (j))
#define XB_XSUB(j)  (1280 + 64 * (j))
#define XB_XGEN(j)  (2304 + 64 * (j))
#define XB_TOP      3328
#define XB_TOPGEN   3392
#define XCD_BAR_WORDS 3456
#define XB_SPIN_CAP (1u << 22)

__device__ __forceinline__ unsigned xb_ld(unsigned* p)              { return __hip_atomic_load(p, __ATOMIC_RELAXED, __HIP_MEMORY_SCOPE_AGENT); }
__device__ __forceinline__ unsigned xb_add(unsigned* p, unsigned v) { return __hip_atomic_fetch_add(p, v, __ATOMIC_RELAXED, __HIP_MEMORY_SCOPE_AGENT); }
__device__ __forceinline__ unsigned xb_xcc_id() { return (unsigned)__builtin_amdgcn_s_getreg((3 << 11) | 20) & 0xFu; }
#define XB_SPIN(cond, bar) do { unsigned _sp = 0; while (cond) { __builtin_amdgcn_s_sleep(1); \
    if ((++_sp & 255u) == 0u) { if (xb_ld(&(bar)[XB_TMO])) break; if (_sp > XB_SPIN_CAP) { atomicAdd(&(bar)[XB_TMO], 1u); break; } } } } while (0)

struct XcdBarrier {
    unsigned* bar; unsigned x;
    volatile LAS unsigned* st;
};

__device__ __forceinline__ XcdBarrier xcd_barrier_post(unsigned* bar, volatile LAS unsigned* st) {
    XcdBarrier b; b.bar = bar; b.x = xb_xcc_id(); b.st = st;
    if (threadIdx.x == 0) (void)xb_add(&bar[XB_XCNT(b.x)], 1u);
    return b;
}
__device__ __forceinline__ void xcd_barrier_complete(unsigned* bar, unsigned x, unsigned& nloc, unsigned& nx) {
    const unsigned G = gridDim.x * gridDim.y * gridDim.z;
    unsigned sum, cnt, mine, sp = 0u;
    for (;;) {
        sum = 0u; cnt = 0u; mine = 0u;
#pragma unroll
        for (unsigned j = 0; j < 16; ++j) { const unsigned c = xb_ld(&bar[XB_XCNT(j)]); sum += c; cnt += (c > 0u) ? 1u : 0u; mine = (j == x) ? c : mine; }
        if (sum == G) break;
        __builtin_amdgcn_s_sleep(1);
        if ((++sp & 255u) == 0u) { if (xb_ld(&bar[XB_TMO])) break; if (sp > XB_SPIN_CAP) { atomicAdd(&bar[XB_TMO], 1u); break; } }
    }
    nloc = mine > 0u ? mine : 1u; nx = cnt > 0u ? cnt : 1u;
}

__device__ __forceinline__ void xcd_barrier(const XcdBarrier& b) {
    asm volatile("s_waitcnt vmcnt(0)" ::: "memory");
    __syncthreads();
    if (threadIdx.x == 0) {
        unsigned* bar = b.bar;
        __builtin_amdgcn_s_waitcnt(0);
        unsigned nloc = b.st[0], nx = b.st[1];
        if (nloc == 0u) { xcd_barrier_complete(bar, b.x, nloc, nx); b.st[0] = nloc; b.st[1] = nx; }
        const unsigned old = xb_add(&bar[XB_XSUB(b.x)], 1u);
        const unsigned gen = old / nloc;
        if (old + 1u == (gen + 1u) * nloc) {
            __builtin_amdgcn_fence(__ATOMIC_RELEASE, "agent");
            asm volatile("s_waitcnt vmcnt(0)" ::: "memory");
            const unsigned og = xb_add(&bar[XB_TOP], 1u);
            const unsigned tg = og / nx;
            if (og + 1u == (tg + 1u) * nx) xb_add(&bar[XB_TOPGEN], 1u);
            else XB_SPIN(xb_ld(&bar[XB_TOPGEN]) == tg, bar);
            __builtin_amdgcn_fence(__ATOMIC_ACQUIRE, "agent");
            xb_add(&bar[XB_XGEN(b.x)], 1u);
            asm volatile("s_waitcnt vmcnt(0)" ::: "memory");
        } else {
            XB_SPIN(xb_ld(&bar[XB_XGEN(b.x)]) == gen, bar);
            __builtin_amdgcn_fence(__ATOMIC_ACQUIRE, "agent");
            asm volatile("s_waitcnt vmcnt(0)" ::: "memory");
        }
    }
    __syncthreads();
}

struct Args { const float* in[16]; float* out; unsigned char* ws; int ph_lo, ph_hi; };
struct Frame {
    LAS unsigned char* lds;
    int tid, lane, wave, vcu, G, gw, NGW;
};
#define IN_x         (A.in[0])
#define IN_c         (A.in[1])
#define IN_w_ada     (A.in[2])
#define IN_b_ada     (A.in[3])
#define IN_w_in      (A.in[4])
#define IN_lb_logits (A.in[5])
#define IN_hg_norm_g (A.in[6])
#define IN_w_up_a    (A.in[7])
#define IN_w_up_b    (A.in[8])
#define IN_w_o       (A.in[9])
#define IN_w_pq      (A.in[10])
#define IN_sub_keys  (A.in[11])
#define IN_peer_u    (A.in[12])
#define IN_peer_v    (A.in[13])
#define IN_ln_g      (A.in[14])
#define IN_ln_b      (A.in[15])
#define P_X      (xout)
#define WSF(off) ((float*)(ws + (off)))
#define WSB(off) ((bf16*)(ws + (off)))
#define P_MOD    WSF(WS_MOD)
#define P_LB     WSF(WS_LB)
#define P_MODP   WSF(WS_MODP)
#define P_GATE   WSF(WS_GATE)
#define P_WIN    WSB(WS_WIN)
#define P_WUA    WSB(WS_WUA)
#define P_WUB    WSB(WS_WUB)
#define P_WO     WSB(WS_WO)
#define P_WPQ    WSB(WS_WPQ)
#define P_SK     WSB(WS_SK)
#define P_HB     WSB(WS_HB)
#define P_OA     WSB(WS_OA)
#define P_OB     WSB(WS_OB)
#define P_QA     WSB(WS_QA)
#define P_GLOG   WSB(WS_GLOG)
#define P_MERGED WSB(WS_MERGED)
#define P_KK     WSB(WS_KK)
#define P_IA     WSB(WS_IA)
#define P_PQ     WSB(WS_PQ)
#define P_GA     WSB(WS_GA)
#define P_IDX    WSB(WS_IDX)
#define P_QB     WSB(WS_QB)
#define P_KB     WSB(WS_KB)
#define P_VT     WSB(WS_VT)
#define P_PU     WSB(WS_PU)
#define P_PV     WSB(WS_PV)
#define P_GTA    WSB(WS_GTA)
#define P_GTB    WSB(WS_GTB)
#define P_PART   WSF(WS_PART)
#define P_Y      WSB(WS_Y)
#define P_XT     WSB(WS_XT)
#define P_STATS  WSF(WS_STATS)
#define P_HB8    ((unsigned char*)(ws + WS_HB8))
#define P_HSC    WSF(WS_HSC)
#define P_SC     WSF(WS_SC)
#define P_W16    ((bf16*)(ws + WS_W16))
#define P_XS     ((bf16*)xout)
#define LAUNDER() Args A; { long z_ = 0; asm volatile("" : "+s"(z_)); _Pragma("unroll") for (int i_ = 0; i_ < 16; ++i_) A.in[i_] = A0.in[i_] + z_; A.out = A0.out + z_; A.ws = A0.ws + z_; A.ph_lo = A0.ph_lo; A.ph_hi = A0.ph_hi; } \
    Frame F = F0; { unsigned m_ = ~0u; asm volatile("" : "+s"(m_)); F.lane = (int)__builtin_amdgcn_mbcnt_hi(m_, __builtin_amdgcn_mbcnt_lo(m_, 0u)); F.tid = (F0.wave << 6) | F.lane; }     unsigned char* const ws = A.ws; float* const xout = A.out; (void)ws; (void)xout;

__device__ __forceinline__ void transpose_item(const float* W, int K, int N, bf16* WT, LAS float* scr, int item, int lane, bool inproj = false) {
    const int nblk = N / 32, kb = item / nblk, nb = item % nblk, k0 = 64 * kb, n0 = 32 * nb;
    const float ws_ = !inproj ? 1.0f : (n0 >= 3584 ? -1.4426950408889634f : ((n0 >= 2048 && n0 < 2560) ? 0.125f : 1.0f));
    { f32x4 wv[8]; const int cg = lane & 7, kr = lane >> 3;
#pragma unroll
      for (int i = 0; i < 8; ++i) wv[i] = *(const f32x4*)(W + (size_t)(k0 + kr + 8 * i) * N + n0 + 4 * cg);
#pragma unroll
      for (int i = 0; i < 8; ++i) { LAS float* sp = scr + (kr + 8 * i) * 33 + 4 * cg; sp[0] = wv[i][0]; sp[1] = wv[i][1]; sp[2] = wv[i][2]; sp[3] = wv[i][3]; } }
    LDS_WAIT(); asm volatile("" ::: "memory");
    const int c = lane & 7;
#pragma unroll
    for (int j = 0; j < 4; ++j) { const int n = (lane >> 3) + 8 * j; const LAS float* s = scr + (8 * c) * 33 + n;
        v4u o; o.x = pk2(s[0 * 33] * ws_, s[1 * 33] * ws_); o.y = pk2(s[2 * 33] * ws_, s[3 * 33] * ws_); o.z = pk2(s[4 * 33] * ws_, s[5 * 33] * ws_); o.w = pk2(s[6 * 33] * ws_, s[7 * 33] * ws_);
        *(v4u*)(WT + (size_t)(n0 + n) * K + k0 + 8 * c) = o; }
    LDS_WAIT(); asm volatile("" ::: "memory");
}

__device__ __forceinline__ void phase_proA(const Args& A0, Frame& F0) {
    LAUNDER();
    LAS float* scr = (LAS float*)(F.lds + F.wave * 16384);
    constexpr int I_IN = (DM / 64) * (INW / 32), I_UP = (512 / 64) * (DM / 32), I_SQ = (DM / 64) * (DM / 32), I_L = I_IN + 2 * I_UP + 2 * I_SQ;
    for (int it = F.gw; it < DEPTH * I_L; it += F.NGW) {
        const int l = it / I_L; int r = it % I_L;
        if (r < I_IN) { transpose_item(IN_w_in + (size_t)l * DM * INW, DM, INW, P_WIN + (size_t)l * INW * DM, scr, r, F.lane, true); continue; } r -= I_IN;
        if (r < I_UP) { transpose_item(IN_w_up_a + (size_t)l * 512 * DM, 512, DM, P_WUA + (size_t)l * DM * 512, scr, r, F.lane); continue; } r -= I_UP;
        if (r < I_UP) { transpose_item(IN_w_up_b + (size_t)l * 512 * DM, 512, DM, P_WUB + (size_t)l * DM * 512, scr, r, F.lane); continue; } r -= I_UP;
        if (r < I_SQ) { transpose_item(IN_w_o + (size_t)l * DM * DM, DM, DM, P_WO + (size_t)l * DM * DM, scr, r, F.lane); continue; } r -= I_SQ;
        transpose_item(IN_w_pq + (size_t)l * DM * DM, DM, DM, P_WPQ + (size_t)l * DM * DM, scr, r, F.lane);
    }
    { const int gt = F.vcu * NTHREADS + F.tid, NGT = F.G * NTHREADS;
      for (int i = gt; i < DEPTH * 2 * 8 * 128 * 64 / 8; i += NGT) { const f32x4 a = *(const f32x4*)(IN_sub_keys + (size_t)i * 8), b = *(const f32x4*)(IN_sub_keys + (size_t)i * 8 + 4);
          const int tab = i >> 10, n = (i & 1023) >> 3, d0 = (i & 7) * 8;
          *(v4u*)(P_SK + ((size_t)tab * 16 + (n >> 5) * 4 + (d0 >> 4)) * 512 + ((n & 31) + 32 * ((d0 >> 3) & 1)) * 8) = pk8(a, b); } }
    if (blockIdx.x == 0) { const int j = F.tid; float z[4], m = -1e30f, s = 0.f;
#pragma unroll
        for (int l = 0; l < 4; ++l) { z[l] = IN_lb_logits[l * 512 + j]; m = fmaxf(m, z[l]); }
#pragma unroll
        for (int l = 0; l < 4; ++l) { z[l] = __expf(z[l] - m); s += z[l]; }
        const float inv = 1.0f / s; float cum = 0.f; P_LB[j] = 0.f;
#pragma unroll
        for (int l = 1; l < 4; ++l) { cum += z[l] * inv; P_LB[l * 512 + j] = cum; } }
    for (int it = F.gw; it < DEPTH * 96 * 16; it += F.NGW) {
        const int l = it / 1536, r = it % 1536, nblk = r >> 4, ks = r & 15, n = nblk * 64 + F.lane, k0 = ks * 64;
#pragma unroll 8
        for (int i = 0; i < 32; ++i) { const int idx = F.lane + 64 * i, b = idx >> 6, kk = idx & 63; const float cv = IN_c[b * DM + k0 + kk]; scr[idx] = cv / (1.0f + __expf(-cv)); }
        LDS_WAIT(); asm volatile("" ::: "memory");
        float acc[32];
#pragma unroll
        for (int b = 0; b < 32; ++b) acc[b] = 0.f;
        const float* wp = IN_w_ada + ((size_t)l * DM + k0) * MODW + n;
#pragma unroll 4
        for (int kk = 0; kk < 64; kk += 4) {
            const float w0 = wp[(size_t)(kk + 0) * MODW], w1 = wp[(size_t)(kk + 1) * MODW], w2 = wp[(size_t)(kk + 2) * MODW], w3 = wp[(size_t)(kk + 3) * MODW];
#pragma unroll
            for (int b = 0; b < 32; ++b) { const f32x4 s = *(const LAS f32x4*)(scr + b * 64 + kk); acc[b] += s[0] * w0 + s[1] * w1 + s[2] * w2 + s[3] * w3; }
        }
#pragma unroll
        for (int b = 0; b < 32; ++b) P_MODP[(((size_t)ks * DEPTH + l) * 32 + b) * MODW + n] = acc[b];
        LDS_WAIT(); asm volatile("" ::: "memory");
    }
}
__device__ __forceinline__ void phase_proA2(const Args& A0, Frame& F0) {
    LAUNDER();
    const int gt = F.vcu * NTHREADS + F.tid, NGT = F.G * NTHREADS;
    for (int i = gt; i < DEPTH * 32 * MODW; i += NGT) { const int l = i / (32 * MODW), n = i % MODW; float s = IN_b_ada[l * MODW + n];
#pragma unroll
        for (int ks = 0; ks < 16; ++ks) s += P_MODP[(size_t)ks * DEPTH * 32 * MODW + i];
        P_MOD[i] = s; }
}
struct Row16 { f32x4 a0, a1, b0, b1; };
__device__ __forceinline__ Row16 ld_row(const float* p, int lane) { Row16 r; const f32x4* q = (const f32x4*)(p + 8 * lane); r.a0 = q[0]; r.a1 = q[1]; q = (const f32x4*)(p + 512 + 8 * lane); r.b0 = q[0]; r.b1 = q[1]; return r; }
__device__ __forceinline__ void st_row(float* p, int lane, const Row16& r) { f32x4* q = (f32x4*)(p + 8 * lane); q[0] = r.a0; q[1] = r.a1; q = (f32x4*)(p + 512 + 8 * lane); q[0] = r.b0; q[1] = r.b1; }
__device__ __forceinline__ Row16 ld_row_bf16(const bf16* p, int lane) { const v4u a = *(const v4u*)(p + 8 * lane), b = *(const v4u*)(p + 512 + 8 * lane); Row16 r;
    r.a0 = (f32x4){bflo(a.x), bfhi(a.x), bflo(a.y), bfhi(a.y)}; r.a1 = (f32x4){bflo(a.z), bfhi(a.z), bflo(a.w), bfhi(a.w)}; r.b0 = (f32x4){bflo(b.x), bfhi(b.x), bflo(b.y), bfhi(b.y)}; r.b1 = (f32x4){bflo(b.z), bfhi(b.z), bflo(b.w), bfhi(b.w)}; return r; }
__device__ __forceinline__ void st_row_bf16(bf16* p, int lane, const Row16& r) { *(v4u*)(p + 8 * lane) = pk8(r.a0, r.a1); *(v4u*)(p + 512 + 8 * lane) = pk8(r.b0, r.b1); }
__device__ __forceinline__ float sat8(float x) { return fminf(fmaxf(x, -448.0f), 448.0f); }
__device__ __forceinline__ unsigned pk4_fp8(f32x4 a) { int p = 0; p = __builtin_amdgcn_cvt_pk_fp8_f32(sat8(a[0]), sat8(a[1]), p, false); p = __builtin_amdgcn_cvt_pk_fp8_f32(sat8(a[2]), sat8(a[3]), p, true); return (unsigned)p; }
__device__ __forceinline__ v4u pk16_fp8(f32x4 a, f32x4 b, f32x4 c, f32x4 d) { v4u w; w.x = pk4_fp8(a); w.y = pk4_fp8(b); w.z = pk4_fp8(c); w.w = pk4_fp8(d); return w; }
__device__ __forceinline__ void st_row_fp8(unsigned char* p, int lane, const Row16& r) { v2u a, b; a.x = pk4_fp8(r.a0 * 16.0f); a.y = pk4_fp8(r.a1 * 16.0f); b.x = pk4_fp8(r.b0 * 16.0f); b.y = pk4_fp8(r.b1 * 16.0f); *(v2u*)(p + 8 * lane) = a; *(v2u*)(p + 512 + 8 * lane) = b; }
__device__ __forceinline__ float wave_max(float v) { return wave_max_fast(v); }
__device__ __forceinline__ unsigned pk4_i8(f32x4 a) { unsigned r = 0;
#pragma unroll
    for (int j = 0; j < 4; ++j) { const int q = (int)__builtin_amdgcn_fmed3f(__builtin_rintf(a[j]), -127.0f, 127.0f); r |= ((unsigned)q & 0xffu) << (8 * j); }
    return r; }
__device__ __forceinline__ float row_absmax(const Row16& r) { const f32x4 a = __builtin_elementwise_max(__builtin_elementwise_max(__builtin_elementwise_abs(r.a0), __builtin_elementwise_abs(r.a1)), __builtin_elementwise_max(__builtin_elementwise_abs(r.b0), __builtin_elementwise_abs(r.b1))); return fmaxf(fmaxf(a[0], a[1]), fmaxf(a[2], a[3])); }
__device__ __forceinline__ void st_row_i8(unsigned char* p, int lane, const Row16& r, float s) { v2u a, b; a.x = pk4_i8(r.a0 * s); a.y = pk4_i8(r.a1 * s); b.x = pk4_i8(r.b0 * s); b.y = pk4_i8(r.b1 * s); *(v2u*)(p + 8 * lane) = a; *(v2u*)(p + 512 + 8 * lane) = b; }
__device__ __forceinline__ void pk8_i4x2(f32x4 lo, f32x4 hi, float s, unsigned& wa, unsigned& wb) { wa = 0; wb = 0;
#pragma unroll
    for (int j = 0; j < 8; ++j) { const unsigned qi = __float_as_uint(__builtin_fmaf(j < 4 ? lo[j] : hi[j - 4], s, 12582912.0f)); wa |= (((qi + 8u) >> 4) & 15u) << (4 * j); wb |= (qi & 15u) << (4 * j); } }
__device__ __forceinline__ void st_row_i4x2(unsigned char* p, int lane, const Row16& r, float s) {
    unsigned char* q = p + (lane >> 5) * 256 + ((lane >> 2) & 7) * 32 + (lane & 3) * 4; unsigned wa, wb;
    pk8_i4x2(r.a0, r.a1, s, wa, wb); *(unsigned*)q = wa; *(unsigned*)(q + 16) = wb;
    pk8_i4x2(r.b0, r.b1, s, wa, wb); *(unsigned*)(q + 512) = wa; *(unsigned*)(q + 528) = wb; }
__device__ __forceinline__ Row16 modulate(const Row16& x, const Row16& sc, const Row16& sh) { Row16 r; r.a0 = x.a0 * (sc.a0 + 1.0f) + sh.a0; r.a1 = x.a1 * (sc.a1 + 1.0f) + sh.a1; r.b0 = x.b0 * (sc.b0 + 1.0f) + sh.b0; r.b1 = x.b1 * (sc.b1 + 1.0f) + sh.b1; return r; }
__device__ __forceinline__ float row_sum(const Row16& r) { const f32x4 s = (r.a0 + r.a1) + (r.b0 + r.b1); return (s[0] + s[1]) + (s[2] + s[3]); }
__device__ __forceinline__ Row16 layer_norm_row(const Row16& v, const float* g, const float* bta, int lane) {
    const float mean = wave_sum(row_sum(v)) * (1.0f / DM);
    Row16 d; d.a0 = v.a0 - mean; d.a1 = v.a1 - mean; d.b0 = v.b0 - mean; d.b1 = v.b1 - mean;
    Row16 q; q.a0 = d.a0 * d.a0; q.a1 = d.a1 * d.a1; q.b0 = d.b0 * d.b0; q.b1 = d.b1 * d.b1;
    const float rstd = __builtin_amdgcn_rsqf(wave_sum(row_sum(q)) * (1.0f / DM) + LN_EPS);
    const Row16 gg = ld_row(g, lane), bb = ld_row(bta, lane);
    Row16 o; o.a0 = d.a0 * rstd * gg.a0 + bb.a0; o.a1 = d.a1 * rstd * gg.a1 + bb.a1; o.b0 = d.b0 * rstd * gg.b0 + bb.b0; o.b1 = d.b1 * rstd * gg.b1 + bb.b1; return o;
}
__device__ __forceinline__ Row16 layer_norm_apply(const Row16& v, float mean, float rstd, const float* g, const float* bta, int lane) {
    const Row16 gg = ld_row(g, lane), bb = ld_row(bta, lane);
    Row16 o; o.a0 = (v.a0 - mean) * rstd * gg.a0 + bb.a0; o.a1 = (v.a1 - mean) * rstd * gg.a1 + bb.a1; o.b0 = (v.b0 - mean) * rstd * gg.b0 + bb.b0; o.b1 = (v.b1 - mean) * rstd * gg.b1 + bb.b1; return o;
}
__device__ __forceinline__ void row_stats(const Row16& v, float& mean, float& rstd) {
    mean = wave_sum(row_sum(v)) * (1.0f / DM);
    Row16 q; q.a0 = (v.a0 - mean) * (v.a0 - mean); q.a1 = (v.a1 - mean) * (v.a1 - mean); q.b0 = (v.b0 - mean) * (v.b0 - mean); q.b1 = (v.b1 - mean) * (v.b1 - mean);
    rstd = __builtin_amdgcn_rsqf(wave_sum(row_sum(q)) * (1.0f / DM) + LN_EPS);
}
__device__ __forceinline__ Row16 unpack_row(const v4u a, const v4u b) { Row16 r;
    r.a0 = (f32x4){bflo(a.x), bfhi(a.x), bflo(a.y), bfhi(a.y)}; r.a1 = (f32x4){bflo(a.z), bfhi(a.z), bflo(a.w), bfhi(a.w)}; r.b0 = (f32x4){bflo(b.x), bfhi(b.x), bflo(b.y), bfhi(b.y)}; r.b1 = (f32x4){bflo(b.z), bfhi(b.z), bflo(b.w), bfhi(b.w)}; return r; }
__device__ __forceinline__ Row16 row_affine(const Row16& v, float mean, float rstd, const Row16& g, const Row16& bb) {
    Row16 o; o.a0 = (v.a0 - mean) * rstd * g.a0 + bb.a0; o.a1 = (v.a1 - mean) * rstd * g.a1 + bb.a1; o.b0 = (v.b0 - mean) * rstd * g.b0 + bb.b0; o.b1 = (v.b1 - mean) * rstd * g.b1 + bb.b1; return o; }
__device__ __forceinline__ Row16 row_affine2(const Row16& v, float c1, float c0, const Row16& g, const Row16& bb) {
    Row16 o; o.a0 = (v.a0 * c1 + c0) * g.a0 + bb.a0; o.a1 = (v.a1 * c1 + c0) * g.a1 + bb.a1; o.b0 = (v.b0 * c1 + c0) * g.b0 + bb.b0; o.b1 = (v.b1 * c1 + c0) * g.b1 + bb.b1; return o; }
__device__ __forceinline__ Row16 row_scale(const Row16& v, float s) { Row16 o; o.a0 = v.a0 * s; o.a1 = v.a1 * s; o.b0 = v.b0 * s; o.b1 = v.b1 * s; return o; }
__device__ __forceinline__ Row16 row_fma(const Row16& x, const Row16& m, const Row16& a) { Row16 o; o.a0 = x.a0 * m.a0 + a.a0; o.a1 = x.a1 * m.a1 + a.a1; o.b0 = x.b0 * m.b0 + a.b0; o.b1 = x.b1 * m.b1 + a.b1; return o; }
__device__ __forceinline__ Row16 row_add1(const Row16& v) { Row16 o; o.a0 = v.a0 + 1.0f; o.a1 = v.a1 + 1.0f; o.b0 = v.b0 + 1.0f; o.b1 = v.b1 + 1.0f; return o; }
struct RowSpan { int t0, t1; };
__device__ __forceinline__ RowSpan wave_span(int gw, int NGW) { const int R = 2 * ((NTOK / 2 + NGW - 1) / NGW); RowSpan s; s.t0 = gw * R; s.t1 = s.t0 + R < NTOK ? s.t0 + R : NTOK; return s; }
__device__ __forceinline__ void phase_proB(const Args& A0, Frame& F0) {
    LAUNDER();
    const int lane = F.lane; const RowSpan sp = wave_span(F.gw, F.NGW);
    for (int s0 = sp.t0; s0 < sp.t1; ) { const int b = s0 >> 11, s1 = sp.t1 < ((b + 1) << 11) ? sp.t1 : ((b + 1) << 11);
        const float* mod = P_MOD + (size_t)b * MODW; const Row16 SH = ld_row(mod, lane), SC = ld_row(mod + 1024, lane);
#define CLP(t) ((t) < s1 - 2 ? (t) : s1 - 2)
        Row16 a0 = ld_row(IN_x + (size_t)s0 * DM, lane), a1 = ld_row(IN_x + (size_t)(s0 + 1) * DM, lane);
        for (int tok = s0; tok < s1; tok += 4) {
            const Row16 b0 = ld_row(IN_x + (size_t)CLP(tok + 2) * DM, lane), b1 = ld_row(IN_x + (size_t)(CLP(tok + 2) + 1) * DM, lane);
            __builtin_amdgcn_sched_barrier(0);
            st_row_bf16(P_HB + (size_t)tok * DM, lane, modulate(a0, SC, SH)); st_row_bf16(P_HB + (size_t)(tok + 1) * DM, lane, modulate(a1, SC, SH));
            __builtin_amdgcn_sched_barrier(0);
            a0 = ld_row(IN_x + (size_t)CLP(tok + 4) * DM, lane); a1 = ld_row(IN_x + (size_t)(CLP(tok + 4) + 1) * DM, lane);
            __builtin_amdgcn_sched_barrier(0);
            st_row_bf16(P_HB + (size_t)CLP(tok + 2) * DM, lane, modulate(b0, SC, SH)); st_row_bf16(P_HB + (size_t)(CLP(tok + 2) + 1) * DM, lane, modulate(b1, SC, SH));
            __builtin_amdgcn_sched_barrier(0);
        }
#undef CLP
        s0 = s1; }
}
__device__ __forceinline__ void phase_ln1(const Args& A0, Frame& F0, int l) {
    LAUNDER();
    const float* lng = IN_ln_g + (size_t)(l * 2 + 0) * DM; const float* lnb = IN_ln_b + (size_t)(l * 2 + 0) * DM;
    { const int lane = F.lane; const RowSpan sp = wave_span(F.gw, F.NGW);
      const Row16 G = ld_row(lng, lane), B = ld_row(lnb, lane);
      for (int s0 = sp.t0; s0 < sp.t1; ) { const int b = s0 >> 11, s1 = sp.t1 < ((b + 1) << 11) ? sp.t1 : ((b + 1) << 11);
        const float* mod = P_MOD + ((size_t)l * 32 + b) * MODW; const Row16 SH = ld_row(mod + 3072, lane), SC1 = row_add1(ld_row(mod + 4096, lane));
        struct Raw { v4u a, b; };
        auto ldraw = [&](int tok) __attribute__((always_inline)) { Raw r; const bf16* p = P_XT + (size_t)tok * DM; r.a = *(const v4u*)(p + 8 * lane); r.b = *(const v4u*)(p + 512 + 8 * lane); return r; };
        auto row = [&](const Raw& r, int tok) __attribute__((always_inline)) {
            const Row16 v = unpack_row(r.a, r.b);
            float mu, rs; row_stats(v, mu, rs);
            const Row16 xn = row_affine2(v, rs, -mu * rs, G, B);
            if (lane == 0) *(f32x2*)(P_STATS + (size_t)tok * 2) = (f32x2){mu, rs};
            const Row16 hf = row_fma(xn, SC1, SH);
            st_row_bf16(P_HB + (size_t)tok * DM, lane, hf);
            const float m1 = fmaxf(wave_max(row_absmax(hf)), 1e-20f); st_row_i4x2(P_HB8 + (size_t)tok * DM, lane, hf, 119.0f / m1); if (lane == 0) P_HSC[tok] = m1 * (1.0f / 119.0f); };
#define CLP(t) ((t) < s1 - 2 ? (t) : s1 - 2)
        Raw a0 = ldraw(s0), a1 = ldraw(s0 + 1);
        for (int tok = s0; tok < s1; tok += 4) {
            const Raw b0 = ldraw(CLP(tok + 2)), b1 = ldraw(CLP(tok + 2) + 1);
            __builtin_amdgcn_sched_barrier(0);
            row(a0, tok); row(a1, tok + 1);
            __builtin_amdgcn_sched_barrier(0);
            a0 = ldraw(CLP(tok + 4)); a1 = ldraw(CLP(tok + 4) + 1);
            __builtin_amdgcn_sched_barrier(0);
            row(b0, CLP(tok + 2)); row(b1, CLP(tok + 2) + 1);
            __builtin_amdgcn_sched_barrier(0);
        }
#undef CLP
        s0 = s1; } }
}
__device__ __forceinline__ void peer_convert(const Args& A0, Frame& F0, int l) {
    LAUNDER();
    const int gt = F.vcu * NTHREADS + F.tid, NGT = F.G * NTHREADS;
    const float* pu = IN_peer_u + (size_t)l * 16384 * DM; const float* pv = IN_peer_v + (size_t)l * 16384 * DM;
#if PEER_Q4
    for (int i = gt; i < 16384 * 64; i += NGT) { const int row = i >> 6, ln = i & 63; const size_t so = (size_t)row * DM + 16 * ln, dofs = (size_t)(ln >> 4) * 16384 * 128 + (size_t)row * 128 + (ln & 15) * 8;
        float ustep, vscale;
        { const f32x4 x[4] = {*(const f32x4*)(pu + so), *(const f32x4*)(pu + so + 4), *(const f32x4*)(pu + so + 8), *(const f32x4*)(pu + so + 12)};
          const f32x4 sq = (x[0] * x[0] + x[1] * x[1]) + (x[2] * x[2] + x[3] * x[3]);
          ustep = fmaxf(0.3352f * __builtin_sqrtf(wave_sum((sq[0] + sq[1]) + (sq[2] + sq[3])) * (1.0f / DM)), 1e-30f); const float inv = 1.0f / ustep;
          v2u w = (v2u){0u, 0u};
#pragma unroll
          for (int j = 0; j < 16; ++j) { const int q = (int)__builtin_amdgcn_fmed3f(__builtin_rintf(x[j >> 2][j & 3] * inv), -8.0f, 7.0f); if (j < 8) w.x |= ((unsigned)q & 15u) << (4 * j); else w.y |= ((unsigned)q & 15u) << (4 * (j - 8)); }
          *(v2u*)((unsigned char*)P_PU + dofs) = w; }
        { const f32x4 x[4] = {*(const f32x4*)(pv + so), *(const f32x4*)(pv + so + 4), *(const f32x4*)(pv + so + 8), *(const f32x4*)(pv + so + 12)};
          const f32x4 am = __builtin_elementwise_max(__builtin_elementwise_max(__builtin_elementwise_abs(x[0]), __builtin_elementwise_abs(x[1])), __builtin_elementwise_max(__builtin_elementwise_abs(x[2]), __builtin_elementwise_abs(x[3])));
          vscale = fmaxf(wave_max(fmaxf(fmaxf(am[0], am[1]), fmaxf(am[2], am[3]))) * (1.0f / 6.0f), 1e-30f); const float inv = 1.0f / vscale;
          v2u w = (v2u){0u, 0u};
#pragma unroll
          for (int j = 0; j < 16; ++j) { const float t = x[j >> 2][j & 3] * inv, a = fabsf(t);
              const unsigned c = (unsigned)(a > 0.25f) + (unsigned)(a > 0.75f) + (unsigned)(a > 1.25f) + (unsigned)(a > 1.75f) + (unsigned)(a > 2.5f) + (unsigned)(a > 3.5f) + (unsigned)(a > 5.0f), q = c | (t < 0.0f ? 8u : 0u);
              if (j < 8) w.x |= q << (4 * j); else w.y |= q << (4 * (j - 8)); }
          *(v2u*)((unsigned char*)P_PV + dofs) = w; }
        if (ln == 0) *(f32x2*)(P_SC + (size_t)row * 2) = (f32x2){ustep, vscale}; }
#elif PEER_FP8
#if PEER_KSLICE
    for (int i = gt; i < 16384 * 64; i += NGT) { const int row = i >> 6, ln = i & 63; const size_t so = (size_t)row * DM + 16 * ln, dofs = (size_t)(ln >> 3) * 16384 * 128 + (size_t)row * 128 + (ln & 7) * 16;
        { const f32x4 a = *(const f32x4*)(pu + so) * 2048.0f, b = *(const f32x4*)(pu + so + 4) * 2048.0f, c = *(const f32x4*)(pu + so + 8) * 2048.0f, d = *(const f32x4*)(pu + so + 12) * 2048.0f;
          if (U_INT8) { v4u w; w.x = pk4_i8(a * (600.0f / 2048.0f)); w.y = pk4_i8(b * (600.0f / 2048.0f)); w.z = pk4_i8(c * (600.0f / 2048.0f)); w.w = pk4_i8(d * (600.0f / 2048.0f)); *(v4u*)((unsigned char*)P_PU + dofs) = w; }
          else *(v4u*)((unsigned char*)P_PU + dofs) = pk16_fp8(a, b, c, d); }
        { const f32x4 a = *(const f32x4*)(pv + so) * 128.0f, b = *(const f32x4*)(pv + so + 4) * 128.0f, c = *(const f32x4*)(pv + so + 8) * 128.0f, d = *(const f32x4*)(pv + so + 12) * 128.0f;
          *(v4u*)((unsigned char*)P_PV + dofs) = pk16_fp8(a, b, c, d); } }
#else
    for (int i = gt; i < 16384 * 64; i += NGT) { const int row = i >> 6, ln = i & 63; const size_t so = (size_t)row * DM + 8 * ln;
        { const f32x4 a = *(const f32x4*)(pu + so) * 2048.0f, b = *(const f32x4*)(pu + so + 4) * 2048.0f, c = *(const f32x4*)(pu + so + 512) * 2048.0f, d = *(const f32x4*)(pu + so + 516) * 2048.0f;
          *(v4u*)((unsigned char*)P_PU + (size_t)row * 1024 + 16 * ln) = pk16_fp8(a, b, c, d); }
        { const f32x4 a = *(const f32x4*)(pv + so) * 128.0f, b = *(const f32x4*)(pv + so + 4) * 128.0f, c = *(const f32x4*)(pv + so + 512) * 128.0f, d = *(const f32x4*)(pv + so + 516) * 128.0f;
          *(v4u*)((unsigned char*)P_PV + (size_t)row * 1024 + 16 * ln) = pk16_fp8(a, b, c, d); } }
#endif
#else
    for (int i = gt; i < 16384 * DM / 8; i += NGT) {
        const f32x4 a = *(const f32x4*)(pu + (size_t)i * 8), b = *(const f32x4*)(pu + (size_t)i * 8 + 4); *(v4u*)(P_PU + (size_t)i * 8) = pk8(a, b);
        const f32x4 c = *(const f32x4*)(pv + (size_t)i * 8), d = *(const f32x4*)(pv + (size_t)i * 8 + 4); *(v4u*)(P_PV + (size_t)i * 8) = pk8(c, d); }
#endif
}

__device__ __forceinline__ void hgrn_simple(const Args& A0, Frame& F0, int l) {
    LAUNDER();
    LAS float* fL = (LAS float*)F.lds;
    LAS float* kL = fL + 2048, *qL = kL + 2048, *vL = qL + 2048;
    LAS float* part = vL + 2048;
    const int tid = F.tid, e = tid & 127, dq = tid >> 7;
    for (int unit = blockIdx.x; unit < 128; unit += F.G) {
        const int b = unit >> 2, h = unit & 3;
        float S[32];
#pragma unroll
        for (int i = 0; i < 32; ++i) S[i] = 0.f;
        for (int t0 = 0; t0 < SEQ; t0 += 16) {
#pragma unroll
            for (int i = 0; i < 4; ++i) { const int idx = tid + 512 * i, tt = idx >> 7, d = idx & 127; const size_t off = ((size_t)(b * SEQ + t0 + tt)) * 512 + h * 128 + d;
                fL[idx] = __expf(bf2f(P_GLOG[off])); kL[idx] = bf2f(P_KK[off]); qL[idx] = bf2f(P_QA[off]); vL[idx] = bf2f(P_IA[off]); }
            __syncthreads();
            for (int tt = 0; tt < 16; ++tt) {
                const float ve = vL[tt * 128 + e]; float o = 0.f;
#pragma unroll
                for (int i4 = 0; i4 < 8; ++i4) {
                    const f32x4 f4 = *(const LAS f32x4*)(fL + tt * 128 + 32 * dq + 4 * i4), k4 = *(const LAS f32x4*)(kL + tt * 128 + 32 * dq + 4 * i4), q4 = *(const LAS f32x4*)(qL + tt * 128 + 32 * dq + 4 * i4);
#pragma unroll
                    for (int j = 0; j < 4; ++j) { S[4 * i4 + j] = f4[j] * S[4 * i4 + j] + k4[j] * ve; o += S[4 * i4 + j] * q4[j]; }
                }
                part[(tt * 4 + dq) * 128 + e] = o;
            }
            __syncthreads();
            { const int tt = tid >> 5, eg = (tid & 31) * 4; f32x4 o4 = (f32x4){0.f, 0.f, 0.f, 0.f};
#pragma unroll
              for (int q = 0; q < 4; ++q) o4 = o4 + *(const LAS f32x4*)(part + (tt * 4 + q) * 128 + eg);
              float ss = (o4[0] * o4[0] + o4[1] * o4[1]) + (o4[2] * o4[2] + o4[3] * o4[3]);
#pragma unroll
              for (int m = 1; m < 32; m <<= 1) ss += __shfl_xor(ss, m);
              const float rstd = 1.0f / sqrtf(ss * (1.0f / 128.0f) + RMS_EPS);
              const size_t ro = ((size_t)(b * SEQ + t0 + tt)) * 512 + h * 128 + eg;
              const f32x4 gn = *(const f32x4*)(IN_hg_norm_g + l * 512 + h * 128 + eg); const v2u gw2 = *(const v2u*)(P_GA + ro);
              const float r0 = o4[0] * rstd * gn[0] * bflo(gw2.x), r1 = o4[1] * rstd * gn[1] * bfhi(gw2.x), r2 = o4[2] * rstd * gn[2] * bflo(gw2.y), r3 = o4[3] * rstd * gn[3] * bfhi(gw2.y);
              v2u w; w.x = pk2(r0, r1); w.y = pk2(r2, r3); *(v2u*)(P_OA + ro) = w; }
            __syncthreads();
        }
    }
}
__device__ __forceinline__ void attn_simple(const Args& A0, Frame& F0) {
    LAUNDER();
    for (int item = blockIdx.x; item < 1024; item += F.G) {
        const int bh = item >> 2, t = (item & 3) * 512 + F.tid, b = bh >> 3, h = bh & 7;
        float q[64], o[64];
        { const v4u* qp = (const v4u*)(P_QB + ((size_t)bh * SEQ + t) * 64);
#pragma unroll
          for (int i = 0; i < 8; ++i) { const v4u w = qp[i]; q[8 * i] = bflo(w.x); q[8 * i + 1] = bfhi(w.x); q[8 * i + 2] = bflo(w.y); q[8 * i + 3] = bfhi(w.y); q[8 * i + 4] = bflo(w.z); q[8 * i + 5] = bfhi(w.z); q[8 * i + 6] = bflo(w.w); q[8 * i + 7] = bfhi(w.w); } }
#pragma unroll
        for (int d = 0; d < 64; ++d) o[d] = 0.f;
        float R = 0.f;
        for (int s = t - 1; s >= 0; --s) {
            if (R < -104.0f) break;
            const v4u* kp = (const v4u*)(P_KB + ((size_t)bh * SEQ + s) * 64); float z = 0.f;
#pragma unroll
            for (int i = 0; i < 8; ++i) { const v4u w = kp[i]; z += q[8 * i] * bflo(w.x) + q[8 * i + 1] * bfhi(w.x) + q[8 * i + 2] * bflo(w.y) + q[8 * i + 3] * bfhi(w.y) + q[8 * i + 4] * bflo(w.z) + q[8 * i + 5] * bfhi(w.z) + q[8 * i + 6] * bflo(w.w) + q[8 * i + 7] * bfhi(w.w); }
            const float sp = fmaxf(z, 0.f) + __logf(1.0f + __expf(-fabsf(z)));
            const float w = __expf(z - sp + R); R -= sp;
            const bf16* vp = P_VT + (size_t)bh * 64 * SEQ + s;
#pragma unroll
            for (int d = 0; d < 64; ++d) o[d] += w * bf2f(vp[(size_t)d * SEQ]);
        }
        bf16* op = P_OB + ((size_t)(b * SEQ + t)) * 512 + h * 64;
#pragma unroll
        for (int i = 0; i < 8; ++i) { v4u w; w.x = pk2(o[8 * i], o[8 * i + 1]); w.y = pk2(o[8 * i + 2], o[8 * i + 3]); w.z = pk2(o[8 * i + 4], o[8 * i + 5]); w.w = pk2(o[8 * i + 6], o[8 * i + 7]); *(v4u*)(op + 8 * i) = w; }
    }
}

__device__ __forceinline__ unsigned f2sort(float f) { const unsigned u = __float_as_uint(f); return u ^ ((unsigned)((int)u >> 31) | 0x80000000u); }
__device__ __forceinline__ float sort2f(unsigned k) { return __uint_as_float((k & 0x80000000u) ? (k ^ 0x80000000u) : ~k); }
__device__ __forceinline__ void ins16(unsigned (&top)[16], unsigned x) {
#pragma unroll
    for (int i = 0; i < 16; ++i) { const unsigned hi = top[i] > x ? top[i] : x; x = top[i] > x ? x : top[i]; top[i] = hi; }
}
__device__ __forceinline__ void peer_topk_simple(const Args& A0, Frame& F0, int l) {
    LAUNDER();
    LAS unsigned char* nscr = (LAS unsigned char*)F.lds + (F.wave * 64 + F.lane) * 32;
    for (int item = blockIdx.x; item < NTOK / 64; item += F.G) {
        const int tok = item * 64 + F.lane, h = F.wave;
        unsigned top[2][16];
#pragma unroll
        for (int p = 0; p < 2; ++p) {
            float q[64];
            { const v4u* qp = (const v4u*)(P_PQ + (size_t)tok * DM + h * 128 + p * 64);
#pragma unroll
              for (int i = 0; i < 8; ++i) { const v4u w = qp[i]; q[8 * i] = bflo(w.x); q[8 * i + 1] = bfhi(w.x); q[8 * i + 2] = bflo(w.y); q[8 * i + 3] = bfhi(w.y); q[8 * i + 4] = bflo(w.z); q[8 * i + 5] = bfhi(w.z); q[8 * i + 6] = bflo(w.w); q[8 * i + 7] = bfhi(w.w); } }
#pragma unroll
            for (int i = 0; i < 16; ++i) top[p][i] = 0u;
            const bf16* key = P_SK + ((size_t)((l * 2 + p) * 8 + h)) * 128 * 64;
            for (int n = 0; n < 128; ++n) {
                const v4u* kp = (const v4u*)(key + n * 64); float s = 0.f;
#pragma unroll
                for (int i = 0; i < 8; ++i) { const v4u w = kp[i]; s += q[8 * i] * bflo(w.x) + q[8 * i + 1] * bfhi(w.x) + q[8 * i + 2] * bflo(w.y) + q[8 * i + 3] * bfhi(w.y) + q[8 * i + 4] * bflo(w.z) + q[8 * i + 5] * bfhi(w.z) + q[8 * i + 6] * bflo(w.w) + q[8 * i + 7] * bfhi(w.w); }
                ins16(top[p], (f2sort(s) & ~127u) | (unsigned)(127 - n));
            }
        }
        float v1[16], v2[16];
#pragma unroll
        for (int i = 0; i < 16; ++i) { v1[i] = sort2f(top[0][i] & ~127u); v2[i] = sort2f(top[1][i] & ~127u); nscr[i] = (unsigned char)(127u - (top[0][i] & 127u)); nscr[16 + i] = (unsigned char)(127u - (top[1][i] & 127u)); }
        unsigned ct[16];
#pragma unroll
        for (int i = 0; i < 16; ++i) ct[i] = 0u;
#pragma unroll
        for (int i = 0; i < 16; ++i)
#pragma unroll
            for (int j = 0; j < 16; ++j) if ((i + 1) * (j + 1) <= 16) ins16(ct, (f2sort(v1[i] + v2[j]) & ~255u) | (unsigned)(255 - (i * 16 + j)));
        LDS_WAIT(); asm volatile("" ::: "memory");
        float ev[16], es = 0.f; const float vmax = sort2f(ct[0] & ~255u);
#pragma unroll
        for (int k = 0; k < 16; ++k) { ev[k] = __expf(sort2f(ct[k] & ~255u) - vmax); es += ev[k]; }
        const float inv = 1.0f / es;
        bf16* ip = P_IDX + (size_t)tok * 128 + h * 16; float* gp = P_GATE + (size_t)tok * 128 + h * 16;
#pragma unroll
        for (int k = 0; k < 16; ++k) { const unsigned code = 255u - (ct[k] & 255u); const unsigned n1 = nscr[code >> 4], n2 = nscr[16 + (code & 15u)];
            ip[k] = (bf16)(n1 * 128u + n2); gp[k] = ev[k] * inv; }
        LDS_WAIT(); asm volatile("" ::: "memory");
    }
}

typedef __bf16 bf16x2_t __attribute__((ext_vector_type(2)));
__device__ __forceinline__ float dot2(unsigned a, unsigned b, float c) { return __builtin_amdgcn_fdot2_f32_bf16(__builtin_bit_cast(bf16x2_t, a), __builtin_bit_cast(bf16x2_t, b), c, false); }
__device__ __forceinline__ float dot8(v4u a, v4u b, float c) { c = dot2(a.x, b.x, c); c = dot2(a.y, b.y, c); c = dot2(a.z, b.z, c); return dot2(a.w, b.w, c); }
__device__ __forceinline__ void axpy8(float (&y)[16], int o, float w, v4u v) {
    y[o + 0] += w * bflo(v.x); y[o + 1] += w * bfhi(v.x); y[o + 2] += w * bflo(v.y); y[o + 3] += w * bfhi(v.y);
    y[o + 4] += w * bflo(v.z); y[o + 5] += w * bfhi(v.z); y[o + 6] += w * bflo(v.w); y[o + 7] += w * bfhi(v.w);
}
#if PEER_FP8
__device__ __forceinline__ void peer_group8(const bf16* PUp, const bf16* PVp, Frame& F, const float (&hf)[16], unsigned idxv, float gatev, int e0, float (&y)[16]) {
    const int lane = F.lane;
    v4u uq[8], vq[8];
#pragma unroll
    for (int j = 0; j < 8; ++j) { const unsigned e = (unsigned)__builtin_amdgcn_readlane((int)idxv, e0 + j);
        uq[j] = *(const v4u*)((const unsigned char*)PUp + (size_t)e * 1024 + 16 * lane); vq[j] = *(const v4u*)((const unsigned char*)PVp + (size_t)e * 1024 + 16 * lane); }
    float p[8];
#pragma unroll
    for (int j = 0; j < 8; ++j) { float s = 0.f; const unsigned uw[4] = {uq[j].x, uq[j].y, uq[j].z, uq[j].w};
#pragma unroll
        for (int w = 0; w < 4; ++w) { const f32x2 lo = __builtin_amdgcn_cvt_pk_f32_fp8((int)uw[w], false), hi = __builtin_amdgcn_cvt_pk_f32_fp8((int)uw[w], true);
            s += hf[4 * w] * lo[0]; s += hf[4 * w + 1] * lo[1]; s += hf[4 * w + 2] * hi[0]; s += hf[4 * w + 3] * hi[1]; }
        p[j] = s; }
    const bool b5 = lane & 32, b4 = lane & 16, b3 = lane & 8;
    float r[4];
#pragma unroll
    for (int i = 0; i < 4; ++i) { const float snd = b5 ? p[i] : p[i + 4], kp = b5 ? p[i + 4] : p[i]; r[i] = kp + __shfl_xor(snd, 32); }
    float r2[2];
#pragma unroll
    for (int i = 0; i < 2; ++i) { const float snd = b4 ? r[i] : r[i + 2], kp = b4 ? r[i + 2] : r[i]; r2[i] = kp + __shfl_xor(snd, 16); }
    float r3; { const float snd = b3 ? r2[0] : r2[1], kp = b3 ? r2[1] : r2[0]; r3 = kp + __shfl_xor(snd, 8); }
    r3 += __shfl_xor(r3, 4); r3 += __shfl_xor(r3, 2); r3 += __shfl_xor(r3, 1);
    r3 *= (1.0f / 2048.0f);
    const float g = __shfl(gatev, e0 + (lane >> 3));
    const float wv = g * (0.5f / 128.0f) * r3 * (1.0f + erff(r3 * 0.70710678118654752f));
#pragma unroll
    for (int j = 0; j < 8; ++j) { const float w = __int_as_float(__builtin_amdgcn_readlane(__float_as_int(wv), 8 * j)); const unsigned vw[4] = {vq[j].x, vq[j].y, vq[j].z, vq[j].w};
#pragma unroll
        for (int q = 0; q < 4; ++q) { const f32x2 lo = __builtin_amdgcn_cvt_pk_f32_fp8((int)vw[q], false), hi = __builtin_amdgcn_cvt_pk_f32_fp8((int)vw[q], true);
            y[4 * q] += w * lo[0]; y[4 * q + 1] += w * lo[1]; y[4 * q + 2] += w * hi[0]; y[4 * q + 3] += w * hi[1]; } }
}
#else
__device__ __forceinline__ void peer_group8(const bf16* PUp, const bf16* PVp, Frame& F, const v4u hA, const v4u hB, unsigned idxv, float gatev, int e0, float (&y)[16]) {
    const int lane = F.lane;
    v4u uA[8], uB[8], vA[8], vB[8];
#pragma unroll
    for (int j = 0; j < 8; ++j) { const unsigned e = (unsigned)__builtin_amdgcn_readlane((int)idxv, e0 + j);
        const bf16* up = PUp + (size_t)e * DM + 8 * lane; const bf16* vp = PVp + (size_t)e * DM + 8 * lane;
        uA[j] = *(const v4u*)up; uB[j] = *(const v4u*)(up + 512); vA[j] = *(const v4u*)vp; vB[j] = *(const v4u*)(vp + 512); }
    float p[8];
#pragma unroll
    for (int j = 0; j < 8; ++j) p[j] = dot8(hB, uB[j], dot8(hA, uA[j], 0.f));
    const bool b5 = lane & 32, b4 = lane & 16, b3 = lane & 8;
    float r[4];
#pragma unroll
    for (int i = 0; i < 4; ++i) { const float snd = b5 ? p[i] : p[i + 4], kp = b5 ? p[i + 4] : p[i]; r[i] = kp + __shfl_xor(snd, 32); }
    float r2[2];
#pragma unroll
    for (int i = 0; i < 2; ++i) { const float snd = b4 ? r[i] : r[i + 2], kp = b4 ? r[i + 2] : r[i]; r2[i] = kp + __shfl_xor(snd, 16); }
    float r3; { const float snd = b3 ? r2[0] : r2[1], kp = b3 ? r2[1] : r2[0]; r3 = kp + __shfl_xor(snd, 8); }
    r3 += __shfl_xor(r3, 4); r3 += __shfl_xor(r3, 2); r3 += __shfl_xor(r3, 1);
    const float g = __shfl(gatev, e0 + (lane >> 3));
    const float wv = g * 0.5f * r3 * (1.0f + erff(r3 * 0.70710678118654752f));
#pragma unroll
    for (int j = 0; j < 8; ++j) { const float w = __int_as_float(__builtin_amdgcn_readlane(__float_as_int(wv), 8 * j)); axpy8(y, 0, w, vA[j]); axpy8(y, 8, w, vB[j]); }
}
#endif
__device__ __forceinline__ void phase_peer_expert(const Args& A0, Frame& F0, int l) {
    LAUNDER();
    const int lane = opqv(F.lane); const bf16* const PUp = P_PU; const bf16* const PVp = P_PV;
    for (int tok = F.gw; tok < NTOK; tok += F.NGW) {
        const int b = tok >> 11;
        const v4u hA = *(const v4u*)(P_HB + (size_t)tok * DM + 8 * lane), hB = *(const v4u*)(P_HB + (size_t)tok * DM + 512 + 8 * lane);
        const unsigned i0 = P_IDX[(size_t)tok * 128 + lane], i1 = P_IDX[(size_t)tok * 128 + 64 + lane];
        const float g0 = P_GATE[(size_t)tok * 128 + lane], g1 = P_GATE[(size_t)tok * 128 + 64 + lane];
        float y[16];
#pragma unroll
        for (int i = 0; i < 16; ++i) y[i] = 0.f;
        for (int rep = 0; rep < ((PROBE_MASK & 64) ? 2 : 1); ++rep) {
#if PEER_FP8
        float hf[16]; { const unsigned hw[8] = {hA.x, hA.y, hA.z, hA.w, hB.x, hB.y, hB.z, hB.w};
#pragma unroll
          for (int i = 0; i < 8; ++i) { hf[2 * i] = bflo(hw[i]); hf[2 * i + 1] = bfhi(hw[i]); } }
        for (int grp = 0; grp < 8; ++grp) peer_group8(PUp, PVp, F, hf, i0, g0, grp * 8, y);
        for (int grp = 0; grp < 8; ++grp) peer_group8(PUp, PVp, F, hf, i1, g1, grp * 8, y);
#else
        for (int grp = 0; grp < 8; ++grp) peer_group8(PUp, PVp, F, hA, hB, i0, g0, grp * 8, y);
        for (int grp = 0; grp < 8; ++grp) peer_group8(PUp, PVp, F, hA, hB, i1, g1, grp * 8, y);
#endif
        }
        if (PROBE_MASK & 64) {
#pragma unroll
            for (int i = 0; i < 16; ++i) y[i] *= 0.5f; }
        const float* mod = P_MOD + ((size_t)l * 32 + b) * MODW;
        const Row16 xr = ld_row(P_X + (size_t)tok * DM, lane), gt = ld_row(mod + 5120, lane);
        Row16 v;
        v.a0 = xr.a0 * DN_ALPHA + (f32x4){y[0], y[1], y[2], y[3]} * gt.a0; v.a1 = xr.a1 * DN_ALPHA + (f32x4){y[4], y[5], y[6], y[7]} * gt.a1;
        v.b0 = xr.b0 * DN_ALPHA + (f32x4){y[8], y[9], y[10], y[11]} * gt.b0; v.b1 = xr.b1 * DN_ALPHA + (f32x4){y[12], y[13], y[14], y[15]} * gt.b1;
        const Row16 xn = layer_norm_row(v, IN_ln_g + (size_t)(l * 2 + 1) * DM, IN_ln_b + (size_t)(l * 2 + 1) * DM, lane);
        st_row(P_X + (size_t)tok * DM, lane, xn);
        if (l + 1 < DEPTH) { const float* mod2 = P_MOD + ((size_t)(l + 1) * 32 + b) * MODW; const Row16 sh = ld_row(mod2, lane), sc = ld_row(mod2 + 1024, lane);
            st_row_bf16(P_HB + (size_t)tok * DM, lane, modulate(xn, sc, sh)); }
    }
}

typedef short bf16x8 __attribute__((ext_vector_type(8)));
typedef float f32x16 __attribute__((ext_vector_type(16)));
typedef float f32x2_t __attribute__((ext_vector_type(2)));
typedef unsigned u32x2v __attribute__((ext_vector_type(2)));
#define MFMA32(a, b, c) __builtin_amdgcn_mfma_f32_32x32x16_bf16((a), (b), (c), 0, 0, 0)
__device__ __forceinline__ unsigned cvtpk(float lo, float hi) { f32x2_t v = {lo, hi}; bf16x2_t b = __builtin_convertvector(v, bf16x2_t); return __builtin_bit_cast(unsigned, b); }
__device__ __forceinline__ bf16x8 ld_frag(const bf16* p) { return __builtin_bit_cast(bf16x8, *(const v4u*)p); }
__device__ __forceinline__ bf16x8 ld_frag2(const bf16* p0, const bf16* p1) { const v2u a = *(const v2u*)p0, b = *(const v2u*)p1; v4u w; w.x = a.x; w.y = a.y; w.z = b.x; w.w = b.y; return __builtin_bit_cast(bf16x8, w); }

template <bool MASK>
__device__ __forceinline__ void sb_tile(const bf16* Kp, const bf16* Vp, const bf16x8 (&qf)[4], const bf16x8 (&kf)[4], const bf16x8 (&vf)[2][2], bf16x8 (&kn)[4], bf16x8 (&vn)[2][2], f32x16 (&oacc)[2], float& R, int s0, int s0n, int t, int lane, int h) {
#pragma unroll
    for (int kk = 0; kk < 4; ++kk) kn[kk] = ld_frag(Kp + ((size_t)((s0n >> 5) * 4 + kk) * 64 + lane) * 8);
#pragma unroll
    for (int db = 0; db < 2; ++db)
#pragma unroll
        for (int s2 = 0; s2 < 2; ++s2) vn[db][s2] = ld_frag(Vp + ((size_t)(((s0n >> 5) * 2 + db) * 2 + s2) * 64 + lane) * 8);
    f32x16 z;
#pragma unroll
    for (int i = 0; i < 16; ++i) z[i] = 0.f;
#pragma unroll
    for (int kk = 0; kk < 4; ++kk) z = MFMA32(kf[kk], qf[kk], z);
    float q[16], bt[16];
#pragma unroll
    for (int i = 0; i < 16; ++i) {
        const float e = __builtin_amdgcn_exp2f(fminf(z[i] * 1.4426950408889634f, 60.0f)), r = __builtin_amdgcn_rcpf(1.0f + e);
        const bool valid = !MASK || (s0 + (i & 3) + 8 * (i >> 2) + 4 * h < t);
        q[i] = valid ? r : 1.0f; bt[i] = valid ? e * r : 0.0f;
    }
    float a[16], G[4], P[4];
#pragma unroll
    for (int g = 0; g < 4; ++g) { a[4 * g + 3] = 1.0f; a[4 * g + 2] = q[4 * g + 3]; a[4 * g + 1] = a[4 * g + 2] * q[4 * g + 2]; a[4 * g] = a[4 * g + 1] * q[4 * g + 1]; G[g] = a[4 * g] * q[4 * g]; }
    { const u32x2v a01 = __builtin_amdgcn_permlane32_swap(__float_as_uint(G[0]), __float_as_uint(G[1]), false, false), b01 = __builtin_amdgcn_permlane32_swap(__float_as_uint(G[1]), __float_as_uint(G[0]), false, false);
      const u32x2v a23 = __builtin_amdgcn_permlane32_swap(__float_as_uint(G[2]), __float_as_uint(G[3]), false, false), b23 = __builtin_amdgcn_permlane32_swap(__float_as_uint(G[3]), __float_as_uint(G[2]), false, false);
      P[0] = __uint_as_float(h ? b01[0] : a01[1]); P[1] = __uint_as_float(h ? a01[0] : b01[1]); P[2] = __uint_as_float(h ? b23[0] : a23[1]); P[3] = __uint_as_float(h ? a23[0] : b23[1]); }
    float off[4]; float run = R;
#pragma unroll
    for (int g = 3; g >= 0; --g) { off[g] = run * (h == 0 ? P[g] : 1.0f); run *= G[g] * P[g]; }
    float w[16];
#pragma unroll
    for (int i = 0; i < 16; ++i) w[i] = bt[i] * (off[i >> 2] * a[i]);
    R = run;
    bf16x8 pf[2];
#pragma unroll
    for (int s2 = 0; s2 < 2; ++s2) { v4u pw; pw.x = cvtpk(w[8 * s2], w[8 * s2 + 1]); pw.y = cvtpk(w[8 * s2 + 2], w[8 * s2 + 3]); pw.z = cvtpk(w[8 * s2 + 4], w[8 * s2 + 5]); pw.w = cvtpk(w[8 * s2 + 6], w[8 * s2 + 7]); pf[s2] = __builtin_bit_cast(bf16x8, pw); }
#pragma unroll
    for (int db = 0; db < 2; ++db)
#pragma unroll
        for (int s2 = 0; s2 < 2; ++s2) oacc[db] = MFMA32(vf[db][s2], pf[s2], oacc[db]);
}
__device__ __forceinline__ void sb_block(const bf16* QBp, const bf16* KBp, const bf16* VTp, bf16* OBp, int bh, int t0, int r, int h) {
    const int t = t0 + r, lane = r + 32 * h;
    const bf16* Kp = KBp + (size_t)bh * SEQ * 64; const bf16* Vp = VTp + (size_t)bh * 64 * SEQ; const bf16* Qp = QBp + (size_t)bh * SEQ * 64;
    bf16x8 qf[4], ka[4], kb[4], va[2][2], vb[2][2];
#pragma unroll
    for (int kk = 0; kk < 4; ++kk) { qf[kk] = ld_frag(Qp + ((size_t)((t0 >> 5) * 4 + kk) * 64 + lane) * 8); ka[kk] = ld_frag(Kp + ((size_t)((t0 >> 5) * 4 + kk) * 64 + lane) * 8); }
#pragma unroll
    for (int db = 0; db < 2; ++db)
#pragma unroll
        for (int s2 = 0; s2 < 2; ++s2) va[db][s2] = ld_frag(Vp + ((size_t)(((t0 >> 5) * 2 + db) * 2 + s2) * 64 + lane) * 8);
    f32x16 oacc[2];
#pragma unroll
    for (int i = 0; i < 16; ++i) { oacc[0][i] = 0.f; oacc[1][i] = 0.f; }
    float R = 1.0f;
    sb_tile<true>(Kp, Vp, qf, ka, va, kb, vb, oacc, R, t0, t0 >= 32 ? t0 - 32 : 0, t, lane, h);
    for (int s0 = t0 - 32; s0 >= 0; s0 -= 64) {
        if (__all(R < 5.421010862427522e-20f)) break;
        sb_tile<false>(Kp, Vp, qf, kb, vb, ka, va, oacc, R, s0, s0 >= 32 ? s0 - 32 : 0, t, lane, h);
        if (s0 < 32 || __all(R < 5.421010862427522e-20f)) break;
        sb_tile<false>(Kp, Vp, qf, ka, va, kb, vb, oacc, R, s0 - 32, s0 >= 64 ? s0 - 64 : 0, t, lane, h);
    }
    bf16* op = OBp + ((size_t)((bh >> 3) * SEQ + t)) * 512 + (bh & 7) * 64 + 4 * h;
#pragma unroll
    for (int db = 0; db < 2; ++db)
#pragma unroll
        for (int g = 0; g < 4; ++g) { v2u o; o.x = cvtpk(oacc[db][4 * g], oacc[db][4 * g + 1]); o.y = cvtpk(oacc[db][4 * g + 2], oacc[db][4 * g + 3]); *(v2u*)(op + 32 * db + 8 * g) = o; }
}
__device__ __forceinline__ void attn_fast(const Args& A0, Frame& F0, int l) {
    LAUNDER();
    const int lane = F.lane, r = lane & 31, h = lane >> 5;
    const bf16* QBp = P_QB; const bf16* KBp = P_KB; const bf16* VTp = P_VT; bf16* OBp = P_OB;
    unsigned* qhead = (unsigned*)(A.ws + WS_CTL) + CW_QUEUE + 1024 * l;
    int shard = (int)blockIdx.x & 7, tried = 0;
    unsigned tkv = 0; if (lane == 0) tkv = __hip_atomic_fetch_add(qhead + 64 * shard, 1u, RLX_AGENT);
    unsigned tk = (unsigned)__builtin_amdgcn_readfirstlane((int)tkv);
    while (tried < 8) {
        if (tk >= 1024u) { shard = (shard + 1) & 7; ++tried; tkv = 0; if (lane == 0) tkv = __hip_atomic_fetch_add(qhead + 64 * shard, 1u, RLX_AGENT); tk = (unsigned)__builtin_amdgcn_readfirstlane((int)tkv); continue; }
        const int unit = shard * 1024 + (int)tk;
        tkv = 0; if (lane == 0) tkv = __hip_atomic_fetch_add(qhead + 64 * shard, 1u, RLX_AGENT);
        const int bh = unit >> 5, tb = (unit & 31) * 64;
        sb_block(QBp, KBp, VTp, OBp, bh, tb + 32, r, h);
        sb_block(QBp, KBp, VTp, OBp, bh, tb, r, h);
        tk = (unsigned)__builtin_amdgcn_readfirstlane((int)tkv);
    }
}

__device__ __forceinline__ void ce_desc(unsigned& x, unsigned& y) { const float fx = __uint_as_float(x), fy = __uint_as_float(y); x = __float_as_uint(fmaxf(fx, fy)); y = __float_as_uint(fminf(fx, fy)); }
__device__ __forceinline__ void sort16_desc(unsigned (&a)[16]) {
    ce_desc(a[0], a[13]); ce_desc(a[1], a[12]); ce_desc(a[2], a[15]); ce_desc(a[3], a[14]); ce_desc(a[4], a[8]); ce_desc(a[5], a[6]); ce_desc(a[7], a[11]); ce_desc(a[9], a[10]);
    ce_desc(a[0], a[5]); ce_desc(a[1], a[7]); ce_desc(a[2], a[9]); ce_desc(a[3], a[4]); ce_desc(a[6], a[13]); ce_desc(a[8], a[14]); ce_desc(a[10], a[15]); ce_desc(a[11], a[12]);
    ce_desc(a[0], a[1]); ce_desc(a[2], a[3]); ce_desc(a[4], a[5]); ce_desc(a[6], a[8]); ce_desc(a[7], a[9]); ce_desc(a[10], a[11]); ce_desc(a[12], a[13]); ce_desc(a[14], a[15]);
    ce_desc(a[0], a[2]); ce_desc(a[1], a[3]); ce_desc(a[4], a[10]); ce_desc(a[5], a[11]); ce_desc(a[6], a[7]); ce_desc(a[8], a[9]); ce_desc(a[12], a[14]); ce_desc(a[13], a[15]);
    ce_desc(a[1], a[2]); ce_desc(a[3], a[12]); ce_desc(a[4], a[6]); ce_desc(a[5], a[7]); ce_desc(a[8], a[10]); ce_desc(a[9], a[11]); ce_desc(a[13], a[14]);
    ce_desc(a[1], a[4]); ce_desc(a[2], a[6]); ce_desc(a[5], a[8]); ce_desc(a[7], a[10]); ce_desc(a[9], a[13]); ce_desc(a[11], a[14]);
    ce_desc(a[2], a[4]); ce_desc(a[3], a[6]); ce_desc(a[9], a[12]); ce_desc(a[11], a[13]);
    ce_desc(a[3], a[5]); ce_desc(a[6], a[8]); ce_desc(a[7], a[9]); ce_desc(a[10], a[12]);
    ce_desc(a[3], a[4]); ce_desc(a[5], a[6]); ce_desc(a[7], a[8]); ce_desc(a[9], a[10]); ce_desc(a[11], a[12]);
    ce_desc(a[6], a[7]); ce_desc(a[8], a[9]);
}
__device__ __forceinline__ void merge_top16(unsigned (&a)[16], const unsigned (&b)[16]) {
#pragma unroll
    for (int i = 0; i < 16; ++i) a[i] = __float_as_uint(fmaxf(__uint_as_float(a[i]), __uint_as_float(b[15 - i])));
#pragma unroll
    for (int j = 8; j > 0; j >>= 1)
#pragma unroll
        for (int i = 0; i < 16; ++i) { const int l = i ^ j; if (l > i) ce_desc(a[i], a[l]); }
}
__device__ __forceinline__ void topk_scores(const bf16* keyp, const bf16* qp, int lane, int hh, unsigned (&top)[16]) {
    bf16x8 qf[4], kf[4][4];
#pragma unroll
    for (int kk = 0; kk < 4; ++kk) qf[kk] = ld_frag(qp + ((size_t)kk * 64 + lane) * 8);
#pragma unroll
    for (int nb = 0; nb < 4; ++nb)
#pragma unroll
        for (int kk = 0; kk < 4; ++kk) kf[nb][kk] = ld_frag(keyp + ((size_t)(nb * 4 + kk) * 64 + lane) * 8);
#pragma unroll
    for (int nb = 0; nb < 4; ++nb) {
        f32x16 s;
#pragma unroll
        for (int i = 0; i < 16; ++i) s[i] = 0.f;
#pragma unroll
        for (int kk = 0; kk < 4; ++kk) s = MFMA32(kf[nb][kk], qf[kk], s);
        unsigned u[16];
#pragma unroll
        for (int i = 0; i < 16; ++i) u[i] = (__float_as_uint(s[i]) & ~127u) | (unsigned)(127 - (32 * nb + (i & 3) + 8 * (i >> 2) + 4 * hh));
        sort16_desc(u);
        if (nb == 0) {
#pragma unroll
            for (int i = 0; i < 16; ++i) top[i] = u[i];
        } else merge_top16(top, u);
    }
}
__device__ __forceinline__ void peer_topk_fast(const Args& A0, Frame& F0, int l) {
    LAUNDER();
    const int lane = F.lane, r = lane & 31, hh = lane >> 5;
    LAS unsigned char* nscr = (LAS unsigned char*)F.lds + (F.wave * 64 + lane) * 32;
    for (int item = F.gw; item < NTOK / 32; item += F.NGW) {
        const int tok = item * 32 + r;
        for (int pair = 0; pair < 4; ++pair) {
            unsigned mine[2][16];
#pragma unroll
            for (int p = 0; p < 2; ++p) {
                unsigned ta[16], tb[16];
                topk_scores(P_SK + ((size_t)((l * 2 + p) * 8 + 2 * pair)) * 128 * 64, P_PQ + ((size_t)((item * 8 + 2 * pair) * 2 + p)) * 2048, lane, hh, ta);
                topk_scores(P_SK + ((size_t)((l * 2 + p) * 8 + 2 * pair + 1)) * 128 * 64, P_PQ + ((size_t)((item * 8 + 2 * pair + 1) * 2 + p)) * 2048, lane, hh, tb);
                unsigned other[16];
#pragma unroll
                for (int i = 0; i < 16; ++i) { const u32x2v sw = __builtin_amdgcn_permlane32_swap(ta[i], tb[i], false, false);
                    mine[p][i] = hh ? sw[1] : sw[0]; other[i] = hh ? sw[0] : sw[1]; }
                merge_top16(mine[p], other);
            }
            const int head = 2 * pair + hh;
            float v1[16], v2[16];
#pragma unroll
            for (int i = 0; i < 16; ++i) { v1[i] = __uint_as_float(mine[0][i] & ~127u); v2[i] = __uint_as_float(mine[1][i] & ~127u); nscr[i] = (unsigned char)(127u - (mine[0][i] & 127u)); nscr[16 + i] = (unsigned char)(127u - (mine[1][i] & 127u)); }
#define CKEY(i, j) ((__float_as_uint(v1[i] + v2[j]) & ~255u) | (unsigned)(255 - ((i) * 16 + (j))))
            unsigned ct[16], gb[16], gc[16], gd[16];
#pragma unroll
            for (int j = 0; j < 16; ++j) ct[j] = CKEY(0, j);
            { int n = 0;
#pragma unroll
              for (int i = 1; i <= 2; ++i)
#pragma unroll
                  for (int j = 0; j < 16; ++j) if ((i + 1) * (j + 1) <= 16) { gb[n] = CKEY(i, j); ++n; }
#pragma unroll
              for (int q = 13; q < 16; ++q) gb[q] = 0xff800000u; }
            { int n = 0;
#pragma unroll
              for (int i = 3; i <= 7; ++i)
#pragma unroll
                  for (int j = 0; j < 16; ++j) if ((i + 1) * (j + 1) <= 16) { gc[n] = CKEY(i, j); ++n; }
#pragma unroll
              for (int q = 13; q < 16; ++q) gc[q] = 0xff800000u; }
#pragma unroll
            for (int i = 8; i < 16; ++i) gd[i - 8] = CKEY(i, 0);
#pragma unroll
            for (int q = 8; q < 16; ++q) gd[q] = 0xff800000u;
#undef CKEY
            sort16_desc(gb); sort16_desc(gc); sort16_desc(gd);
            merge_top16(ct, gb); merge_top16(gc, gd); merge_top16(ct, gc);
            LDS_WAIT(); asm volatile("" ::: "memory");
            float ev[16], es = 0.f; const float vmax = __uint_as_float(ct[0] & ~255u);
#pragma unroll
            for (int k = 0; k < 16; ++k) { ev[k] = __expf(__uint_as_float(ct[k] & ~255u) - vmax); es += ev[k]; }
            const float inv = __builtin_amdgcn_rcpf(es);
            unsigned idx[16];
#pragma unroll
            for (int k = 0; k < 16; ++k) { const unsigned code = 255u - (ct[k] & 255u); idx[k] = (unsigned)nscr[code >> 4] * 128u + (unsigned)nscr[16 + (code & 15u)]; }
            bf16* ip = P_IDX + (size_t)tok * 128 + head * 16; float* gp = P_GATE + (size_t)tok * 128 + head * 16;
            v4u iw0, iw1; iw0.x = idx[0] | (idx[1] << 16); iw0.y = idx[2] | (idx[3] << 16); iw0.z = idx[4] | (idx[5] << 16); iw0.w = idx[6] | (idx[7] << 16);
            iw1.x = idx[8] | (idx[9] << 16); iw1.y = idx[10] | (idx[11] << 16); iw1.z = idx[12] | (idx[13] << 16); iw1.w = idx[14] | (idx[15] << 16);
            *(v4u*)ip = iw0; *(v4u*)(ip + 8) = iw1;
#pragma unroll
            for (int k4 = 0; k4 < 4; ++k4) *(f32x4*)(gp + 4 * k4) = (f32x4){ev[4 * k4] * inv, ev[4 * k4 + 1] * inv, ev[4 * k4 + 2] * inv, ev[4 * k4 + 3] * inv};
            LDS_WAIT(); asm volatile("" ::: "memory");
        }
    }
}

__device__ __forceinline__ void hg_bar() { asm volatile("s_waitcnt lgkmcnt(0)" ::: "memory"); __builtin_amdgcn_s_barrier(); asm volatile("" ::: "memory"); }
#define MFMA16(a, b, c) __builtin_amdgcn_mfma_f32_16x16x32_bf16((a), (b), (c), 0, 0, 0)
__device__ __forceinline__ void hgrn_fast(const Args& A0, Frame& F0, int l) {
    LAUNDER();
    constexpr int QM_OFF = 0, KM_OFF = 8704, QI_OFF = 17408, KET_OFF = 26112, VT_OFF = 36352, AL_OFF = 46592, EBC_OFF = 49152, TOT_OFF = 49664, ST_OFF = 51712, OL_OFF = ST_OFF + 8 * 4352;
    static_assert(OL_OFF + 32 * 132 * 4 <= RING_BYTES, "hgrn LDS");
    const int tid = F.tid, lane = F.lane, w = F.wave, fr = lane & 15, fq = lane >> 4;
    const int d = tid & 127, tq = tid >> 7, et = tid >> 4, eg = (tid & 15) * 8;
    LAS unsigned char* L = F.lds;
    LAS float* TOT = (LAS float*)(L + TOT_OFF); LAS float* EBC = (LAS float*)(L + EBC_OFF); LAS float* OL = (LAS float*)(L + OL_OFF);
    for (int unit = blockIdx.x; unit < 128; unit += F.G) {
        const int b = unit >> 2, h = unit & 3;
        const size_t ebase = ((size_t)b * SEQ + 8 * tq) * 512 + h * 128 + d;
        const size_t obase = ((size_t)b * SEQ + et) * 512 + h * 128 + eg;
        const f32x4 gn0 = *(const f32x4*)(IN_hg_norm_g + l * 512 + h * 128 + eg), gn1 = *(const f32x4*)(IN_hg_norm_g + l * 512 + h * 128 + eg + 4);
        f32x4 S[8];
#pragma unroll
        for (int i = 0; i < 8; ++i) S[i] = (f32x4){0.f, 0.f, 0.f, 0.f};
        unsigned rgA[8], rqA[8], rvA[8], rgB[8], rqB[8], rvB[8];
#define HG_LOAD(c, rg, rq, rv) do { const size_t o_ = ebase + (size_t)(c) * 32 * 512; _Pragma("unroll") for (int i = 0; i < 8; ++i) { rg[i] = P_GLOG[o_ + i * 512]; rq[i] = P_QA[o_ + i * 512]; rv[i] = P_IA[o_ + i * 512]; } } while (0)
        float cs[8];
#define HG_PIN(r) do { _Pragma("unroll") for (int i = 0; i < 8; ++i) asm volatile("" : "+v"(r[i])); } while (0)
#define HG_TOT(rg) do { HG_PIN(rg); float run_ = 0.f; _Pragma("unroll") for (int i = 0; i < 8; ++i) { run_ += bf2f(rg[i]); cs[i] = run_; } TOT[tq * 128 + d] = run_; } while (0)
#define HG_STAGE(rg, rq, rv) do { HG_PIN(rq); HG_PIN(rv); const float t0_ = TOT[d], t1_ = TOT[128 + d], t2_ = TOT[256 + d], t3_ = TOT[384 + d]; \
            const float offs_ = (tq > 0 ? t0_ : 0.f) + (tq > 1 ? t1_ : 0.f) + (tq > 2 ? t2_ : 0.f), bmid_ = t0_ + t1_, bC_ = (t0_ + t1_) + (t2_ + t3_); \
            unsigned ke_[8], vv_[8]; const float emid_ = __expf(bmid_), ecm_ = __expf(bC_ - bmid_);     \
            _Pragma("unroll") for (int i = 0; i < 8; ++i) { const float bt_ = offs_ + cs[i], q_ = bf2f(rq[i]), k_ = 1.0f - __expf(bf2f(rg[i])); const int t_     = 8 * tq + i; \
                const float qmf_ = q_ * __expf(fminf(bt_ - bmid_, 80.f)), kmf_ = k_ * __expf(fminf(bmid_ - bt_, 80.f)); \
                const unsigned qm_ = cvtpk(qmf_, 0.f), km_ = cvtpk(kmf_, 0.f), qi_ = cvtpk(qmf_ * emid_, 0.f); ke_[i] = cvtpk(kmf_ * ecm_, 0.f); vv_[i] = rv[i]; \
                *(LAS unsigned short*)(L + QM_OFF + t_ * 272 + d * 2) = (unsigned short)qm_; *(LAS unsigned short*)(L + KM_OFF + t_ * 272 + d * 2) = (unsigned short)km_; *(LAS unsigned short*)(L + QI_OFF + t_ * 272 + d * 2) = (unsigned short)qi_; } \
            v4u kw_, vw_; kw_.x = (ke_[0] & 0xffffu) | (ke_[1] << 16); kw_.y = (ke_[2] & 0xffffu) | (ke_[3] << 16); kw_.z = (ke_[4] & 0xffffu) | (ke_[5] << 16); kw_.w = (ke_[6] & 0xffffu) | (ke_[7] << 16); \
            vw_.x = vv_[0] | (vv_[1] << 16); vw_.y = vv_[2] | (vv_[3] << 16); vw_.z = vv_[4] | (vv_[5] << 16); vw_.w = vv_[6] | (vv_[7] << 16); \
            *(LAS v4u*)(L + KET_OFF + d * 80 + tq * 16) = kw_; *(LAS v4u*)(L + VT_OFF + d * 80 + tq * 16) = vw_; \
            if (tq == 0) EBC[d] = __expf(bC_); } while (0)
        HG_LOAD(0, rgA, rqA, rvA); HG_TOT(rgA); hg_bar(); HG_STAGE(rgA, rqA, rvA); hg_bar();
        HG_LOAD(1, rgB, rqB, rvB);
        auto body = [&](const int c, unsigned (&cg)[8], unsigned (&cq)[8], unsigned (&cv)[8], unsigned (&lg)[8], unsigned (&lq)[8], unsigned (&lv)[8]) __attribute__((always_inline)) {
            const bool more = c + 1 < SEQ / 32;
            const v4u rga = *(const v4u*)(P_GA + obase + (size_t)c * 32 * 512);
            __builtin_amdgcn_sched_barrier(0);
            HG_LOAD((c + 2 < SEQ / 32 ? c + 2 : SEQ / 32 - 1), lg, lq, lv);
            bf16x8 kmf[4], qmf[4]; v4u qif[2][4];
            const int ats = w >> 1, att = w & 1;
            if (w < 4) {
#pragma unroll
                for (int ks = 0; ks < 4; ++ks) { kmf[ks] = *(const LAS bf16x8*)(L + KM_OFF + (16 * ats + fr) * 272 + (32 * ks + 8 * fq) * 2); qmf[ks] = *(const LAS bf16x8*)(L + QM_OFF + (16 * att + fr) * 272 + (32 * ks + 8 * fq) * 2); } }
#pragma unroll
            for (int tt = 0; tt < 2; ++tt)
#pragma unroll
                for (int ks = 0; ks < 4; ++ks) { const LAS unsigned char* qp = L + QI_OFF + (16 * tt + fr) * 272 + (32 * ks + 4 * fq) * 2; const v2u q0 = *(const LAS v2u*)qp, q1 = *(const LAS v2u*)(qp + 32);
                    qif[tt][ks].x = q0.x; qif[tt][ks].y = q0.y; qif[tt][ks].z = q1.x; qif[tt][ks].w = q1.y; }
            __builtin_amdgcn_sched_barrier(0);
            f32x4 o[2];
            { bf16x8 sf[4];
#pragma unroll
              for (int ks = 0; ks < 4; ++ks) { v4u pw; pw.x = cvtpk(S[2 * ks][0], S[2 * ks][1]); pw.y = cvtpk(S[2 * ks][2], S[2 * ks][3]); pw.z = cvtpk(S[2 * ks + 1][0], S[2 * ks + 1][1]); pw.w = cvtpk(S[2 * ks + 1][2], S[2 * ks + 1][3]); sf[ks] = __builtin_bit_cast(bf16x8, pw); }
#pragma unroll
              for (int tt = 0; tt < 2; ++tt) { o[tt] = (f32x4){0.f, 0.f, 0.f, 0.f};
#pragma unroll
                for (int ks = 0; ks < 4; ++ks) o[tt] = MFMA16(sf[ks], __builtin_bit_cast(bf16x8, qif[tt][ks]), o[tt]); } }
            if (w < 4) { f32x4 at = (f32x4){0.f, 0.f, 0.f, 0.f};
#pragma unroll
                for (int ks = 0; ks < 4; ++ks) at = MFMA16(kmf[ks], qmf[ks], at);
                const int t = 16 * att + fr, s0 = 16 * ats + 4 * fq; v2u aw;
                aw.x = cvtpk(s0 <= t ? at[0] : 0.f, s0 + 1 <= t ? at[1] : 0.f); aw.y = cvtpk(s0 + 2 <= t ? at[2] : 0.f, s0 + 3 <= t ? at[3] : 0.f);
                *(LAS v2u*)(L + AL_OFF + t * 80 + s0 * 2) = aw; }
            hg_bar();
            const bf16x8 vb = *(const LAS bf16x8*)(L + VT_OFF + (16 * w + fr) * 80 + 16 * fq);
            bf16x8 alf[2], kef[8]; f32x4 ebf[8];
#pragma unroll
            for (int tt = 0; tt < 2; ++tt) alf[tt] = *(const LAS bf16x8*)(L + AL_OFF + (16 * tt + fr) * 80 + 16 * fq);
#pragma unroll
            for (int dt = 0; dt < 8; ++dt) { ebf[dt] = *(const LAS f32x4*)(EBC + 16 * dt + 4 * fq); kef[dt] = *(const LAS bf16x8*)(L + KET_OFF + (16 * dt + fr) * 80 + 16 * fq); }
            __builtin_amdgcn_sched_barrier(0);
#pragma unroll
            for (int tt = 0; tt < 2; ++tt) { o[tt] = MFMA16(vb, alf[tt], o[tt]);
                *(LAS f32x4*)(OL + (16 * tt + fr) * 132 + 16 * w + 4 * fq) = o[tt]; }
#pragma unroll
            for (int dt = 0; dt < 8; ++dt) S[dt] = MFMA16(kef[dt], vb, S[dt] * ebf[dt]);
            if (more) HG_TOT(cg);
            hg_bar();
            { const f32x4 o0 = *(const LAS f32x4*)(OL + et * 132 + eg), o1 = *(const LAS f32x4*)(OL + et * 132 + eg + 4);
              float ss = ((o0[0] * o0[0] + o0[1] * o0[1]) + (o0[2] * o0[2] + o0[3] * o0[3])) + ((o1[0] * o1[0] + o1[1] * o1[1]) + (o1[2] * o1[2] + o1[3] * o1[3]));
              ss += dpp_f<0xB1>(ss); ss += dpp_f<0x4E>(ss); ss += dpp_f<0x141>(ss); ss += dpp_f<0x140>(ss);
              const float rstd = __builtin_amdgcn_rsqf(ss * (1.0f / 128.0f) + RMS_EPS);
              const f32x4 r0 = o0 * rstd * gn0 * (f32x4){bflo(rga.x), bfhi(rga.x), bflo(rga.y), bfhi(rga.y)}, r1 = o1 * rstd * gn1 * (f32x4){bflo(rga.z), bfhi(rga.z), bflo(rga.w), bfhi(rga.w)};
              *(v4u*)(P_OA + obase + (size_t)c * 32 * 512) = pk8(r0, r1); }
            if (more) HG_STAGE(cg, cq, cv);
            hg_bar();
        };
        for (int c = 0; c < SEQ / 32; c += 2) { body(c, rgB, rqB, rvB, rgA, rqA, rvA); body(c + 1, rgA, rqA, rvA, rgB, rqB, rvB); }
#undef HG_LOAD
#undef HG_TOT
#undef HG_PIN
#undef HG_STAGE
    }
}

#if PEER_KSLICE
typedef float f32x2v __attribute__((ext_vector_type(2)));
__device__ __forceinline__ f32x2v cvt8lo(unsigned w) { return __builtin_amdgcn_cvt_pk_f32_fp8((int)w, false); }
__device__ __forceinline__ f32x2v cvt8hi(unsigned w) { return __builtin_amdgcn_cvt_pk_f32_fp8((int)w, true); }
template <int CTRL> __device__ __forceinline__ float dppf(float v) { return __int_as_float(__builtin_amdgcn_update_dpp(0, __float_as_int(v), CTRL, 0xF, 0xF, true)); }
__device__ __forceinline__ float swap32_sum(float a, float b) { const u32x2v r = __builtin_amdgcn_permlane32_swap(__float_as_uint(a), __float_as_uint(b), false, false); return __uint_as_float(r[0]) + __uint_as_float(r[1]); }
__device__ __forceinline__ float swap16_sum(float a, float b) { const u32x2v r = __builtin_amdgcn_permlane16_swap(__float_as_uint(a), __float_as_uint(b), false, false); return __uint_as_float(r[0]) + __uint_as_float(r[1]); }
struct SlicePre { v4u ia, ib, x0, x1, x2, x3; };
__device__ __forceinline__ void slice_issue(const unsigned char* base, unsigned lofs, const SlicePre& P, v4u (&q)[16]) {
    const unsigned iw[8] = {P.ia.x, P.ia.y, P.ia.z, P.ia.w, P.ib.x, P.ib.y, P.ib.z, P.ib.w};
#pragma unroll
    for (int i = 0; i < 16; ++i) { const unsigned off = (((i & 1) ? (iw[i >> 1] >> 9) : (iw[i >> 1] << 7)) & 0x7fff80u) | lofs; q[i] = *(const v4u*)(base + off); }
}
__device__ __forceinline__ SlicePre u_pre(const bf16* HBp, const bf16* IDXp, int tok, int xs, int g, int m) {
    SlicePre P; P.ia = *(const v4u*)(IDXp + (size_t)tok * 128 + 16 * g); P.ib = *(const v4u*)(IDXp + (size_t)tok * 128 + 16 * g + 8);
    P.x0 = *(const v4u*)(HBp + (size_t)tok * DM + 128 * xs + 16 * m); P.x1 = *(const v4u*)(HBp + (size_t)tok * DM + 128 * xs + 16 * m + 8); P.x2 = P.x0; P.x3 = P.x0; return P;
}
__device__ __forceinline__ void u_compute(const SlicePre& P, const v4u (&uq)[16], bf16* dst, bool b2, bool b1, bool b0) {
    const unsigned hw[8] = {P.x0.x, P.x0.y, P.x0.z, P.x0.w, P.x1.x, P.x1.y, P.x1.z, P.x1.w};
    f32x2v hf[8];
#pragma unroll
    for (int i = 0; i < 8; ++i) hf[i] = (f32x2v){bflo(hw[i]), bfhi(hw[i])};
    float p[16];
#pragma unroll
    for (int i = 0; i < 16; ++i) { const unsigned uw[4] = {uq[i].x, uq[i].y, uq[i].z, uq[i].w}; f32x2v acc = (f32x2v){0.f, 0.f};
#pragma unroll
        for (int w = 0; w < 4; ++w) { acc += hf[2 * w] * cvt8lo(uw[w]); acc += hf[2 * w + 1] * cvt8hi(uw[w]); }
        if (PROBE_MASK & 16384) { unsigned uw2[4] = {uq[i].x, uq[i].y, uq[i].z, uq[i].w}; asm volatile("" : "+v"(uw2[0]), "+v"(uw2[1]), "+v"(uw2[2]), "+v"(uw2[3]));
#pragma unroll
            for (int w = 0; w < 4; ++w) { acc += hf[2 * w] * cvt8lo(uw2[w]); acc += hf[2 * w + 1] * cvt8hi(uw2[w]); }
            acc *= 0.5f; }
        p[i] = acc[0] + acc[1]; }
    float r[8], r2[4], r3[2];
#pragma unroll
    for (int j = 0; j < 8; ++j) { const float snd = b2 ? p[j] : p[8 + j], kp = b2 ? p[8 + j] : p[j]; r[j] = kp + dppf<0x141>(snd); }
#pragma unroll
    for (int j = 0; j < 4; ++j) { const float snd = b1 ? r[j] : r[4 + j], kp = b1 ? r[4 + j] : r[j]; r2[j] = kp + dppf<0x4E>(snd); }
#pragma unroll
    for (int j = 0; j < 2; ++j) { const float snd = b0 ? r2[j] : r2[2 + j], kp = b0 ? r2[2 + j] : r2[j]; r3[j] = kp + dppf<0xB1>(snd); }
    *(unsigned*)dst = pk2(r3[0], r3[1]);
}
#if U_MFMA
typedef long i64_t;
struct UPre { v4u id, h0, h1; };
__device__ __forceinline__ UPre um_pre(const unsigned char* HB8p, const bf16* IDXp, int tok, int fr) {
    UPre P; P.id = *(const v4u*)(IDXp + (size_t)tok * 128 + 8 * fr); const v4u* hp = (const v4u*)(HB8p + (size_t)tok * DM); P.h0 = hp[0]; P.h1 = hp[1]; return P; }
__device__ __forceinline__ void um_issue(const unsigned char* tab, const UPre& P, v4u (&q)[16]) {
    const unsigned iw[4] = {P.id.x, P.id.y, P.id.z, P.id.w};
#pragma unroll
    for (int T = 0; T < 8; ++T) { const unsigned e = (T & 1) ? (iw[T >> 1] >> 16) : (iw[T >> 1] & 0xffffu); const v4u* rp = (const v4u*)(tab + (size_t)e * 128); q[2 * T] = rp[0]; q[2 * T + 1] = rp[1]; }
}
__device__ __forceinline__ i64_t mk64(unsigned lo, unsigned hi) { return (i64_t)(((unsigned long long)hi << 32) | lo); }
__device__ __forceinline__ void um_compute(const UPre& P, const v4u (&q)[16], bf16* dst, int fr) {
    const i64_t b0 = mk64(P.h0.x, P.h0.y), b1 = mk64(P.h0.z, P.h0.w), b2 = mk64(P.h1.x, P.h1.y), b3 = mk64(P.h1.z, P.h1.w);
    float val[8];
#pragma unroll
    for (int T = 0; T < 8; ++T) { f32x4 acc = (f32x4){0.f, 0.f, 0.f, 0.f};
        acc = __builtin_amdgcn_mfma_f32_16x16x32_fp8_fp8(mk64(q[2 * T].x, q[2 * T].y), b0, acc, 0, 0, 0); acc = __builtin_amdgcn_mfma_f32_16x16x32_fp8_fp8(mk64(q[2 * T].z, q[2 * T].w), b1, acc, 0, 0, 0);
        acc = __builtin_amdgcn_mfma_f32_16x16x32_fp8_fp8(mk64(q[2 * T + 1].x, q[2 * T + 1].y), b2, acc, 0, 0, 0); acc = __builtin_amdgcn_mfma_f32_16x16x32_fp8_fp8(mk64(q[2 * T + 1].z, q[2 * T + 1].w), b3, acc, 0, 0, 0);
        const float v01 = (fr & 1) ? acc[1] : acc[0], v23 = (fr & 1) ? acc[3] : acc[2]; val[T] = (fr & 2) ? v23 : v01; }
    if (fr < 4) { v4u w; w.x = pk2(val[0], val[1]); w.y = pk2(val[2], val[3]); w.z = pk2(val[4], val[5]); w.w = pk2(val[6], val[7]); *(v4u*)dst = w; }
}
__device__ __forceinline__ void peer_slice_u(const Args& A0, Frame& F0) {
    LAUNDER();
    const int lane = F.lane, fr = lane & 15, fq = lane >> 4;
    const int xs = blockIdx.x & 7, nwv = (F.G >> 3) * NWAVES, wv = (blockIdx.x >> 3) * NWAVES + F.wave;
    const unsigned char* tab = (const unsigned char*)P_PU + (size_t)xs * 16384 * 128 + 32 * fq;
    const unsigned char* HB8p = P_HB8 + 128 * xs + 32 * fq; const bf16* IDXp = P_IDX;
    bf16* part = (bf16*)P_PART + (size_t)xs * NTOK * 128 + 8 * (4 * fq + (fr & 3));
    const int n = (NTOK - wv + nwv - 1) / nwv;
#define TOKK(k) (wv + ((k) < n ? (k) : n - 1) * nwv)
    v4u qa[16], qb[16];
    UPre pa = um_pre(HB8p, IDXp, TOKK(0), fr); um_issue(tab, pa, qa);
    UPre pb = um_pre(HB8p, IDXp, TOKK(1), fr);
    for (int k = 0; k < n; k += 2) {
        um_issue(tab, pb, qb);
        const UPre pc = um_pre(HB8p, IDXp, TOKK(k + 2), fr);
        um_compute(pa, qa, part + (size_t)TOKK(k) * 128, fr);
        um_issue(tab, pc, qa);
        const UPre pd = um_pre(HB8p, IDXp, TOKK(k + 3), fr);
        if (k + 1 < n) um_compute(pb, qb, part + (size_t)TOKK(k + 1) * 128, fr);
        pa = pc; pb = pd;
    }
#undef TOKK
}
#else
#if U_INT8
template <int CTRL> __device__ __forceinline__ int dppi(int v) { return __builtin_amdgcn_update_dpp(0, v, CTRL, 0xF, 0xF, true); }
__device__ __forceinline__ SlicePre u_pre8(const unsigned char* HB8p, const float* HSCp, const bf16* IDXp, int tok, int g) {
    SlicePre P; P.ia = *(const v4u*)(IDXp + (size_t)tok * 128 + 16 * g); P.ib = *(const v4u*)(IDXp + (size_t)tok * 128 + 16 * g + 8);
    P.x0 = *(const v4u*)(HB8p + (size_t)tok * DM); P.x1 = (v4u){__float_as_uint(HSCp[tok]), 0u, 0u, 0u}; P.x2 = P.x0; P.x3 = P.x0; return P;
}
__device__ __forceinline__ void u_compute8(const SlicePre& P, const v4u (&uq)[16], bf16* dst, bool b2, bool b1, bool b0) {
    int p[16];
#pragma unroll
    for (int i = 0; i < 16; ++i) p[i] = __builtin_amdgcn_sdot4((int)P.x0.w, (int)uq[i].w, __builtin_amdgcn_sdot4((int)P.x0.z, (int)uq[i].z, __builtin_amdgcn_sdot4((int)P.x0.y, (int)uq[i].y, __builtin_amdgcn_sdot4((int)P.x0.x, (int)uq[i].x, 0, false), false), false), false);
    int r[8], r2[4], r3[2];
#pragma unroll
    for (int j = 0; j < 8; ++j) { const int snd = b2 ? p[j] : p[8 + j], kp = b2 ? p[8 + j] : p[j]; r[j] = kp + dppi<0x141>(snd); }
#pragma unroll
    for (int j = 0; j < 4; ++j) { const int snd = b1 ? r[j] : r[4 + j], kp = b1 ? r[4 + j] : r[j]; r2[j] = kp + dppi<0x4E>(snd); }
#pragma unroll
    for (int j = 0; j < 2; ++j) { const int snd = b0 ? r2[j] : r2[2 + j], kp = b0 ? r2[2 + j] : r2[j]; r3[j] = kp + dppi<0xB1>(snd); }
    const float sc = __uint_as_float(P.x1.x) * (1.0f / 600.0f);
    *(unsigned*)dst = pk2((float)r3[0] * sc, (float)r3[1] * sc);
}
#endif
__device__ __forceinline__ void peer_slice_u(const Args& A0, Frame& F0) {
    LAUNDER();
    const int lane = F.lane, g = lane >> 3, m = lane & 7;
    const int xs = blockIdx.x & 7, nwv = (F.G >> 3) * NWAVES, wv = (blockIdx.x >> 3) * NWAVES + F.wave;
    const unsigned char* tab = (const unsigned char*)P_PU + (size_t)xs * 16384 * 128; const unsigned lofs = 16u * (unsigned)m;
    bf16* part = (bf16*)P_PART + (size_t)xs * NTOK * 128 + 2 * lane;
    const bf16* HBp = P_HB; const bf16* IDXp = P_IDX; const unsigned char* HB8p = P_HB8 + 128 * xs + 16 * m; const float* HSCp = P_HSC; (void)HBp; (void)HB8p; (void)HSCp;
    const bool b2 = m & 4, b1 = m & 2, b0 = m & 1;
    const int n = (NTOK - wv + nwv - 1) / nwv;
#if U_INT8
#define UPRE(t) u_pre8(HB8p, HSCp, IDXp, (t), g)
#define UCOMP(P_, q_, d_) u_compute8(P_, q_, d_, b2, b1, b0)
#else
#define UPRE(t) u_pre(HBp, IDXp, (t), xs, g, m)
#define UCOMP(P_, q_, d_) u_compute(P_, q_, d_, b2, b1, b0)
#endif
#define TOKK(k) (wv + ((k) < n ? (k) : n - 1) * nwv)
    v4u qa[16], qb[16];
    SlicePre pa = UPRE(TOKK(0)); slice_issue(tab, lofs, pa, qa);
    SlicePre pb = UPRE(TOKK(1));
    for (int k = 0; k < n; k += 2) {
        slice_issue(tab, lofs, pb, qb);
        const SlicePre pc = UPRE(TOKK(k + 2));
        UCOMP(pa, qa, part + (size_t)TOKK(k) * 128);
        slice_issue(tab, lofs, pc, qa);
        const SlicePre pd = UPRE(TOKK(k + 3));
        if (k + 1 < n) UCOMP(pb, qb, part + (size_t)TOKK(k + 1) * 128);
        pa = pc; pb = pd;
    }
#undef TOKK
}
#endif
__device__ __forceinline__ void peer_slice_r(const Args& A0, Frame& F0) {
    LAUNDER();
    const int gt = F.vcu * NTHREADS + F.tid, NGT = F.G * NTHREADS;
    for (int i = gt; i < NTOK * 128 / 4; i += NGT) {
        f32x4 s = (f32x4){0.f, 0.f, 0.f, 0.f};
#pragma unroll
        for (int q = 0; q < 8; ++q) { const v2u w = *(const v2u*)((const bf16*)P_PART + (size_t)q * NTOK * 128 + (size_t)i * 4); s = s + (f32x4){bflo(w.x), bfhi(w.x), bflo(w.y), bfhi(w.y)}; }
        const f32x4 gv = *(const f32x4*)(P_GATE + (size_t)i * 4); f32x4 o;
#pragma unroll
        for (int j = 0; j < 4; ++j) { const float pre = s[j] * (U_INT8 ? 1.0f : (U_MFMA ? (1.0f / (2048.0f * 16.0f)) : (1.0f / 2048.0f))); o[j] = gv[j] * (0.5f / 128.0f) * pre * (1.0f + erff(pre * 0.70710678118654752f)); }
        *(f32x4*)(P_GATE + (size_t)i * 4) = o;
    }
}
__device__ __forceinline__ SlicePre v_pre(const float* Wp, const bf16* IDXp, int tok, int g) {
    SlicePre P; P.ia = *(const v4u*)(IDXp + (size_t)tok * 128 + 16 * g); P.ib = *(const v4u*)(IDXp + (size_t)tok * 128 + 16 * g + 8);
    const v4u* w = (const v4u*)(Wp + (size_t)tok * 128 + 16 * g); P.x0 = w[0]; P.x1 = w[1]; P.x2 = w[2]; P.x3 = w[3]; return P;
}
__device__ __forceinline__ void v_compute(const SlicePre& P, const v4u (&vq)[16], bf16* dst, bool b3) {
    const unsigned ww[16] = {P.x0.x, P.x0.y, P.x0.z, P.x0.w, P.x1.x, P.x1.y, P.x1.z, P.x1.w, P.x2.x, P.x2.y, P.x2.z, P.x2.w, P.x3.x, P.x3.y, P.x3.z, P.x3.w};
    f32x2v acc[8];
#pragma unroll
    for (int q = 0; q < 8; ++q) acc[q] = (f32x2v){0.f, 0.f};
#pragma unroll
    for (int i = 0; i < 16; ++i) { const unsigned vw[4] = {vq[i].x, vq[i].y, vq[i].z, vq[i].w}; const float wi = __uint_as_float(ww[i]); const f32x2v w2 = (f32x2v){wi, wi};
#pragma unroll
        for (int w = 0; w < 4; ++w) { acc[2 * w] += w2 * cvt8lo(vw[w]); acc[2 * w + 1] += w2 * cvt8hi(vw[w]); } }
    float a[16], r[8], r2[4], r3[2];
#pragma unroll
    for (int q = 0; q < 8; ++q) { a[2 * q] = acc[q][0]; a[2 * q + 1] = acc[q][1]; }
#pragma unroll
    for (int j = 0; j < 8; ++j) r[j] = swap32_sum(a[j], a[8 + j]);
#pragma unroll
    for (int j = 0; j < 4; ++j) r2[j] = swap16_sum(r[j], r[4 + j]);
#pragma unroll
    for (int j = 0; j < 2; ++j) { const float snd = b3 ? r2[j] : r2[2 + j], kp = b3 ? r2[2 + j] : r2[j]; r3[j] = kp + dppf<0x128>(snd); }
    *(unsigned*)dst = pk2(r3[0], r3[1]);
}
__device__ __forceinline__ void peer_slice_v(const Args& A0, Frame& F0) {
    LAUNDER();
    const int lane = F.lane, g = lane >> 3, m = lane & 7;
    const int xs = blockIdx.x & 7, nwv = (F.G >> 3) * NWAVES, wv = (blockIdx.x >> 3) * NWAVES + F.wave;
    const unsigned char* tab = (const unsigned char*)P_PV + (size_t)xs * 16384 * 128; const unsigned lofs = 16u * (unsigned)m;
    const bool b5 = lane & 32, b4 = lane & 16, b3 = lane & 8;
    bf16* yp = P_Y + 128 * xs + 16 * m + (b5 ? 8 : 0) + (b4 ? 4 : 0) + (b3 ? 2 : 0);
    const float* Wp = P_GATE; const bf16* IDXp = P_IDX;
    const int n = (NTOK - wv + nwv - 1) / nwv;
#define TOKK(k) (wv + ((k) < n ? (k) : n - 1) * nwv)
    v4u qa[16], qb[16];
    SlicePre pa = v_pre(Wp, IDXp, TOKK(0), g); slice_issue(tab, lofs, pa, qa);
    SlicePre pb = v_pre(Wp, IDXp, TOKK(1), g);
    for (int k = 0; k < n; k += 2) {
        slice_issue(tab, lofs, pb, qb);
        const SlicePre pc = v_pre(Wp, IDXp, TOKK(k + 2), g);
        v_compute(pa, qa, yp + (size_t)TOKK(k) * DM, b3);
        slice_issue(tab, lofs, pc, qa);
        const SlicePre pd = v_pre(Wp, IDXp, TOKK(k + 3), g);
        if (k + 1 < n) v_compute(pb, qb, yp + (size_t)TOKK(k + 1) * DM, b3);
        pa = pc; pb = pd;
    }
#undef TOKK
}
#if PEER_Q4
struct Ids { v4u a, b; };
__device__ __forceinline__ Ids ld_ids(const bf16* IDXp, int tok, int g) { Ids I; I.a = *(const v4u*)(IDXp + (size_t)tok * 128 + 16 * g); I.b = *(const v4u*)(IDXp + (size_t)tok * 128 + 16 * g + 8); return I; }
__device__ __forceinline__ void ids_issue(const unsigned char* base, unsigned lofs, const Ids& I, v4u (&q)[16]) {
    const unsigned iw[8] = {I.a.x, I.a.y, I.a.z, I.a.w, I.b.x, I.b.y, I.b.z, I.b.w};
#pragma unroll
    for (int i = 0; i < 16; ++i) { const unsigned off = (((i & 1) ? (iw[i >> 1] >> 9) : (iw[i >> 1] << 7)) & 0x7fff80u) | lofs; q[i] = *(const v4u*)(base + off); }
}
struct UX { v4u a, b; float sc; };
__device__ __forceinline__ UX ld_ux(const unsigned char* H4p, const float* HSCp, int tok) { UX X; X.a = *(const v4u*)(H4p + (size_t)tok * DM); X.b = *(const v4u*)(H4p + (size_t)tok * DM + 16); X.sc = HSCp[tok]; return X; }
__device__ __forceinline__ int dot8x4(const v4u& h, const v4u& u) { return __builtin_amdgcn_sdot8((int)h.w, (int)u.w, __builtin_amdgcn_sdot8((int)h.z, (int)u.z, __builtin_amdgcn_sdot8((int)h.y, (int)u.y, __builtin_amdgcn_sdot8((int)h.x, (int)u.x, 0, false), false), false), false); }
__device__ __forceinline__ void u4_compute(const UX& X, const v4u (&uq)[16], bf16* dst, bool b2, bool b1, bool b0) {
    int p[16];
#pragma unroll
    for (int i = 0; i < 16; ++i) { p[i] = (dot8x4(X.a, uq[i]) << 4) + dot8x4(X.b, uq[i]);
        if (PROBE_MASK & 16384) { v4u u2 = uq[i]; asm volatile("" : "+v"(u2.x), "+v"(u2.y), "+v"(u2.z), "+v"(u2.w)); p[i] = (p[i] + (dot8x4(X.a, u2) << 4) + dot8x4(X.b, u2)) >> 1; } }
    int r[8], r2[4], r3[2];
#pragma unroll
    for (int j = 0; j < 8; ++j) { const int snd = b2 ? p[j] : p[8 + j], kp = b2 ? p[8 + j] : p[j]; r[j] = kp + dppi<0x141>(snd); }
#pragma unroll
    for (int j = 0; j < 4; ++j) { const int snd = b1 ? r[j] : r[4 + j], kp = b1 ? r[4 + j] : r[j]; r2[j] = kp + dppi<0x4E>(snd); }
#pragma unroll
    for (int j = 0; j < 2; ++j) { const int snd = b0 ? r2[j] : r2[2 + j], kp = b0 ? r2[2 + j] : r2[j]; r3[j] = kp + dppi<0xB1>(snd); }
    *(unsigned*)dst = pk2((float)r3[0] * X.sc, (float)r3[1] * X.sc);
}
__device__ __forceinline__ void peer4_u(const Args& A0, Frame& F0) {
    LAUNDER();
    const int lane = F.lane, g = lane >> 3, m = lane & 7;
    const int xs = blockIdx.x & 3, nwv = (F.G >> 2) * NWAVES, wv = (blockIdx.x >> 2) * NWAVES + F.wave;
    const unsigned char* tab = (const unsigned char*)P_PU + (size_t)xs * 16384 * 128; const unsigned lofs = 16u * (unsigned)m;
    bf16* part = (bf16*)P_PART + (size_t)xs * NTOK * 128 + 2 * lane;
    const bf16* IDXp = P_IDX; const unsigned char* H4p = P_HB8 + 256 * xs + 32 * m; const float* HSCp = P_HSC;
    const bool b2 = m & 4, b1 = m & 2, b0 = m & 1;
    const int n = (NTOK - wv + nwv - 1) / nwv;
#define TOKK(k) (wv + ((k) < n ? (k) : n - 1) * nwv)
    v4u qa[16], qb[16];
    Ids i1 = ld_ids(IDXp, TOKK(1), g), i2 = ld_ids(IDXp, TOKK(2), g);
    __builtin_amdgcn_sched_barrier(0);
    { const Ids i0 = ld_ids(IDXp, TOKK(0), g); ids_issue(tab, lofs, i0, qa); }
    UX x0 = ld_ux(H4p, HSCp, TOKK(0)), x1 = x0;
    for (int k = 0; k < n; k += 2) {
        ids_issue(tab, lofs, i1, qb); x1 = ld_ux(H4p, HSCp, TOKK(k + 1));
        i1 = ld_ids(IDXp, TOKK(k + 3), g);
        __builtin_amdgcn_sched_barrier(0);
        u4_compute(x0, qa, part + (size_t)TOKK(k) * 128, b2, b1, b0);
        __builtin_amdgcn_sched_barrier(0);
        ids_issue(tab, lofs, i2, qa); x0 = ld_ux(H4p, HSCp, TOKK(k + 2));
        i2 = ld_ids(IDXp, TOKK(k + 4), g);
        __builtin_amdgcn_sched_barrier(0);
        u4_compute(x1, qb, part + (size_t)TOKK(k + 1) * 128, b2, b1, b0);
        __builtin_amdgcn_sched_barrier(0);
    }
#undef TOKK
}
typedef _Float16 h16x2 __attribute__((ext_vector_type(2)));
__device__ __forceinline__ unsigned pkh2(float a, float b) { const h16x2 p = {(_Float16)a, (_Float16)b}; return __builtin_bit_cast(unsigned, p); }
__device__ __forceinline__ void peer4_r(const Args& A0, Frame& F0) {
    LAUNDER();
    const int gt = F.vcu * NTHREADS + F.tid, NGT = F.G * NTHREADS;
    constexpr int NI = NTOK * 128 / 8;
    struct RIn { v4u iw, p[4]; f32x4 g0, g1; };
    auto ldin = [&](int i) __attribute__((always_inline)) { RIn r; r.iw = *(const v4u*)(P_IDX + (size_t)i * 8);
#pragma unroll
        for (int q = 0; q < 4; ++q) r.p[q] = *(const v4u*)((const bf16*)P_PART + (size_t)q * NTOK * 128 + (size_t)i * 8);
        r.g0 = *(const f32x4*)(P_GATE + (size_t)i * 8); r.g1 = *(const f32x4*)(P_GATE + (size_t)i * 8 + 4); return r; };
    auto eval = [&](const RIn& r, int i) __attribute__((always_inline)) {
        const unsigned e[8] = {r.iw.x & 0xffffu, r.iw.x >> 16, r.iw.y & 0xffffu, r.iw.y >> 16, r.iw.z & 0xffffu, r.iw.z >> 16, r.iw.w & 0xffffu, r.iw.w >> 16};
        f32x2 sc[8];
#pragma unroll
        for (int j = 0; j < 8; ++j) sc[j] = *(const f32x2*)(P_SC + (size_t)e[j] * 2);
        float s[8];
#pragma unroll
        for (int j = 0; j < 8; ++j) s[j] = 0.f;
#pragma unroll
        for (int q = 0; q < 4; ++q) { const v4u w = r.p[q];
            s[0] += bflo(w.x); s[1] += bfhi(w.x); s[2] += bflo(w.y); s[3] += bfhi(w.y); s[4] += bflo(w.z); s[5] += bfhi(w.z); s[6] += bflo(w.w); s[7] += bfhi(w.w); }
        float o[8];
#pragma unroll
        for (int j = 0; j < 8; ++j) { const float pre = s[j] * sc[j][0], gv = j < 4 ? r.g0[j] : r.g1[j - 4]; o[j] = gv * sc[j][1] * 0.5f * pre * (1.0f + erff(pre * 0.70710678118654752f)); }
        v4u ow; ow.x = pkh2(o[0], o[1]); ow.y = pkh2(o[2], o[3]); ow.z = pkh2(o[4], o[5]); ow.w = pkh2(o[6], o[7]); *(v4u*)(P_W16 + (size_t)i * 8) = ow; };
#define CLI(i_) ((i_) < NI ? (i_) : NI - 1)
    RIn ra = ldin(CLI(gt));
    for (int i = gt; i < NI; i += 2 * NGT) {
        RIn rb = ldin(CLI(i + NGT));
        __builtin_amdgcn_sched_barrier(0);
        eval(ra, i);
        __builtin_amdgcn_sched_barrier(0);
        ra = ldin(CLI(i + 2 * NGT));
        __builtin_amdgcn_sched_barrier(0);
        eval(rb, CLI(i + NGT));
        __builtin_amdgcn_sched_barrier(0);
    }
#undef CLI
}
struct VX { v4u a, b; };
__device__ __forceinline__ VX ld_vx(const bf16* Wp, int tok, int g) { VX X; const v4u* w = (const v4u*)(Wp + (size_t)tok * 128 + 16 * g); X.a = w[0]; X.b = w[1]; return X; }
template <int K> __device__ __forceinline__ h16x2 cvt4h(unsigned w) { return __builtin_amdgcn_cvt_scalef32_pk_f16_fp4(w, 1.0f, K); }
__device__ __forceinline__ unsigned swap32_sumh(unsigned a, unsigned b) { const u32x2v r = __builtin_amdgcn_permlane32_swap(a, b, false, false); unsigned x = r[0], y = r[1]; asm volatile("" : "+v"(x), "+v"(y)); return __builtin_bit_cast(unsigned, __builtin_bit_cast(h16x2, x) + __builtin_bit_cast(h16x2, y)); }
__device__ __forceinline__ unsigned swap16_sumh(unsigned a, unsigned b) { const u32x2v r = __builtin_amdgcn_permlane16_swap(a, b, false, false); unsigned x = r[0], y = r[1]; asm volatile("" : "+v"(x), "+v"(y)); return __builtin_bit_cast(unsigned, __builtin_bit_cast(h16x2, x) + __builtin_bit_cast(h16x2, y)); }
__device__ __forceinline__ void v4_compute(const VX& X, const v4u (&vq)[16], bf16* dst, bool b3) {
    const unsigned ww[8] = {X.a.x, X.a.y, X.a.z, X.a.w, X.b.x, X.b.y, X.b.z, X.b.w};
    h16x2 acc[16];
#pragma unroll
    for (int q = 0; q < 16; ++q) acc[q] = (h16x2){(_Float16)0, (_Float16)0};
#pragma unroll
    for (int i = 0; i < 16; ++i) { const unsigned vw[4] = {vq[i].x, vq[i].y, vq[i].z, vq[i].w}; const h16x2 wp = __builtin_bit_cast(h16x2, ww[i >> 1]); const _Float16 wi = (i & 1) ? wp[1] : wp[0]; const h16x2 w2 = {wi, wi};
#pragma unroll
        for (int w = 0; w < 4; ++w) { acc[4 * w] += w2 * cvt4h<0>(vw[w]); acc[4 * w + 1] += w2 * cvt4h<1>(vw[w]); acc[4 * w + 2] += w2 * cvt4h<2>(vw[w]); acc[4 * w + 3] += w2 * cvt4h<3>(vw[w]); } }
    unsigned a[16], r[8], r2[4], r3[2];
#pragma unroll
    for (int q = 0; q < 16; ++q) a[q] = __builtin_bit_cast(unsigned, acc[q]);
#pragma unroll
    for (int j = 0; j < 8; ++j) r[j] = swap32_sumh(a[j], a[8 + j]);
#pragma unroll
    for (int j = 0; j < 4; ++j) r2[j] = swap16_sumh(r[j], r[4 + j]);
#pragma unroll
    for (int j = 0; j < 2; ++j) { const unsigned snd = b3 ? r2[j] : r2[2 + j], kp = b3 ? r2[2 + j] : r2[j];
        const unsigned got = (unsigned)__builtin_amdgcn_update_dpp(0, (int)snd, 0x128, 0xF, 0xF, true);
        r3[j] = __builtin_bit_cast(unsigned, __builtin_bit_cast(h16x2, kp) + __builtin_bit_cast(h16x2, got)); }
    const h16x2 y0 = __builtin_bit_cast(h16x2, r3[0]), y1 = __builtin_bit_cast(h16x2, r3[1]);
    v2u o; o.x = pk2((float)y0[0], (float)y0[1]); o.y = pk2((float)y1[0], (float)y1[1]); *(v2u*)dst = o;
}
__device__ __forceinline__ void peer4_v(const Args& A0, Frame& F0) {
    LAUNDER();
    const int lane = F.lane, g = lane >> 3, m = lane & 7;
    const int xs = blockIdx.x & 3, nwv = (F.G >> 2) * NWAVES, wv = (blockIdx.x >> 2) * NWAVES + F.wave;
    const unsigned char* tab = (const unsigned char*)P_PV + (size_t)xs * 16384 * 128; const unsigned lofs = 16u * (unsigned)m;
    const bool b5 = lane & 32, b4 = lane & 16, b3 = lane & 8;
    bf16* yp = P_Y + 256 * xs + 32 * m + (b5 ? 16 : 0) + (b4 ? 8 : 0) + (b3 ? 4 : 0);
    const bf16* Wp = P_W16; const bf16* IDXp = P_IDX;
    const int n = (NTOK - wv + nwv - 1) / nwv;
#define TOKK(k) (wv + ((k) < n ? (k) : n - 1) * nwv)
    v4u qa[16], qb[16];
    Ids i1 = ld_ids(IDXp, TOKK(1), g), i2 = ld_ids(IDXp, TOKK(2), g);
    __builtin_amdgcn_sched_barrier(0);
    { const Ids i0 = ld_ids(IDXp, TOKK(0), g); ids_issue(tab, lofs, i0, qa); }
    VX x0 = ld_vx(Wp, TOKK(0), g), x1 = x0;
    for (int k = 0; k < n; k += 2) {
        ids_issue(tab, lofs, i1, qb); x1 = ld_vx(Wp, TOKK(k + 1), g);
        i1 = ld_ids(IDXp, TOKK(k + 3), g);
        __builtin_amdgcn_sched_barrier(0);
        v4_compute(x0, qa, yp + (size_t)TOKK(k) * DM, b3);
        __builtin_amdgcn_sched_barrier(0);
        ids_issue(tab, lofs, i2, qa); x0 = ld_vx(Wp, TOKK(k + 2), g);
        i2 = ld_ids(IDXp, TOKK(k + 4), g);
        __builtin_amdgcn_sched_barrier(0);
        v4_compute(x1, qb, yp + (size_t)TOKK(k + 1) * DM, b3);
        __builtin_amdgcn_sched_barrier(0);
    }
#undef TOKK
}
#endif
#if PEER_Q4
#define PEER_PH_U peer4_u
#define PEER_PH_R peer4_r
#define PEER_PH_V peer4_v
#else
#define PEER_PH_U peer_slice_u
#define PEER_PH_R peer_slice_r
#define PEER_PH_V peer_slice_v
#endif
__device__ __forceinline__ Row16 ln2_in(const bf16* Xp, const float* stats, const float* lng1, const float* lnb1, const bf16* Yp, const float* gtp, int tok, int lane) {
    const f32x2 st = *(const f32x2*)(stats + (size_t)tok * 2);
    const Row16 xr = layer_norm_apply(ld_row_bf16(Xp + (size_t)tok * DM, lane), st[0], st[1], lng1, lnb1, lane), gt = ld_row(gtp, lane);
    const v4u ya = *(const v4u*)(Yp + (size_t)tok * DM + 8 * lane), yb = *(const v4u*)(Yp + (size_t)tok * DM + 512 + 8 * lane);
    Row16 v;
    v.a0 = xr.a0 * DN_ALPHA + (f32x4){bflo(ya.x), bfhi(ya.x), bflo(ya.y), bfhi(ya.y)} * gt.a0; v.a1 = xr.a1 * DN_ALPHA + (f32x4){bflo(ya.z), bfhi(ya.z), bflo(ya.w), bfhi(ya.w)} * gt.a1;
    v.b0 = xr.b0 * DN_ALPHA + (f32x4){bflo(yb.x), bfhi(yb.x), bflo(yb.y), bfhi(yb.y)} * gt.b0; v.b1 = xr.b1 * DN_ALPHA + (f32x4){bflo(yb.z), bfhi(yb.z), bflo(yb.w), bfhi(yb.w)} * gt.b1;
    return v;
}
__device__ __forceinline__ void peer_slice_ln(const Args& A0, Frame& F0, int l) {
    LAUNDER();
    const int lane = F.lane; const RowSpan sp = wave_span(F.gw, F.NGW);
    const Row16 G2 = ld_row(IN_ln_g + (size_t)(l * 2 + 1) * DM, lane), B2 = ld_row(IN_ln_b + (size_t)(l * 2 + 1) * DM, lane);
    const Row16 AG1 = row_scale(ld_row(IN_ln_g + (size_t)(l * 2 + 0) * DM, lane), DN_ALPHA), AB1 = row_scale(ld_row(IN_ln_b + (size_t)(l * 2 + 0) * DM, lane), DN_ALPHA);
    const bool lastl = (l + 1 == DEPTH);
    for (int s0 = sp.t0; s0 < sp.t1; ) { const int b = s0 >> 11, s1 = sp.t1 < ((b + 1) << 11) ? sp.t1 : ((b + 1) << 11);
        const Row16 GT = ld_row(P_MOD + ((size_t)l * 32 + b) * MODW + 5120, lane);
        const float* m1 = P_MOD + ((size_t)(lastl ? l : l + 1) * 32 + b) * MODW; const Row16 SC1 = row_add1(ld_row(m1 + 1024, lane)), SH = ld_row(m1, lane);
        struct Raw { v4u xa, xb, ya, yb; f32x2 st; };
        auto ldraw = [&](int tok) __attribute__((always_inline)) { Raw r; const bf16* px = P_XT + (size_t)tok * DM; const bf16* py = P_Y + (size_t)tok * DM;
            r.xa = *(const v4u*)(px + 8 * lane); r.xb = *(const v4u*)(px + 512 + 8 * lane); r.ya = *(const v4u*)(py + 8 * lane); r.yb = *(const v4u*)(py + 512 + 8 * lane); r.st = *(const f32x2*)(P_STATS + (size_t)tok * 2); return r; };
        auto row = [&](const Raw& r, int tok) __attribute__((always_inline)) {
            const Row16 ax = row_affine2(unpack_row(r.xa, r.xb), r.st[1], -r.st[0] * r.st[1], AG1, AB1), y = unpack_row(r.ya, r.yb);
            const Row16 v = row_fma(y, GT, ax);
            float mu, rs; row_stats(v, mu, rs);
            const Row16 xn = row_affine2(v, rs, -mu * rs, G2, B2);
            if (lastl) st_row(P_X + (size_t)tok * DM, lane, xn);
            else { st_row_bf16(P_XS + (size_t)tok * DM, lane, xn); st_row_bf16(P_HB + (size_t)tok * DM, lane, row_fma(xn, SC1, SH)); } };
#define CLP(t) ((t) < s1 - 2 ? (t) : s1 - 2)
        Raw a0 = ldraw(s0), a1 = ldraw(s0 + 1);
        for (int tok = s0; tok < s1; tok += 4) {
            const Raw b0 = ldraw(CLP(tok + 2)), b1 = ldraw(CLP(tok + 2) + 1);
            __builtin_amdgcn_sched_barrier(0);
            row(a0, tok); row(a1, tok + 1);
            __builtin_amdgcn_sched_barrier(0);
            a0 = ldraw(CLP(tok + 4)); a1 = ldraw(CLP(tok + 4) + 1);
            __builtin_amdgcn_sched_barrier(0);
            row(b0, CLP(tok + 2)); row(b1, CLP(tok + 2) + 1);
            __builtin_amdgcn_sched_barrier(0);
        }
#undef CLP
        s0 = s1; }
}
#endif

__device__ __forceinline__ void hgrn_ws(const Args& A0, Frame& F0, int l) {
    LAUNDER();
    constexpr int BUFSZ = 47104, QM_O = 0, KM_O = 8704, QI_O = 17408, KET_O = 26112, VT_O = 36352, EBC_O = 46592;
    constexpr int OL_OFF = 2 * BUFSZ, OLSZ = 8704, SCR_OFF = OL_OFF + 2 * OLSZ, AL_SZ = 2560, SCRW = AL_SZ + 8704;
    static_assert(SCR_OFF + 4 * SCRW <= LDSCTL_OFF, "hgrn_ws LDS");
    const int tid = F.tid, lane = F.lane, w = F.wave;
    LAS unsigned char* L = F.lds;
    constexpr int NCH = SEQ / 32;
    for (int unit = blockIdx.x; unit < 128; unit += F.G) {
        const int b = unit >> 2, h = unit & 3;
        if (w < 4) {
            const int mw = w, fr = lane & 15, fq = lane >> 4;
            LAS unsigned char* ALw = L + SCR_OFF + mw * SCRW; LAS unsigned char* STw = ALw + AL_SZ;
            f32x4 S[8][2];
#pragma unroll
            for (int dt = 0; dt < 8; ++dt) { S[dt][0] = (f32x4){0.f, 0.f, 0.f, 0.f}; S[dt][1] = (f32x4){0.f, 0.f, 0.f, 0.f}; }
            { const v2u z2 = {0u, 0u}; *(LAS v2u*)(ALw + (fr) * 80 + (16 + 4 * fq) * 2) = z2; }
            hg_bar();
            for (int c = 0; c < NCH; ++c) {
                LAS unsigned char* B = L + (c & 1) * BUFSZ; LAS unsigned char* OLc = L + OL_OFF + (c & 1) * OLSZ;
#pragma unroll
                for (int dt = 0; dt < 8; ++dt)
#pragma unroll
                    for (int et = 0; et < 2; ++et) { v2u sw; sw.x = cvtpk(S[dt][et][0], S[dt][et][1]); sw.y = cvtpk(S[dt][et][2], S[dt][et][3]); *(LAS v2u*)(STw + (16 * et + fr) * 272 + (16 * dt + 4 * fq) * 2) = sw; }
#pragma unroll
                for (int ts = 0; ts < 2; ++ts)
#pragma unroll
                    for (int tt = 0; tt < 2; ++tt) { if (ts == 1 && tt == 0) continue;
                        f32x4 at = (f32x4){0.f, 0.f, 0.f, 0.f};
#pragma unroll
                        for (int ks = 0; ks < 4; ++ks) at = MFMA16(*(const LAS bf16x8*)(B + KM_O + (16 * ts + fr) * 272 + (32 * ks + 8 * fq) * 2), *(const LAS bf16x8*)(B + QM_O + (16 * tt + fr) * 272 + (32 * ks + 8 * fq) * 2), at);
                        const int t = 16 * tt + fr, s0 = 16 * ts + 4 * fq; v2u aw;
                        aw.x = cvtpk(s0 <= t ? at[0] : 0.f, s0 + 1 <= t ? at[1] : 0.f); aw.y = cvtpk(s0 + 2 <= t ? at[2] : 0.f, s0 + 3 <= t ? at[3] : 0.f);
                        *(LAS v2u*)(ALw + t * 80 + s0 * 2) = aw; }
                asm volatile("s_waitcnt lgkmcnt(0)" ::: "memory");
                const bf16x8 vb0 = *(const LAS bf16x8*)(B + VT_O + (32 * mw + fr) * 80 + 16 * fq), vb1 = *(const LAS bf16x8*)(B + VT_O + (32 * mw + 16 + fr) * 80 + 16 * fq);
#pragma unroll
                for (int tt = 0; tt < 2; ++tt) {
                    f32x4 o0 = (f32x4){0.f, 0.f, 0.f, 0.f}, o1 = (f32x4){0.f, 0.f, 0.f, 0.f};
#pragma unroll
                    for (int ks = 0; ks < 4; ++ks) { const bf16x8 qi = *(const LAS bf16x8*)(B + QI_O + (16 * tt + fr) * 272 + (32 * ks + 8 * fq) * 2);
                        o0 = MFMA16(*(const LAS bf16x8*)(STw + (fr) * 272 + (32 * ks + 8 * fq) * 2), qi, o0); o1 = MFMA16(*(const LAS bf16x8*)(STw + (16 + fr) * 272 + (32 * ks + 8 * fq) * 2), qi, o1); }
                    const bf16x8 al = *(const LAS bf16x8*)(ALw + (16 * tt + fr) * 80 + 16 * fq);
                    o0 = MFMA16(vb0, al, o0); o1 = MFMA16(vb1, al, o1);
                    v2u w0, w1; w0.x = cvtpk(o0[0], o0[1]); w0.y = cvtpk(o0[2], o0[3]); w1.x = cvtpk(o1[0], o1[1]); w1.y = cvtpk(o1[2], o1[3]);
                    *(LAS v2u*)(OLc + (16 * tt + fr) * 272 + (32 * mw + 4 * fq) * 2) = w0; *(LAS v2u*)(OLc + (16 * tt + fr) * 272 + (32 * mw + 16 + 4 * fq) * 2) = w1; }
#pragma unroll
                for (int dt = 0; dt < 8; ++dt) { const f32x4 e4 = *(const LAS f32x4*)(B + EBC_O + (16 * dt + 4 * fq) * 4); const bf16x8 ke = *(const LAS bf16x8*)(B + KET_O + (16 * dt + fr) * 80 + 16 * fq);
                    S[dt][0] = MFMA16(ke, vb0, S[dt][0] * e4); S[dt][1] = MFMA16(ke, vb1, S[dt][1] * e4); }
                hg_bar();
            }
        } else {
            const int gt = tid - 256, d = gt >> 1, half = gt & 1, et = gt >> 3, eg = (gt & 7) * 16;
            const size_t ebase = ((size_t)b * SEQ + 16 * half) * 512 + h * 128 + d;
            const size_t obase = ((size_t)b * SEQ + et) * 512 + h * 128 + eg;
            f32x4 gn[4];
#pragma unroll
            for (int q = 0; q < 4; ++q) gn[q] = *(const f32x4*)(IN_hg_norm_g + l * 512 + h * 128 + eg + 4 * q);
            unsigned short rg[16], rk[16], rq[16], rv[16];
#define WS_LOAD(c) do { const size_t o_ = ebase + (size_t)(c) * 32 * 512; _Pragma("unroll") for (int i = 0; i < 16; ++i) { rg[i] = P_GLOG[o_ + i * 512]; rk[i] = P_KK[o_ + i * 512]; rq[i] = P_QA[o_ + i * 512]; rv[i] = P_IA[o_ + i * 512]; } } while (0)
#define WS_STAGE(c) do { LAS unsigned char* B_ = L + ((c) & 1) * BUFSZ; float cs_[16], run_ = 0.f; \
            _Pragma("unroll") for (int i = 0; i < 16; ++i) { run_ += bf2f(rg[i]); cs_[i] = run_; } \
            const float ptot_ = dppf<0xB1>(run_), offs_ = half ? ptot_ : 0.f, bmid_ = half ? ptot_ : run_, bC_ = run_ + ptot_, emid_ = __expf(bmid_), ecm_ = __expf(bC_ - bmid_); \
            unsigned ke_[16]; \
            _Pragma("unroll") for (int i = 0; i < 16; ++i) { const float bt_ = offs_ + cs_[i], qmf_ = bf2f(rq[i]) * __expf(fminf(bt_ - bmid_, 80.f)), kmf_ = bf2f(rk[i]) * __expf(fminf(bmid_ - bt_, 80.f)); const int t_ = 16 * half + i; \
                *(LAS unsigned short*)(B_ + QM_O + t_ * 272 + d * 2) = (unsigned short)cvtpk(qmf_, 0.f); *(LAS unsigned short*)(B_ + KM_O + t_ * 272 + d * 2) = (unsigned short)cvtpk(kmf_, 0.f); \
                *(LAS unsigned short*)(B_ + QI_O + t_ * 272 + d * 2) = (unsigned short)cvtpk(qmf_ * emid_, 0.f); ke_[i] = cvtpk(kmf_ * ecm_, 0.f) & 0xffffu; } \
            v4u k0_, k1_, v0_, v1_; k0_.x = ke_[0] | (ke_[1] << 16); k0_.y = ke_[2] | (ke_[3] << 16); k0_.z = ke_[4] | (ke_[5] << 16); k0_.w = ke_[6] | (ke_[7] << 16); \
            k1_.x = ke_[8] | (ke_[9] << 16); k1_.y = ke_[10] | (ke_[11] << 16); k1_.z = ke_[12] | (ke_[13] << 16); k1_.w = ke_[14] | (ke_[15] << 16); \
            v0_.x = rv[0] | ((unsigned)rv[1] << 16); v0_.y = rv[2] | ((unsigned)rv[3] << 16); v0_.z = rv[4] | ((unsigned)rv[5] << 16); v0_.w = rv[6] | ((unsigned)rv[7] << 16); \
            v1_.x = rv[8] | ((unsigned)rv[9] << 16); v1_.y = rv[10] | ((unsigned)rv[11] << 16); v1_.z = rv[12] | ((unsigned)rv[13] << 16); v1_.w = rv[14] | ((unsigned)rv[15] << 16); \
            *(LAS v4u*)(B_ + KET_O + d * 80 + half * 32) = k0_; *(LAS v4u*)(B_ + KET_O + d * 80 + half * 32 + 16) = k1_; *(LAS v4u*)(B_ + VT_O + d * 80 + half * 32) = v0_; *(LAS v4u*)(B_ + VT_O + d * 80 + half * 32 + 16) = v1_; \
            if (half == 0) *(LAS float*)(B_ + EBC_O + d * 4) = __expf(bC_); } while (0)
#define WS_EPI(c, ga0, ga1) do { const LAS unsigned char* O_ = L + OL_OFF + ((c) & 1) * OLSZ + et * 272 + eg * 2; const v4u oa_ = *(const LAS v4u*)O_, ob_ = *(const LAS v4u*)(O_ + 16); \
            const f32x4 o0_ = (f32x4){bflo(oa_.x), bfhi(oa_.x), bflo(oa_.y), bfhi(oa_.y)}, o1_ = (f32x4){bflo(oa_.z), bfhi(oa_.z), bflo(oa_.w), bfhi(oa_.w)}, o2_ = (f32x4){bflo(ob_.x), bfhi(ob_.x), bflo(ob_.y), bfhi(ob_.y)}, o3_ = (f32x4){bflo(ob_.z), bfhi(ob_.z), bflo(ob_.w), bfhi(ob_.w)}; \
            const f32x4 sq_ = (o0_ * o0_ + o1_ * o1_) + (o2_ * o2_ + o3_ * o3_); float ss_ = (sq_[0] + sq_[1]) + (sq_[2] + sq_[3]); \
            ss_ += dppf<0xB1>(ss_); ss_ += dppf<0x4E>(ss_); ss_ += dppf<0x141>(ss_); \
            const float rstd_ = __builtin_amdgcn_rsqf(ss_ * (1.0f / 128.0f) + RMS_EPS); \
            const f32x4 g0_ = (f32x4){bflo(ga0.x), bfhi(ga0.x), bflo(ga0.y), bfhi(ga0.y)}, g1_ = (f32x4){bflo(ga0.z), bfhi(ga0.z), bflo(ga0.w), bfhi(ga0.w)}, g2_ = (f32x4){bflo(ga1.x), bfhi(ga1.x), bflo(ga1.y), bfhi(ga1.y)}, g3_ = (f32x4){bflo(ga1.z), bfhi(ga1.z), bflo(ga1.w), bfhi(ga1.w)}; \
            bf16* op_ = P_OA + obase + (size_t)(c) * 32 * 512; \
            *(v4u*)op_ = pk8(o0_ * rstd_ * gn[0] * g0_, o1_ * rstd_ * gn[1] * g1_); *(v4u*)(op_ + 8) = pk8(o2_ * rstd_ * gn[2] * g2_, o3_ * rstd_ * gn[3] * g3_); } while (0)
            WS_LOAD(0); WS_STAGE(0); WS_LOAD(1);
            hg_bar();
            for (int c = 0; c < NCH; ++c) {
                v4u ga0 = {0u, 0u, 0u, 0u}, ga1 = {0u, 0u, 0u, 0u};
                if (c >= 1) { const bf16* gp = P_GA + obase + (size_t)(c - 1) * 32 * 512; ga0 = *(const v4u*)gp; ga1 = *(const v4u*)(gp + 8); }
                if (c + 1 < NCH) { WS_STAGE(c + 1); if (c + 2 < NCH) WS_LOAD(c + 2); }
                if (c >= 1) WS_EPI(c - 1, ga0, ga1);
                hg_bar();
            }
            { const bf16* gp = P_GA + obase + (size_t)(NCH - 1) * 32 * 512; const v4u ga0 = *(const v4u*)gp, ga1 = *(const v4u*)(gp + 8); WS_EPI(NCH - 1, ga0, ga1); }
#undef WS_LOAD
#undef WS_STAGE
#undef WS_EPI
        }
        hg_bar();
    }
}

__device__ __forceinline__ void hgrn_pipe(const Args& A0, Frame& F0, int l) {
    LAUNDER();
    constexpr int BUFSZ = 47104, QM_OFF = 0, KM_OFF = 8704, QI_OFF = 17408, KET_OFF = 26112, VT_OFF = 36352, EBC_OFF = 46592;
    constexpr int AL_OFF = 2 * BUFSZ, TOT_OFF = AL_OFF + 2560, ST_OFF = TOT_OFF + 2048, OL_OFF = ST_OFF + 8 * 4352;
    static_assert(OL_OFF + 32 * 132 * 4 <= LDSCTL_OFF, "hgrn_pipe LDS");
    const int tid = F.tid, lane = F.lane, w = F.wave, fr = lane & 15, fq = lane >> 4;
    const int d = tid & 127, tq = tid >> 7, et = tid >> 4, eg = (tid & 15) * 8;
    LAS unsigned char* L = F.lds;
    LAS float* TOT = (LAS float*)(L + TOT_OFF); LAS float* OL = (LAS float*)(L + OL_OFF);
    LAS unsigned char* STw = L + ST_OFF + w * 4352;
    for (int unit = blockIdx.x; unit < 128; unit += F.G) {
        const int b = unit >> 2, h = unit & 3;
        const size_t ebase = ((size_t)b * SEQ + 8 * tq) * 512 + h * 128 + d;
        const size_t obase = ((size_t)b * SEQ + et) * 512 + h * 128 + eg;
        const f32x4 gn0 = *(const f32x4*)(IN_hg_norm_g + l * 512 + h * 128 + eg), gn1 = *(const f32x4*)(IN_hg_norm_g + l * 512 + h * 128 + eg + 4);
        f32x4 S[8];
#pragma unroll
        for (int i = 0; i < 8; ++i) S[i] = (f32x4){0.f, 0.f, 0.f, 0.f};
        for (int i = lane; i < 4352 / 4; i += 64) ((LAS unsigned*)STw)[i] = 0u;
        unsigned short rg[8], rk[8], rq[8], rv[8];
#define HG_LOAD(c) do { const size_t o_ = ebase + (size_t)(c) * 32 * 512; _Pragma("unroll") for (int i = 0; i < 8; ++i) { rg[i] = P_GLOG[o_ + i * 512]; rk[i] = P_KK[o_ + i * 512]; rq[i] = P_QA[o_ + i * 512]; rv[i] = P_IA[o_ + i * 512]; } } while (0)
        float cs[8];
#define HG_TOT() do { float run_ = 0.f; _Pragma("unroll") for (int i = 0; i < 8; ++i) { run_ += bf2f(rg[i]); cs[i] = run_; } TOT[tq * 128 + d] = run_; } while (0)
#define HG_STAGE(BW) do { LAS unsigned char* W_ = (BW); const float t0_ = TOT[d], t1_ = TOT[128 + d], t2_ = TOT[256 + d], t3_ = TOT[384 + d]; \
            const float offs_ = (tq > 0 ? t0_ : 0.f) + (tq > 1 ? t1_ : 0.f) + (tq > 2 ? t2_ : 0.f), bmid_ = t0_ + t1_, bC_ = (t0_ + t1_) + (t2_ + t3_); \
            unsigned ke_[8], vv_[8]; const float emid_ = __expf(bmid_), ecm_ = __expf(bC_ - bmid_);     \
            _Pragma("unroll") for (int i = 0; i < 8; ++i) { const float bt_ = offs_ + cs[i], q_ = bf2f(rq[i]), k_ = bf2f(rk[i]); const int t_ = 8 * tq + i; \
                const float qmf_ = q_ * __expf(fminf(bt_ - bmid_, 80.f)), kmf_ = k_ * __expf(fminf(bmid_ - bt_, 80.f)); \
                const unsigned qm_ = cvtpk(qmf_, 0.f), km_ = cvtpk(kmf_, 0.f), qi_ = cvtpk(qmf_ * emid_, 0.f); ke_[i] = cvtpk(kmf_ * ecm_, 0.f); vv_[i] = rv[i]; \
                *(LAS unsigned short*)(W_ + QM_OFF + t_ * 272 + d * 2) = (unsigned short)qm_; *(LAS unsigned short*)(W_ + KM_OFF + t_ * 272 + d * 2) = (unsigned short)km_; *(LAS unsigned short*)(W_ + QI_OFF + t_ * 272 + d * 2) = (unsigned short)qi_; } \
            v4u kw_, vw_; kw_.x = (ke_[0] & 0xffffu) | (ke_[1] << 16); kw_.y = (ke_[2] & 0xffffu) | (ke_[3] << 16); kw_.z = (ke_[4] & 0xffffu) | (ke_[5] << 16); kw_.w = (ke_[6] & 0xffffu) | (ke_[7] << 16); \
            vw_.x = vv_[0] | (vv_[1] << 16); vw_.y = vv_[2] | (vv_[3] << 16); vw_.z = vv_[4] | (vv_[5] << 16); vw_.w = vv_[6] | (vv_[7] << 16); \
            *(LAS v4u*)(W_ + KET_OFF + d * 80 + tq * 16) = kw_; *(LAS v4u*)(W_ + VT_OFF + d * 80 + tq * 16) = vw_; \
            if (tq == 0) *(LAS float*)(W_ + EBC_OFF + d * 4) = __expf(bC_); } while (0)
        constexpr int NCH = SEQ / 32;
        HG_LOAD(0); HG_TOT(); hg_bar(); HG_STAGE(L); HG_LOAD(1); hg_bar();
        v4u rga = {0u, 0u, 0u, 0u};
        for (int c = 0; c < NCH; ++c) {
            const LAS unsigned char* B = L + (c & 1) * BUFSZ;
            if (w < 4) { const int ts = w >> 1, tt = w & 1; f32x4 at = (f32x4){0.f, 0.f, 0.f, 0.f};
#pragma unroll
                for (int ks = 0; ks < 4; ++ks) at = MFMA16(*(const LAS bf16x8*)(B + KM_OFF + (16 * ts + fr) * 272 + (32 * ks + 8 * fq) * 2), *(const LAS bf16x8*)(B + QM_OFF + (16 * tt + fr) * 272 + (32 * ks + 8 * fq) * 2), at);
                const int t = 16 * tt + fr, s0 = 16 * ts + 4 * fq; v2u aw;
                aw.x = cvtpk(s0 <= t ? at[0] : 0.f, s0 + 1 <= t ? at[1] : 0.f); aw.y = cvtpk(s0 + 2 <= t ? at[2] : 0.f, s0 + 3 <= t ? at[3] : 0.f);
                *(LAS v2u*)(L + AL_OFF + t * 80 + s0 * 2) = aw; }
            f32x4 o[2];
#pragma unroll
            for (int tt = 0; tt < 2; ++tt) { o[tt] = (f32x4){0.f, 0.f, 0.f, 0.f};
#pragma unroll
                for (int ks = 0; ks < 4; ++ks) o[tt] = MFMA16(*(const LAS bf16x8*)(B + QI_OFF + (16 * tt + fr) * 272 + (32 * ks + 8 * fq) * 2), *(const LAS bf16x8*)(STw + fr * 272 + (32 * ks + 8 * fq) * 2), o[tt]); }
            if (c + 1 < NCH) HG_TOT();
            if (c >= 1) { const f32x4 o0 = *(const LAS f32x4*)(OL + et * 132 + eg), o1 = *(const LAS f32x4*)(OL + et * 132 + eg + 4);
              float ss = ((o0[0] * o0[0] + o0[1] * o0[1]) + (o0[2] * o0[2] + o0[3] * o0[3])) + ((o1[0] * o1[0] + o1[1] * o1[1]) + (o1[2] * o1[2] + o1[3] * o1[3]));
              ss += __shfl_xor(ss, 1); ss += __shfl_xor(ss, 2); ss += __shfl_xor(ss, 4); ss += __shfl_xor(ss, 8);
              const float rstd = __builtin_amdgcn_rsqf(ss * (1.0f / 128.0f) + RMS_EPS);
              const f32x4 r0 = o0 * rstd * gn0 * (f32x4){bflo(rga.x), bfhi(rga.x), bflo(rga.y), bfhi(rga.y)}, r1 = o1 * rstd * gn1 * (f32x4){bflo(rga.z), bfhi(rga.z), bflo(rga.w), bfhi(rga.w)};
              *(v4u*)(P_OA + obase + (size_t)(c - 1) * 32 * 512) = pk8(r0, r1); }
            hg_bar();
            const bf16x8 vb = *(const LAS bf16x8*)(B + VT_OFF + (16 * w + fr) * 80 + 16 * fq);
#pragma unroll
            for (int tt = 0; tt < 2; ++tt) { o[tt] = MFMA16(*(const LAS bf16x8*)(L + AL_OFF + (16 * tt + fr) * 80 + 16 * fq), vb, o[tt]);
#pragma unroll
                for (int j = 0; j < 4; ++j) OL[(16 * tt + 4 * fq + j) * 132 + 16 * w + fr] = o[tt][j]; }
#pragma unroll
            for (int dt = 0; dt < 8; ++dt) { const f32x4 e4 = *(const LAS f32x4*)(B + EBC_OFF + (16 * dt + 4 * fq) * 4); S[dt] = S[dt] * e4;
                S[dt] = MFMA16(*(const LAS bf16x8*)(B + KET_OFF + (16 * dt + fr) * 80 + 16 * fq), vb, S[dt]);
                v2u sw; sw.x = cvtpk(S[dt][0], S[dt][1]); sw.y = cvtpk(S[dt][2], S[dt][3]); *(LAS v2u*)(STw + fr * 272 + (16 * dt + 4 * fq) * 2) = sw; }
            if (c + 1 < NCH) { HG_STAGE(L + ((c + 1) & 1) * BUFSZ); if (c + 2 < NCH) HG_LOAD(c + 2); }
            rga = *(const v4u*)(P_GA + obase + (size_t)c * 32 * 512);
            hg_bar();
        }
        { const f32x4 o0 = *(const LAS f32x4*)(OL + et * 132 + eg), o1 = *(const LAS f32x4*)(OL + et * 132 + eg + 4);
          float ss = ((o0[0] * o0[0] + o0[1] * o0[1]) + (o0[2] * o0[2] + o0[3] * o0[3])) + ((o1[0] * o1[0] + o1[1] * o1[1]) + (o1[2] * o1[2] + o1[3] * o1[3]));
          ss += __shfl_xor(ss, 1); ss += __shfl_xor(ss, 2); ss += __shfl_xor(ss, 4); ss += __shfl_xor(ss, 8);
          const float rstd = __builtin_amdgcn_rsqf(ss * (1.0f / 128.0f) + RMS_EPS);
          const f32x4 r0 = o0 * rstd * gn0 * (f32x4){bflo(rga.x), bfhi(rga.x), bflo(rga.y), bfhi(rga.y)}, r1 = o1 * rstd * gn1 * (f32x4){bflo(rga.z), bfhi(rga.z), bflo(rga.w), bfhi(rga.w)};
          *(v4u*)(P_OA + obase + (size_t)(NCH - 1) * 32 * 512) = pk8(r0, r1); }
        hg_bar();
#undef HG_LOAD
#undef HG_TOT
#undef HG_STAGE
    }
}

#if PEER_KSLICE
constexpr int PH_L = 11;
#else
constexpr int PH_L = 8;
#endif
constexpr int NPHASE = 3 + PH_L * DEPTH;
__global__ void __launch_bounds__(NTHREADS, 2) trunk_fwd(Args args) {
    extern __shared__ __attribute__((aligned(16))) unsigned char lds[];
    Frame F;
    F.lds = (LAS unsigned char*)lds;
        F.tid = threadIdx.x; F.lane = F.tid & 63; F.wave = __builtin_amdgcn_readfirstlane(F.tid >> 6);
    F.G = gridDim.x; { const int bx = blockIdx.x; F.vcu = (F.G % 8 == 0) ? (bx % 8) * (F.G / 8) + bx / 8 : bx; }
    F.gw = F.vcu * NWAVES + F.wave; F.NGW = F.G * NWAVES;
    const Args& A0 = args; Frame& F0 = F;
    gu32* const ctl = (gu32*)(A0.ws + WS_CTL);
    for (int u = F.tid; u < (LDS_BYTES - LDSCTL_OFF) / 4; u += NTHREADS) ((LAS unsigned*)(F.lds + LDSCTL_OFF))[u] = 0u;
    __syncthreads();
    XcdBarrier bar; bar.bar = (unsigned*)(ctl + CW_BAR); bar.x = 0; bar.st = nullptr;
    if (!MK_PER_PHASE) bar = xcd_barrier_post((unsigned*)(ctl + CW_BAR), (volatile LAS unsigned*)(F.lds + MISC_OFF) + 8);
    const int lo = args.ph_lo, hi = args.ph_hi;
#define IN(k) (lo <= (k) && (k) < hi)
#define SEAM(k) do { if (IN(k) && IN((k) + 1)) { XcdBarrier b2 = bar; b2.bar = opq(b2.bar); xcd_barrier(b2); if (PROBE_MASK & 8192) xcd_barrier(b2); } } while (0)

    if (PROBE_MASK & (1 << 18 | 1 << 19)) {
        unsigned char* base = A0.ws + WS_XT + (size_t)F.gw * 65536; const int fr = F.lane & 15, fq = F.lane >> 4;
        const size_t lofs = (PROBE_MASK & (1 << 18)) ? ((size_t)fr * 2048 + fq * 16) : ((size_t)(fr & 7) * 2048 + (fr >> 3) * 64 + fq * 16);
        const v4u val = {1u, 2u, 3u, 4u};
        for (int it = 0; it < 1024; ++it) { const int rg = it & 1, cg = it >> 1;
            *(v4u*)(base + (size_t)rg * ((PROBE_MASK & (1 << 18)) ? 16 : 8) * 2048 + (size_t)(cg & 15) * 128 + lofs) = val; }
        __syncthreads();
    }
    for (int rep = 0; rep < ((PROBE_MASK & 4096) ? 2 : 1); ++rep) {
    if (IN(0)) { phase_proA(A0, F0); } SEAM(0);
    if (IN(1)) { phase_proA2(A0, F0); } SEAM(1);
    if (IN(2)) { phase_proB(A0, F0); } SEAM(2);
    }

    for (int l = 0; l < DEPTH; ++l) {
        const int pb = 3 + PH_L * l;
        for (int rep = 0; rep < ((PROBE_MASK & 1) ? 2 : 1); ++rep)
        if (IN(pb + 0)) { LAUNDER();
            if (GEMM_STAGGER) { const unsigned long long dly = (unsigned long long)(((unsigned)blockIdx.x * 5u) & 15u) * GEMM_STAGGER, t0 = __builtin_amdgcn_s_memrealtime();
                while (__builtin_amdgcn_s_memrealtime() - t0 < dly) __builtin_amdgcn_s_sleep(8); }
            pg8::Gemm g{P_HB, P_WIN + (size_t)l * INW * DM, NTOK, INW, DM}; pg8::StaticOrder S; S.init(NTOK, INW, F.G, (int)blockIdx.x);
            pg8::EpiInProj E{ws, P_LB + l * 512};
            pg8::gemm_phase<pg8::EpiInProj, pg8::StaticOrder, true, true>(F.lds, g, S, E, F.tid);
        }
        SEAM(pb + 0);
        if (IN(pb + 1)) { for (int rep = 0; rep < ((PROBE_MASK & 2) ? 2 : 1); ++rep) { if (HGRN_WS) hgrn_ws(A0, F0, l); else if (HGRN_PIPE) hgrn_pipe(A0, F0, l); else hgrn_fast(A0, F0, l); } for (int rep = 0; rep < ((PROBE_MASK & 4) ? 2 : 1); ++rep) attn_fast(A0, F0, l + 4 * rep); }
        SEAM(pb + 1);
        for (int rep = 0; rep < ((PROBE_MASK & 8) ? 2 : 1); ++rep)
        if (IN(pb + 2)) {
            { LAUNDER(); pg8::Gemm g{P_OA, P_WUA + (size_t)l * DM * 512, NTOK, DM, 512, P_OB, P_WUB + (size_t)l * DM * 512}; pg8::SegOrder S; S.init(NTOK, DM, F.G, (int)blockIdx.x);
              pg8::EpiUp2 E{P_MERGED, (const unsigned char*)P_GTA, (const unsigned char*)P_GTB}; pg8::gemm_phase<pg8::EpiUp2, pg8::SegOrder, true, true>(F.lds, g, S, E, F.tid); }
        }
        SEAM(pb + 2);
        for (int rep = 0; rep < ((PROBE_MASK & 32768) ? 2 : 1); ++rep)
        if (IN(pb + 3)) { LAUNDER();
            pg8::Gemm g{P_MERGED, P_WO + (size_t)l * DM * DM, NTOK, DM, DM}; pg8::StaticOrder S; S.init(NTOK, DM, F.G, (int)blockIdx.x);
            pg8::EpiWo E{l == 0 ? IN_x : (const float*)nullptr, P_XS, P_XT, P_MOD + (size_t)l * 32 * MODW + 2048, DN_ALPHA};
            pg8::gemm_phase<pg8::EpiWo, pg8::StaticOrder, true, true>(F.lds, g, S, E, F.tid);
        }
        SEAM(pb + 3);
        if (IN(pb + 4)) { for (int rep = 0; rep < ((PROBE_MASK & 65536) ? 2 : 1); ++rep) { if (rep == 0) peer_convert(A0, F0, l); phase_ln1(A0, F0, l); } }
        SEAM(pb + 4);
        for (int rep = 0; rep < ((PROBE_MASK & 16) ? 2 : 1); ++rep)
        if (IN(pb + 5)) { LAUNDER();
            pg8::Gemm g{P_HB, P_WPQ + (size_t)l * DM * DM, NTOK, DM, DM}; pg8::StaticOrder S; S.init(NTOK, DM, F.G, (int)blockIdx.x);
            if (PROBE_MASK & 2048) { pg8::Gemm g2{P_HB, P_WPQ + (size_t)l * DM * DM, NTOK, DM, DM, P_HB, P_WPQ + (size_t)l * DM * DM}; pg8::SegOrder S2; S2.init(NTOK, DM, F.G, (int)blockIdx.x);
                pg8::EpiProbeK2 E2{P_PQ}; pg8::gemm_phase<pg8::EpiProbeK2, pg8::SegOrder, true, true>(F.lds, g2, S2, E2, F.tid); }
            else { pg8::EpiPQ E{P_PQ}; pg8::gemm_phase<pg8::EpiPQ, pg8::StaticOrder, true, true>(F.lds, g, S, E, F.tid); }
        }
        SEAM(pb + 5);
        if (IN(pb + 6)) { for (int rep = 0; rep < ((PROBE_MASK & 32) ? 2 : 1); ++rep) { if (FAST_TOPK) peer_topk_fast(A0, F0, l); else peer_topk_simple(A0, F0, l); __syncthreads(); } }
        SEAM(pb + 6);
#if PEER_KSLICE
        if (IN(pb + 7)) { for (int rep = 0; rep < ((PROBE_MASK & 128) ? 2 : 1); ++rep) PEER_PH_U(A0, F0); }
        SEAM(pb + 7);
        if (IN(pb + 8)) { PEER_PH_R(A0, F0); }
        SEAM(pb + 8);
        if (IN(pb + 9)) { for (int rep = 0; rep < ((PROBE_MASK & 256) ? 2 : 1); ++rep) PEER_PH_V(A0, F0); }
        SEAM(pb + 9);
        if (IN(pb + 10)) { for (int rep = 0; rep < ((PROBE_MASK & 131072) ? 2 : 1); ++rep) peer_slice_ln(A0, F0, l); }
        SEAM(pb + 10);
#else
        if (IN(pb + 7)) { phase_peer_expert(A0, F0, l); }
        SEAM(pb + 7);
#endif
    }
#undef IN
#undef SEAM
}

extern "C" void kernel_launch(void* const* d_in, const int* in_sizes, int n_in, void* d_out, int out_size, void* d_ws, size_t ws_size, hipStream_t stream) {
    static int grid = 0;
    if (grid == 0) {
        if (n_in != 16 || out_size != NTOK * DM || ws_size < WS_END) { fprintf(stderr, "kernel_launch: unexpected shapes (n_in %d, out %d, ws %zu)\n", n_in, out_size, ws_size); grid = -1; return; }
        int dev = 0, cus = 0, per_cu = 0;
        if (hipGetDevice(&dev) != hipSuccess || hipDeviceGetAttribute(&cus, hipDeviceAttributeMultiprocessorCount, dev) != hipSuccess) { grid = -1; return; }
        if (hipFuncSetAttribute((const void*)trunk_fwd, hipFuncAttributeMaxDynamicSharedMemorySize, LDS_BYTES) != hipSuccess) { fprintf(stderr, "kernel_launch: hipFuncSetAttribute failed\n"); grid = -1; return; }
        if (hipOccupancyMaxActiveBlocksPerMultiprocessor(&per_cu, (const void*)trunk_fwd, NTHREADS, LDS_BYTES) != hipSuccess || per_cu < 1) { fprintf(stderr, "kernel_launch: occupancy query says %d\n", per_cu); }
        (void)hipGetLastError();
        grid = cus;
    }
    if (grid < 0) return;
    if (hipMemsetAsync((char*)d_ws + WS_CTL, 0, CTL_ZERO_BYTES, stream) != hipSuccess) return;
    Args a{};
    for (int i = 0; i < 16; ++i) a.in[i] = (const float*)d_in[i];
    a.out = (float*)d_out; a.ws = (unsigned char*)d_ws;
#if MK_PER_PHASE
    for (int k = 0; k < NPHASE; ++k) { a.ph_lo = k; a.ph_hi = k + 1; hipLaunchKernelGGL(trunk_fwd, dim3(grid), dim3(NTHREADS), LDS_BYTES, stream, a); }
#else
    a.ph_lo = 0; a.ph_hi = NPHASE;
    hipLaunchKernelGGL(trunk_fwd, dim3(grid), dim3(NTHREADS), LDS_BYTES, stream, a);
#endif
    const hipError_t le = hipPeekAtLastError();
    if (le != hipSuccess) fprintf(stderr, "kernel_launch: launch failed: %s\n", hipGetErrorName(le));
}
```

```cpp
#include <hip/hip_runtime.h>
#include <cstdio>
#include <cstdint>

#ifndef MK_PER_PHASE
#define MK_PER_PHASE 0
#endif

#ifndef PROBE_MASK
#define PROBE_MASK 0
#endif

#ifndef FAST_ATTN
#define FAST_ATTN 1
#endif
#ifndef FAST_TOPK
#define FAST_TOPK 1
#endif
#ifndef FAST_HGRN
#define FAST_HGRN 1
#endif

#ifndef PEER_FP8
#define PEER_FP8 1
#endif

#ifndef PEER_KSLICE
#define PEER_KSLICE 1
#endif

#ifndef GEMM_STAGGER
#define GEMM_STAGGER 0
#endif

#ifndef HGRN_WS
#define HGRN_WS 0
#endif

#ifndef U_MFMA
#define U_MFMA 0
#endif

#ifndef U_INT8
#define PEER_Q4 1
#define U_INT8 1
#endif

#ifndef HGRN_PIPE
#define HGRN_PIPE 0
#endif

namespace pg8 {
#define PG8_LAS __attribute__((address_space(3)))
typedef unsigned short bf16_t;
typedef short bf16x8 __attribute__((ext_vector_type(8)));
typedef float f32x4 __attribute__((ext_vector_type(4)));
typedef unsigned u32x4 __attribute__((ext_vector_type(4)));
constexpr int BM = 256, BK = 64, HALF = 128, HTB = HALF * BK * 2  , STAGE_BYTES = 8 * HTB, NXCD = 8, WGM = 8;

__host__ __device__ __forceinline__ int lds_byte(int r, int c) { const int st = (r >> 4) * 2 + (c >> 5), rr = r & 15, cc = c & 31, ob = rr * 64 + cc * 2; return st * 1024 + (ob ^ (((ob >> 9) & 1) << 5)); }
__host__ __device__ __forceinline__ void stage_rc(int b, int& R, int& C) { const int st = b / 1024, sb = b % 1024, swz = sb ^ (((sb >> 9) & 1) << 5); R = (st >> 1) * 16 + swz / 64; C = (st & 1) * 32 + (swz % 64) / 2; }
__host__ __device__ __forceinline__ int perm32(int rho) { const int n = rho >> 4, i = rho & 15; return 8 * (i >> 2) + 4 * n + (i & 3); }

struct Unit { int pm, pn, seg; };
struct Gemm { const bf16_t* A; const bf16_t* Bt; int M, N, K; const bf16_t* A2; const bf16_t* Bt2; };

struct StaticOrder {
    int nM, nN, nwg, G, c;
    __host__ __device__ void init(int M, int N, int G_, int c_) { nM = M / BM; nN = N / BM; nwg = nM * nN; G = G_; c = c_; }
    __host__ __device__ bool next(int i, Unit& u) const {
        const long L = (long)i * G + c; if (L >= nwg) return false;
        int wgid = (int)L; { const int q = nwg / NXCD, r = nwg % NXCD, xcd = wgid % NXCD, off = wgid / NXCD; wgid = (xcd < r ? xcd * (q + 1) : r * (q + 1) + (xcd - r) * q) + off; }
        const int nig = WGM * nN, gid = wgid / nig, fm = gid * WGM, gsz = (nM - fm) < WGM ? (nM - fm) : WGM;
        u.pm = fm + ((wgid % nig) % gsz); u.pn = (wgid % nig) / gsz; u.seg = 0; return true;
    }
    __device__ __forceinline__ void a_ready(const Unit&) const {}
    __device__ __forceinline__ void done(const Unit&) const {}
};
struct InProjOrder : StaticOrder {
    __host__ __device__ bool next(int i, Unit& u) const { if (!StaticOrder::next(i, u)) return false; const int s = u.pn; u.pn = s < 16 ? ((s & 1) ? 14 + (s >> 1) : (s >> 1)) : s - 8; return true; }
};
struct SegOrder : StaticOrder {
    __host__ __device__ bool next(int i, Unit& u) const { if (!StaticOrder::next(i >> 1, u)) return false; u.seg = i & 1; return true; }
};

typedef __bf16 pk_bf16x2 __attribute__((ext_vector_type(2)));
typedef float pk_f32x2 __attribute__((ext_vector_type(2)));
__device__ __forceinline__ unsigned cvt_pk_bf16(float lo, float hi) { const pk_f32x2 v = {lo, hi}; return __builtin_bit_cast(unsigned, __builtin_convertvector(v, pk_bf16x2)); }
__device__ __forceinline__ u32x4 pack8(f32x4 v0, f32x4 v1) { u32x4 w; w.x = cvt_pk_bf16(v0[0], v0[1]); w.y = cvt_pk_bf16(v0[2], v0[3]); w.z = cvt_pk_bf16(v1[0], v1[1]); w.w = cvt_pk_bf16(v1[2], v1[3]); return w; }
__device__ __forceinline__ float bf_lo(unsigned w) { return __uint_as_float(w << 16); }
__device__ __forceinline__ float bf_hi(unsigned w) { return __uint_as_float(w & 0xffff0000u); }
__device__ __forceinline__ void unpack8(u32x4 w, f32x4& a, f32x4& b) { a = (f32x4){bf_lo(w.x), bf_hi(w.x), bf_lo(w.y), bf_hi(w.y)}; b = (f32x4){bf_lo(w.z), bf_hi(w.z), bf_lo(w.w), bf_hi(w.w)}; }
__device__ __forceinline__ float sigm(float z) { return __builtin_amdgcn_rcpf(1.0f + __builtin_amdgcn_exp2f(z * -1.4426950408889634f)); }

__device__ __forceinline__ unsigned q8x4(f32x4 s) {
    const unsigned a = __float_as_uint(fmaxf(s[0] * 255.0f, 1.0f) + 8388608.0f), b = __float_as_uint(fmaxf(s[1] * 255.0f, 1.0f) + 8388608.0f),
                   c = __float_as_uint(fmaxf(s[2] * 255.0f, 1.0f) + 8388608.0f), d2 = __float_as_uint(fmaxf(s[3] * 255.0f, 1.0f) + 8388608.0f);
    const unsigned lo = __builtin_amdgcn_perm(b, a, 0x0c0c0400u), hi = __builtin_amdgcn_perm(d2, c, 0x04000c0cu);
    return lo | hi; }
__device__ __forceinline__ unsigned q8x4s(f32x4 s255) {
    const unsigned a = __float_as_uint(fmaxf(s255[0], 1.0f) + 8388608.0f), b = __float_as_uint(fmaxf(s255[1], 1.0f) + 8388608.0f), c = __float_as_uint(fmaxf(s255[2], 1.0f) + 8388608.0f), d2 = __float_as_uint(fmaxf(s255[3], 1.0f) + 8388608.0f);
    return __builtin_amdgcn_perm(b, a, 0x0c0c0400u) | __builtin_amdgcn_perm(d2, c, 0x04000c0cu); }
__device__ __forceinline__ f32x4 uq8x4raw(unsigned w) { return (f32x4){(float)(w & 0xffu), (float)((w >> 8) & 0xffu), (float)((w >> 16) & 0xffu), (float)(w >> 24)}; }
__device__ __forceinline__ f32x4 uq8x4(unsigned w) { return (f32x4){(float)(w & 0xffu), (float)((w >> 8) & 0xffu), (float)((w >> 16) & 0xffu), (float)(w >> 24)} * (1.0f / 255.0f); }
struct EpiInProj {
    static constexpr bool PERM = true, AFTER_DRAIN = false, IDEM = true, SEG = false;
    unsigned char* ws; const float* lb;
    static constexpr size_t M_ = 1u << 20, oQA = 202 * M_, oGLOG = 266 * M_, oKK = 330 * M_, oIA = 394 * M_, oGA = 458 * M_, oQB = 522 * M_, oKB = 586 * M_, oVT = 650 * M_, oGTA = 714 * M_, oGTB = 842 * M_;
    __device__ __forceinline__ void operator()(const f32x4 (&acc)[2][2][4][2], const Unit& u, int wr, int wc, int fr, int fq) const {
        const int pn = u.pn, row0 = u.pm * BM + wr * 64 + fr, cl0 = wc * 32 + 8 * fq;
        if (pn < 2 || (pn >= 4 && pn < 8)) {
            bf16_t* base = (bf16_t*)(ws + (pn < 2 ? oQA : (pn < 6 ? oIA : oGA))); const int cb = (pn & 1) * 256 + cl0; const bool act = pn >= 6;
#pragma unroll
            for (int ai = 0; ai < 2; ++ai)
#pragma unroll
                for (int m = 0; m < 4; ++m) { bf16_t* rowp = base + (size_t)(row0 + ai * HALF + m * 16) * 512 + cb;
#pragma unroll
                    for (int bj = 0; bj < 2; ++bj) { f32x4 v0 = acc[ai][bj][m][0], v1 = acc[ai][bj][m][1];
                        if (act) {
#pragma unroll
                            for (int j = 0; j < 4; ++j) { v0[j] = v0[j] * sigm(v0[j]); v1[j] = v1[j] * sigm(v1[j]); } }
                        *(u32x4*)(rowp + bj * HALF) = pack8(v0, v1); } }
        } else if (pn < 4) {
            const int cb = (pn - 2) * 256 + cl0; f32x4 l0[2], l1[2];
#pragma unroll
            for (int bj = 0; bj < 2; ++bj) { l0[bj] = *(const f32x4*)(lb + cb + bj * HALF); l1[bj] = *(const f32x4*)(lb + cb + bj * HALF + 4); }
#pragma unroll
            for (int ai = 0; ai < 2; ++ai)
#pragma unroll
                for (int m = 0; m < 4; ++m) { const size_t ro = (size_t)(row0 + ai * HALF + m * 16) * 512 + cb;
#pragma unroll
                    for (int bj = 0; bj < 2; ++bj) { f32x4 z0 = acc[ai][bj][m][0], z1 = acc[ai][bj][m][1], g0, g1;
#pragma unroll
                        for (int j = 0; j < 4; ++j) {
                            { const float z = fminf(fmaxf(z0[j], -30.f), 30.f), lbv = l0[bj][j], s = __builtin_amdgcn_rcpf(1.0f + __builtin_amdgcn_exp2f(z * -1.4426950408889634f)); g0[j] = __builtin_amdgcn_logf(lbv + (1.0f - lbv) * s) * 0.6931471805599453f; }
                            { const float z = fminf(fmaxf(z1[j], -30.f), 30.f), lbv = l1[bj][j], s = __builtin_amdgcn_rcpf(1.0f + __builtin_amdgcn_exp2f(z * -1.4426950408889634f)); g1[j] = __builtin_amdgcn_logf(lbv + (1.0f - lbv) * s) * 0.6931471805599453f; } }
                        *(u32x4*)((bf16_t*)(ws + oGLOG) + ro + bj * HALF) = pack8(g0, g1); } }
        } else if (pn < 12) {
            bf16_t* base = (bf16_t*)(ws + (pn < 10 ? oQB : oKB));
#pragma unroll
            for (int ai = 0; ai < 2; ++ai)
#pragma unroll
                for (int m = 0; m < 4; ++m) { const int row = row0 + ai * HALF + m * 16, b = row >> 11, t = row & 2047;
#pragma unroll
                    for (int bj = 0; bj < 2; ++bj) { const int c = (pn & 1) * 256 + bj * HALF + cl0, h = c >> 6, d = c & 63;
                        *(u32x4*)(base + ((((size_t)(b * 8 + h) * 64 + (t >> 5)) * 4 + (d >> 4)) * 64 + ((t & 31) + 32 * ((d >> 3) & 1))) * 8) = pack8(acc[ai][bj][m][0], acc[ai][bj][m][1]); } }
        } else if (pn < 14) {
#pragma unroll
            for (int ai = 0; ai < 2; ++ai)
#pragma unroll
                for (int m = 0; m < 4; ++m) { const int row = row0 + ai * HALF + m * 16, b = row >> 11, t = row & 2047;
#pragma unroll
                    for (int bj = 0; bj < 2; ++bj) { const int c = (pn & 1) * 256 + bj * HALF + cl0, h = c >> 6, d = c & 63; const u32x4 w = pack8(acc[ai][bj][m][0], acc[ai][bj][m][1]);
                        bf16_t* p = (bf16_t*)(ws + oVT) + (((((size_t)(b * 8 + h) * 64 + (t >> 5)) * 2 + (d >> 5)) * 2 + ((t >> 4) & 1)) * 64 + ((d & 31) + 32 * (((t & 15) >> 2) & 1))) * 8 + (4 * ((t & 15) >> 3) + (t & 3));
                        p[0] = (bf16_t)(w.x & 0xffffu); p[8] = (bf16_t)(w.x >> 16); p[16] = (bf16_t)(w.y & 0xffffu); p[24] = (bf16_t)(w.y >> 16);
                        p[32] = (bf16_t)(w.z & 0xffffu); p[40] = (bf16_t)(w.z >> 16); p[48] = (bf16_t)(w.w & 0xffffu); p[56] = (bf16_t)(w.w >> 16); } }
        } else {
            int lz = fq * 16 + fr; asm volatile("" : "+v"(lz));
            unsigned char* base = ws + (pn < 18 ? oGTA : oGTB) + (((size_t)(u.pm * 4 + ((pn - 14) & 3)) * 8 + (wr * 4 + wc)) * 8) * 1024 + lz * 16;
#pragma unroll
            for (int ai = 0; ai < 2; ++ai)
#pragma unroll
                for (int m = 0; m < 4; ++m) { u32x4 w;
#pragma unroll
                    for (int bj = 0; bj < 2; ++bj) { f32x4 v0 = acc[ai][bj][m][0], v1 = acc[ai][bj][m][1];
#pragma unroll
                        for (int j = 0; j < 4; ++j) { v0[j] = __builtin_amdgcn_rcpf(__builtin_fmaf(__builtin_amdgcn_exp2f(v0[j]), 1.0f / 255.0f, 1.0f / 255.0f)); v1[j] = __builtin_amdgcn_rcpf(__builtin_fmaf(__builtin_amdgcn_exp2f(v1[j]), 1.0f / 255.0f, 1.0f / 255.0f)); }
                        if (bj == 0) { w.x = q8x4s(v0); w.y = q8x4s(v1); } else { w.z = q8x4s(v0); w.w = q8x4s(v1); } }
                    *(u32x4*)(base + (ai * 4 + m) * 1024) = w; }
        }
    }
};
template <int MODE> struct EpiGate {
    static constexpr bool PERM = true, AFTER_DRAIN = false, IDEM = (MODE != 1), SEG = false;
    bf16_t* O; const bf16_t* G;
    __device__ __forceinline__ void operator()(const f32x4 (&acc)[2][2][4][2], const Unit& u, int wr, int wc, int fr, int fq) const {
        const int row0 = u.pm * BM + wr * 64 + fr, col0 = u.pn * BM + wc * 32 + 8 * fq;
#pragma unroll
        for (int ai = 0; ai < 2; ++ai)
#pragma unroll
            for (int m = 0; m < 4; ++m) { const size_t ro = (size_t)(row0 + ai * HALF + m * 16) * 1024 + col0;
#pragma unroll
                for (int bj = 0; bj < 2; ++bj) { f32x4 v0 = acc[ai][bj][m][0], v1 = acc[ai][bj][m][1];
                    if (MODE != 2) { f32x4 g0, g1; unpack8(*(const u32x4*)(G + ro + bj * HALF), g0, g1); v0 = v0 * g0; v1 = v1 * g1; }
                    if (MODE == 1) { f32x4 o0, o1; unpack8(*(const u32x4*)(O + ro + bj * HALF), o0, o1); v0 = v0 + o0; v1 = v1 + o1; }
                    *(u32x4*)(O + ro + bj * HALF) = pack8(v0, v1); } }
    }
};
struct EpiWo {
    static constexpr bool PERM = true, AFTER_DRAIN = false, IDEM = true, SEG = false;
    const float* RES32; const bf16_t* RES16; bf16_t* T; const float* gt;
    float alpha;
    __device__ __forceinline__ void operator()(const f32x4 (&acc)[2][2][4][2], const Unit& u, int wr, int wc, int fr, int fq) const {
        const int row0 = u.pm * BM + wr * 64 + fr, col0 = u.pn * BM + wc * 32 + 8 * fq;
        const int b = (u.pm * BM) >> 11;
        f32x4 gv[2][2];
#pragma unroll
        for (int bj = 0; bj < 2; ++bj)
#pragma unroll
            for (int n = 0; n < 2; ++n) gv[bj][n] = *(const f32x4*)(gt + (size_t)b * 6144 + col0 + bj * HALF + 4 * n);
        if (RES32) {
#pragma unroll
            for (int ai = 0; ai < 2; ++ai)
#pragma unroll
                for (int mh = 0; mh < 2; ++mh) { f32x4 rr[2][2][2];
#pragma unroll
                    for (int m = 0; m < 2; ++m) { const size_t ro = (size_t)(row0 + ai * HALF + (mh * 2 + m) * 16) * 1024 + col0;
#pragma unroll
                        for (int bj = 0; bj < 2; ++bj) { rr[m][bj][0] = *(const f32x4*)(RES32 + ro + bj * HALF); rr[m][bj][1] = *(const f32x4*)(RES32 + ro + bj * HALF + 4); } }
                    __builtin_amdgcn_sched_barrier(0);
#pragma unroll
                    for (int m = 0; m < 2; ++m) { const size_t ro = (size_t)(row0 + ai * HALF + (mh * 2 + m) * 16) * 1024 + col0;
#pragma unroll
                        for (int bj = 0; bj < 2; ++bj) *(u32x4*)(T + ro + bj * HALF) = pack8(rr[m][bj][0] * alpha + acc[ai][bj][mh * 2 + m][0] * gv[bj][0], rr[m][bj][1] * alpha + acc[ai][bj][mh * 2 + m][1] * gv[bj][1]); }
                    __builtin_amdgcn_sched_barrier(0); }
        } else {
            u32x4 rw[4][2], pk[4][2];
#pragma unroll
            for (int m = 0; m < 4; ++m) { const size_t ro = (size_t)(row0 + m * 16) * 1024 + col0;
#pragma unroll
                for (int bj = 0; bj < 2; ++bj) rw[m][bj] = *(const u32x4*)(RES16 + ro + bj * HALF); }
            __builtin_amdgcn_sched_barrier(0);
#pragma unroll
            for (int m = 0; m < 4; ++m)
#pragma unroll
                for (int bj = 0; bj < 2; ++bj) { f32x4 r0, r1; unpack8(rw[m][bj], r0, r1); pk[m][bj] = pack8(r0 * alpha + acc[0][bj][m][0] * gv[bj][0], r1 * alpha + acc[0][bj][m][1] * gv[bj][1]); }
            __builtin_amdgcn_sched_barrier(0);
#pragma unroll
            for (int m = 0; m < 4; ++m) { const size_t ro = (size_t)(row0 + HALF + m * 16) * 1024 + col0;
#pragma unroll
                for (int bj = 0; bj < 2; ++bj) rw[m][bj] = *(const u32x4*)(RES16 + ro + bj * HALF); }
            __builtin_amdgcn_sched_barrier(0);
#pragma unroll
            for (int m = 0; m < 4; ++m) { const size_t ro = (size_t)(row0 + m * 16) * 1024 + col0;
#pragma unroll
                for (int bj = 0; bj < 2; ++bj) *(u32x4*)(T + ro + bj * HALF) = pk[m][bj]; }
            __builtin_amdgcn_sched_barrier(0);
#pragma unroll
            for (int m = 0; m < 4; ++m) { const size_t ro = (size_t)(row0 + HALF + m * 16) * 1024 + col0;
#pragma unroll
                for (int bj = 0; bj < 2; ++bj) { f32x4 r0, r1; unpack8(rw[m][bj], r0, r1);
                    *(u32x4*)(T + ro + bj * HALF) = pack8(r0 * alpha + acc[1][bj][m][0] * gv[bj][0], r1 * alpha + acc[1][bj][m][1] * gv[bj][1]); } }
        }
    }
};
struct EpiUp2 {
    static constexpr bool PERM = true, AFTER_DRAIN = false, IDEM = true, SEG = true;
    bf16_t* O; const unsigned char* GA_; const unsigned char* GB_;
    typedef unsigned u32x2e __attribute__((ext_vector_type(2)));
    __device__ __forceinline__ void mid(f32x4 (&acc)[2][2][4][2], const Unit& u, int wr, int wc, int fr, int fq) const {
        const size_t go = (((size_t)(u.pm * 4 + u.pn) * 8 + (wr * 4 + wc)) * 8) * 1024 + (fq * 16 + fr) * 16;
#pragma unroll
        for (int ai = 0; ai < 2; ++ai) { u32x2e ga[4][2], gb[4][2];
#pragma unroll
            for (int m = 0; m < 4; ++m) { const u32x4 wa = *(const u32x4*)(GA_ + go + (ai * 4 + m) * 1024), wb = *(const u32x4*)(GB_ + go + (ai * 4 + m) * 1024);
                ga[m][0] = (u32x2e){wa.x, wa.y}; ga[m][1] = (u32x2e){wa.z, wa.w}; gb[m][0] = (u32x2e){wb.x, wb.y}; gb[m][1] = (u32x2e){wb.z, wb.w}; }
            __builtin_amdgcn_sched_barrier(0);
#pragma unroll
            for (int m = 0; m < 4; ++m)
#pragma unroll
                for (int bj = 0; bj < 2; ++bj) { const f32x4 a0 = uq8x4raw(ga[m][bj].x), a1 = uq8x4raw(ga[m][bj].y), b0 = uq8x4raw(gb[m][bj].x), b1 = uq8x4raw(gb[m][bj].y);
#pragma unroll
                    for (int j = 0; j < 4; ++j) { acc[ai][bj][m][0][j] *= a0[j] * __builtin_amdgcn_rcpf(b0[j]); acc[ai][bj][m][1][j] *= a1[j] * __builtin_amdgcn_rcpf(b1[j]); } }
            __builtin_amdgcn_sched_barrier(0); }
    }
    __device__ __forceinline__ void operator()(const f32x4 (&acc)[2][2][4][2], const Unit& u, int wr, int wc, int fr, int fq) const {
        const int row0 = u.pm * BM + wr * 64 + fr, col0 = u.pn * BM + wc * 32 + 8 * fq;
        const size_t go = (((size_t)(u.pm * 4 + u.pn) * 8 + (wr * 4 + wc)) * 8) * 1024 + (fq * 16 + fr) * 16;
        u32x2e gb[2][4][2];
#pragma unroll
        for (int ai = 0; ai < 2; ++ai)
#pragma unroll
            for (int m = 0; m < 4; ++m) { const u32x4 wb = *(const u32x4*)(GB_ + go + (ai * 4 + m) * 1024); gb[ai][m][0] = (u32x2e){wb.x, wb.y}; gb[ai][m][1] = (u32x2e){wb.z, wb.w}; }
        __builtin_amdgcn_sched_barrier(0);
#pragma unroll
        for (int ai = 0; ai < 2; ++ai)
#pragma unroll
            for (int m = 0; m < 4; ++m) { const size_t ro = (size_t)(row0 + ai * HALF + m * 16) * 1024 + col0;
#pragma unroll
                for (int bj = 0; bj < 2; ++bj) { const f32x4 b0 = uq8x4(gb[ai][m][bj].x), b1 = uq8x4(gb[ai][m][bj].y);
                    *(u32x4*)(O + ro + bj * HALF) = pack8(acc[ai][bj][m][0] * b0, acc[ai][bj][m][1] * b1); } }
    }
};
struct EpiProbeK2 {
    static constexpr bool PERM = true, AFTER_DRAIN = false, IDEM = true, SEG = true;
    bf16_t* O;
    __device__ __forceinline__ void mid(f32x4 (&acc)[2][2][4][2], const Unit&, int, int, int, int) const {}
    __device__ __forceinline__ void operator()(const f32x4 (&acc)[2][2][4][2], const Unit& u, int wr, int wc, int fr, int fq) const {
        const int row0 = u.pm * BM + wr * 64 + fr, col0 = u.pn * BM + wc * 32 + 8 * fq;
#pragma unroll
        for (int ai = 0; ai < 2; ++ai)
#pragma unroll
            for (int m = 0; m < 4; ++m) { const size_t ro = (size_t)(row0 + ai * HALF + m * 16) * 1024 + col0;
#pragma unroll
                for (int bj = 0; bj < 2; ++bj) *(u32x4*)(O + ro + bj * HALF) = pack8(acc[ai][bj][m][0] * 0.5f, acc[ai][bj][m][1] * 0.5f); }
    }
};


struct EpiPQ {
    static constexpr bool PERM = true, AFTER_DRAIN = false, IDEM = true, SEG = false;
    bf16_t* O;
    __device__ __forceinline__ void operator()(const f32x4 (&acc)[2][2][4][2], const Unit& u, int wr, int wc, int fr, int fq) const {
        const int row0 = u.pm * BM + wr * 64 + fr, col0 = u.pn * BM + wc * 32 + 8 * fq;
#pragma unroll
        for (int ai = 0; ai < 2; ++ai)
#pragma unroll
            for (int m = 0; m < 4; ++m) { const int r = row0 + ai * HALF + m * 16;
#pragma unroll
                for (int bj = 0; bj < 2; ++bj) { const int c = col0 + bj * HALF;
                    *(u32x4*)(O + ((((size_t)((r >> 5) * 8 + (c >> 7)) * 2 + ((c >> 6) & 1)) * 4 + ((c & 63) >> 4)) * 64 + ((r & 31) + 32 * ((c >> 3) & 1))) * 8) = pack8(acc[ai][bj][m][0], acc[ai][bj][m][1]); } }
    }
};

template <class Epi, class Sched, bool ALIGN_EPI = false, bool SP2 = false>
__device__ __forceinline__ void gemm_phase(PG8_LAS unsigned char* lds, const Gemm g, const Sched& S, const Epi& E, int tid_) {
    asm volatile("" : "+v"(tid_)); const int tid = tid_, wid = __builtin_amdgcn_readfirstlane(tid >> 6), lane = tid & 63, wr = wid >> 2, wc = wid & 3, fr = lane & 15, fq = lane >> 4;
    const int K = g.K, nt = K / BK;
    unsigned voffA[2], voffB[2];
#pragma unroll
    for (int i = 0; i < 2; ++i) { int R, C; stage_rc(tid * 16 + i * 8192, R, C); const int Rb = Epi::PERM ? ((R & ~31) + perm32(R & 31)) : R;
        voffA[i] = (unsigned)(R * K + C) * 2u; voffB[i] = (unsigned)(Rb * K + C) * 2u; }
    const size_t kstep = (size_t)(BK * 2);
    const size_t hstep = (size_t)HALF * K * 2;
    const size_t tstep = 2 * hstep;
    const unsigned ldsw = (unsigned)wid * 1024u;
    const int aoff = lds_byte(wr * 64 + fr, fq * 8), boff = lds_byte(wc * 32 + fr, fq * 8);
#define PG8_SA(b, h) (((b) * 2 + (h)) * HTB)
#define PG8_SB(b, h) ((4 + (b) * 2 + (h)) * HTB)
#define PG8_STAGE(bufoff, gbase, voff) do { _Pragma("unroll") for (int _i = 0; _i < 2; ++_i) \
        __builtin_amdgcn_global_load_lds((const unsigned*)((const char*)(gbase) + (voff)[_i]), (PG8_LAS unsigned*)(lds + (bufoff) + ldsw + _i * 8192), 16, 0, 0); } while (0)
#define PG8_LDA(dst, b, h) do { _Pragma("unroll") for (int m = 0; m < 4; ++m) _Pragma("unroll") for (int k = 0; k < 2; ++k) dst[m][k] = *(const PG8_LAS bf16x8*)(lds + PG8_SA(b, h) + aoff + m * 2048 + k * 1024); } while (0)
#define PG8_LDB(dst, b, h) do { _Pragma("unroll") for (int n = 0; n < 2; ++n) _Pragma("unroll") for (int k = 0; k < 2; ++k) dst[n][k] = *(const PG8_LAS bf16x8*)(lds + PG8_SB(b, h) + boff + n * 2048 + k * 1024); } while (0)
#define PG8_MMA(ai, bj, At, Bt) do { __builtin_amdgcn_s_setprio(1); _Pragma("unroll") for (int m = 0; m < 4; ++m) _Pragma("unroll") for (int n = 0; n < 2; ++n) _Pragma("unroll") for (int k = 0; k < 2; ++k) \
        acc[ai][bj][m][n] = __builtin_amdgcn_mfma_f32_16x16x32_bf16(Bt[n][k], At[m][k], acc[ai][bj][m][n], 0, 0, 0); __builtin_amdgcn_s_setprio(0); } while (0)
#define PG8_WAIT_V(n) asm volatile("s_waitcnt vmcnt(" #n ")" ::: "memory")
#define PG8_WAIT_L(n) asm volatile("s_waitcnt lgkmcnt(" #n ")" ::: "memory")
#define PG8_BAR __builtin_amdgcn_s_barrier()
#define PG8_SCHED __builtin_amdgcn_sched_barrier(0)
    Unit cur, nxt; int ui = 0;
    if (!S.next(0, cur)) return;
    f32x4 acc[2][2][4][2];
#pragma unroll
    for (int a = 0; a < 2; ++a)
#pragma unroll
        for (int b = 0; b < 2; ++b)
#pragma unroll
            for (int m = 0; m < 4; ++m)
#pragma unroll
                for (int n = 0; n < 2; ++n) acc[a][b][m][n] = (f32x4){0.f, 0.f, 0.f, 0.f};
    bf16x8 At[4][2], B0[2][2], B1[2][2];
    const char* cA = (const char*)(cur.seg ? g.A2 : g.A) + (size_t)cur.pm * tstep; const char* cB = (const char*)(cur.seg ? g.Bt2 : g.Bt) + (size_t)cur.pn * tstep;
    S.a_ready(cur);
    if constexpr (SP2) {
        PG8_STAGE(PG8_SB(0, 0), cB, voffB); PG8_STAGE(PG8_SB(0, 1), cB + hstep, voffB); PG8_STAGE(PG8_SA(0, 0), cA, voffA); PG8_STAGE(PG8_SA(0, 1), cA + hstep, voffA);
        if (wr == 1) PG8_BAR;
        PG8_WAIT_V(2); PG8_BAR;
        PG8_STAGE(PG8_SB(1, 0), cB + kstep, voffB); PG8_STAGE(PG8_SA(1, 0), cA + kstep, voffA); PG8_STAGE(PG8_SB(1, 1), cB + hstep + kstep, voffB);
        PG8_WAIT_V(6); PG8_BAR;
    } else {
        PG8_STAGE(PG8_SB(0, 0), cB, voffB); PG8_STAGE(PG8_SA(0, 0), cA, voffA); PG8_STAGE(PG8_SB(0, 1), cB + hstep, voffB); PG8_STAGE(PG8_SA(0, 1), cA + hstep, voffA);
        if (wr == 1) PG8_BAR;
        PG8_WAIT_V(4); PG8_BAR;
        PG8_STAGE(PG8_SB(1, 0), cB + kstep, voffB); PG8_STAGE(PG8_SA(1, 0), cA + kstep, voffA); PG8_STAGE(PG8_SB(1, 1), cB + hstep + kstep, voffB);
        PG8_WAIT_V(6); PG8_BAR;
    }
    for (;;) {
        const bool has_next = S.next(ui + 1, nxt);
        const char* nA = has_next ? (const char*)(nxt.seg ? g.A2 : g.A) + (size_t)nxt.pm * tstep : cA; const char* nB = has_next ? (const char*)(nxt.seg ? g.Bt2 : g.Bt) + (size_t)nxt.pn * tstep : cB;
        for (int t = 0; t < nt; t += 2) {
            const bool last = (t == nt - 2);
            const char* a1 = cA + (size_t)(t + 1) * kstep;
            const char* a2 = last ? nA : cA + (size_t)(t + 2) * kstep; const char* b2 = last ? nB : cB + (size_t)(t + 2) * kstep;
            const char* a3 = a2 + kstep; const char* b3 = b2 + kstep;
            if (last && has_next) S.a_ready(nxt);
            if constexpr (SP2) {
            PG8_LDB(B0, 0, 0); PG8_LDB(B1, 0, 1); PG8_SCHED; PG8_LDA(At, 0, 0); PG8_STAGE(PG8_SA(1, 1), a1 + hstep, voffA);
            PG8_WAIT_V(8); PG8_WAIT_L(0); PG8_BAR; PG8_MMA(0, 0, At, B0); PG8_MMA(0, 1, At, B1); PG8_BAR; PG8_SCHED;
            PG8_LDA(At, 0, 1); PG8_STAGE(PG8_SB(0, 0), b2, voffB); PG8_STAGE(PG8_SB(0, 1), b2 + hstep, voffB); PG8_STAGE(PG8_SA(0, 0), a2, voffA);
            PG8_WAIT_V(8); PG8_WAIT_L(0); PG8_BAR; PG8_MMA(1, 0, At, B0); PG8_MMA(1, 1, At, B1); PG8_BAR; PG8_SCHED;
            PG8_LDB(B0, 1, 0); PG8_LDB(B1, 1, 1); PG8_SCHED; PG8_LDA(At, 1, 0); PG8_STAGE(PG8_SA(0, 1), a2 + hstep, voffA);
            PG8_WAIT_V(8); PG8_WAIT_L(0); PG8_BAR; PG8_MMA(0, 0, At, B0); PG8_MMA(0, 1, At, B1); PG8_BAR; PG8_SCHED;
            PG8_LDA(At, 1, 1); PG8_STAGE(PG8_SB(1, 0), b3, voffB); PG8_STAGE(PG8_SB(1, 1), b3 + hstep, voffB); PG8_STAGE(PG8_SA(1, 0), a3, voffA);
            PG8_WAIT_V(8); PG8_WAIT_L(0); PG8_BAR; PG8_MMA(1, 0, At, B0); PG8_MMA(1, 1, At, B1); PG8_BAR; PG8_SCHED;
            } else {
            PG8_LDB(B0, 0, 0); PG8_SCHED; PG8_LDA(At, 0, 0); PG8_STAGE(PG8_SA(1, 1), a1 + hstep, voffA);
            PG8_WAIT_L(8); PG8_BAR; PG8_WAIT_L(0); PG8_MMA(0, 0, At, B0); PG8_BAR; PG8_SCHED;
            PG8_LDB(B1, 0, 1); PG8_STAGE(PG8_SB(0, 0), b2, voffB);
            PG8_BAR; PG8_WAIT_L(0); PG8_MMA(0, 1, At, B1); PG8_BAR;
            PG8_LDA(At, 0, 1); PG8_STAGE(PG8_SA(0, 0), a2, voffA);
            PG8_BAR; PG8_WAIT_L(0); PG8_MMA(1, 0, At, B0); PG8_BAR; PG8_SCHED;
            PG8_STAGE(PG8_SB(0, 1), b2 + hstep, voffB);
            PG8_WAIT_V(6); PG8_BAR; PG8_MMA(1, 1, At, B1); PG8_BAR;
            PG8_LDB(B0, 1, 0); PG8_SCHED; PG8_LDA(At, 1, 0); PG8_STAGE(PG8_SA(0, 1), a2 + hstep, voffA);
            PG8_WAIT_L(8); PG8_BAR; PG8_WAIT_L(0); PG8_MMA(0, 0, At, B0); PG8_BAR; PG8_SCHED;
            PG8_LDB(B1, 1, 1); PG8_STAGE(PG8_SB(1, 0), b3, voffB);
            PG8_BAR; PG8_WAIT_L(0); PG8_MMA(0, 1, At, B1); PG8_BAR;
            PG8_LDA(At, 1, 1); PG8_STAGE(PG8_SA(1, 0), a3, voffA);
            PG8_BAR; PG8_WAIT_L(0); PG8_MMA(1, 0, At, B0); PG8_BAR; PG8_SCHED;
            PG8_STAGE(PG8_SB(1, 1), b3 + hstep, voffB);
            PG8_WAIT_V(6); PG8_BAR; PG8_MMA(1, 1, At, B1); PG8_BAR;
            }
        }
        bool carry = false;
        if constexpr (Epi::SEG) carry = (cur.seg == 0) && has_next;
        if constexpr (ALIGN_EPI) { if (wr == 0 && !carry) PG8_BAR; }
        if constexpr (Epi::SEG) { if (carry) E.mid(acc, cur, wr, wc, fr, fq); else { E(acc, cur, wr, wc, fr, fq); S.done(cur); } }
        else if constexpr (!Epi::AFTER_DRAIN) { E(acc, cur, wr, wc, fr, fq); if ((PROBE_MASK & 1024) && Epi::IDEM) { asm volatile("" ::: "memory"); E(acc, cur, wr, wc, fr, fq); } S.done(cur); }
        if (!has_next) break;
        { const float keep = carry ? 1.0f : 0.0f;
#pragma unroll
        for (int a = 0; a < 2; ++a)
#pragma unroll
            for (int b = 0; b < 2; ++b)
#pragma unroll
                for (int m = 0; m < 4; ++m)
#pragma unroll
                    for (int n = 0; n < 2; ++n) { if constexpr (Epi::SEG) acc[a][b][m][n] = acc[a][b][m][n] * keep; else acc[a][b][m][n] = (f32x4){0.f, 0.f, 0.f, 0.f}; } }
        cur = nxt; cA = nA; cB = nB; ++ui;
        if constexpr (ALIGN_EPI) { if (wr == 1 && !carry) PG8_BAR; }
    }
    PG8_WAIT_V(0);
    if constexpr (!ALIGN_EPI) { if (wr == 0) PG8_BAR; }
    PG8_BAR;
    if constexpr (Epi::AFTER_DRAIN) { E.fused(acc, cur, wr, wc, fr, fq, lds, wid, lane); S.done(cur); }
#undef PG8_SA
#undef PG8_SB
#undef PG8_STAGE
#undef PG8_LDA
#undef PG8_LDB
#undef PG8_MMA
#undef PG8_WAIT_V
#undef PG8_WAIT_L
#undef PG8_BAR
#undef PG8_SCHED
}
}

constexpr int DM = 1024, NBATCH = 32, SEQ = 2048, NTOK = NBATCH * SEQ, DEPTH = 4, INW = 5632, MODW = 6144;
constexpr float DN_ALPHA = 1.681792830507429f;
constexpr float LN_EPS = 1e-5f, RMS_EPS = 1e-6f;
constexpr int NWAVES = 8, NTHREADS = 512;

constexpr size_t MiB = 1u << 20;
constexpr size_t WS_CTL = 0, CTL_ZERO_BYTES = 1 * MiB;
constexpr size_t WS_MOD = 1 * MiB;
constexpr size_t WS_LB = 4 * MiB;
constexpr size_t WS_STATS = 4 * MiB + 65536;
constexpr size_t WS_SC = 4 * MiB + 65536 + 524288 + 262144;
constexpr size_t WS_HSC = 4 * MiB + 65536 + 524288;
constexpr size_t WS_WIN = 5 * MiB;
constexpr size_t WS_WUA = 49 * MiB, WS_WUB = 53 * MiB;
constexpr size_t WS_WO = 57 * MiB, WS_WPQ = 65 * MiB;
constexpr size_t WS_SK = 73 * MiB;
constexpr size_t WS_HB = 74 * MiB;
constexpr size_t WS_OA = 74 * MiB, WS_OB = 138 * MiB;
constexpr size_t WS_QA = 202 * MiB, WS_GLOG = 266 * MiB;
constexpr size_t WS_MERGED = 202 * MiB;
constexpr size_t WS_KK = 330 * MiB, WS_IA = 394 * MiB;
constexpr size_t WS_PQ = 330 * MiB;
constexpr size_t WS_GA = 458 * MiB;
constexpr size_t WS_IDX = 458 * MiB, WS_GATE = 474 * MiB;
constexpr size_t WS_QB = 522 * MiB, WS_KB = 586 * MiB, WS_VT = 650 * MiB;
constexpr size_t WS_PU = 522 * MiB, WS_PV = 586 * MiB;
constexpr size_t WS_GTA = 714 * MiB, WS_GTB = 842 * MiB;
constexpr size_t WS_MODP = 714 * MiB;
constexpr size_t WS_PART = 650 * MiB;
constexpr size_t WS_W16 = 714 * MiB;
constexpr size_t WS_Y = 202 * MiB;
constexpr size_t WS_XT = 778 * MiB;
constexpr size_t WS_HB8 = 266 * MiB;
constexpr size_t WS_END = 970 * MiB;

constexpr int CW_BAR = 4096;
constexpr int CW_QUEUE = 16384;

constexpr int RING_BYTES = 131072;
constexpr int LDS_BYTES = 163840;
constexpr int LDSCTL_OFF = LDS_BYTES - 512, MISC_OFF = LDSCTL_OFF + 320;

#define GAS __attribute__((address_space(1)))
#define LAS __attribute__((address_space(3)))
typedef unsigned short bf16;
typedef unsigned v4u __attribute__((ext_vector_type(4)));
typedef unsigned v2u __attribute__((ext_vector_type(2)));
typedef float f32x4 __attribute__((ext_vector_type(4)));
typedef float f32x2 __attribute__((ext_vector_type(2)));
typedef GAS unsigned gu32;
#define RLX_AGENT __ATOMIC_RELAXED, __HIP_MEMORY_SCOPE_AGENT
#define LDS_WAIT() asm volatile("s_waitcnt lgkmcnt(0)" ::: "memory")
#define VM_WAIT() asm volatile("s_waitcnt vmcnt(0)" ::: "memory")

__device__ __forceinline__ float bf2f(unsigned h) { return __uint_as_float(h << 16); }
__device__ __forceinline__ float bflo(unsigned w) { return __uint_as_float(w << 16); }
__device__ __forceinline__ float bfhi(unsigned w) { return __uint_as_float(w & 0xffff0000u); }
__device__ __forceinline__ unsigned pk2(float lo, float hi) { return pg8::cvt_pk_bf16(lo, hi); }
__device__ __forceinline__ v4u pk8(f32x4 a, f32x4 b) { v4u w; w.x = pk2(a[0], a[1]); w.y = pk2(a[2], a[3]); w.z = pk2(b[0], b[1]); w.w = pk2(b[2], b[3]); return w; }
__device__ __forceinline__ float fsigmoid(float z) { return 1.0f / (1.0f + __expf(-z)); }
template <int CTRL> __device__ __forceinline__ float dpp_f(float v) { return __int_as_float(__builtin_amdgcn_update_dpp(0, __float_as_int(v), CTRL, 0xF, 0xF, true)); }
typedef unsigned wr_u2 __attribute__((ext_vector_type(2)));
__device__ __forceinline__ float wave_sum(float v) {
    v += dpp_f<0xB1>(v); v += dpp_f<0x4E>(v); v += dpp_f<0x141>(v); v += dpp_f<0x140>(v);
    { const wr_u2 r = __builtin_amdgcn_permlane16_swap(__float_as_uint(v), __float_as_uint(v), false, false); v = __uint_as_float(r[0]) + __uint_as_float(r[1]); }
    { const wr_u2 r = __builtin_amdgcn_permlane32_swap(__float_as_uint(v), __float_as_uint(v), false, false); v = __uint_as_float(r[0]) + __uint_as_float(r[1]); }
    return v;
}
__device__ __forceinline__ float wave_max_fast(float v) {
    v = fmaxf(v, dpp_f<0xB1>(v)); v = fmaxf(v, dpp_f<0x4E>(v)); v = fmaxf(v, dpp_f<0x141>(v)); v = fmaxf(v, dpp_f<0x140>(v));
    { const wr_u2 r = __builtin_amdgcn_permlane16_swap(__float_as_uint(v), __float_as_uint(v), false, false); v = fmaxf(__uint_as_float(r[0]), __uint_as_float(r[1])); }
    { const wr_u2 r = __builtin_amdgcn_permlane32_swap(__float_as_uint(v), __float_as_uint(v), false, false); v = fmaxf(__uint_as_float(r[0]), __uint_as_float(r[1])); }
    return v;
}

template <class T> __device__ __forceinline__ T* opq(T* p) { long z = 0; asm volatile("" : "+s"(z)); return p + z; }
__device__ __forceinline__ int opqv(int v) { asm volatile("" : "+v"(v)); return v; }
__device__ __forceinline__ int opqs(int v) { asm volatile("" : "+s"(v)); return v; }
static_assert(WS_QA == pg8::EpiInProj::oQA && WS_GLOG == pg8::EpiInProj::oGLOG && WS_KK == pg8::EpiInProj::oKK && WS_IA == pg8::EpiInProj::oIA && WS_GA == pg8::EpiInProj::oGA && WS_QB == pg8::EpiInProj::oQB
              && WS_KB == pg8::EpiInProj::oKB && WS_VT == pg8::EpiInProj::oVT && WS_GTA == pg8::EpiInProj::oGTA && WS_GTB == pg8::EpiInProj::oGTB, "EpiInProj offsets vs workspace map");
#define XB_TMO      128
#define XB_XCNT(j)  (256  + 64 * (j))
#define XB_XSUB(j)  (1280 + 64 * (j))
#define XB_XGEN(j)  (2304 + 64 * (j))
#define XB_TOP      3328
#define XB_TOPGEN   3392
#define XCD_BAR_WORDS 3456
#define XB_SPIN_CAP (1u << 22)

__device__ __forceinline__ unsigned xb_ld(unsigned* p)              { return __hip_atomic_load(p, __ATOMIC_RELAXED, __HIP_MEMORY_SCOPE_AGENT); }
__device__ __forceinline__ unsigned xb_add(unsigned* p, unsigned v) { return __hip_atomic_fetch_add(p, v, __ATOMIC_RELAXED, __HIP_MEMORY_SCOPE_AGENT); }
__device__ __forceinline__ unsigned xb_xcc_id() { return (unsigned)__builtin_amdgcn_s_getreg((3 << 11) | 20) & 0xFu; }
#define XB_SPIN(cond, bar) do { unsigned _sp = 0; while (cond) { __builtin_amdgcn_s_sleep(1); \
    if ((++_sp & 255u) == 0u) { if (xb_ld(&(bar)[XB_TMO])) break; if (_sp > XB_SPIN_CAP) { atomicAdd(&(bar)[XB_TMO], 1u); break; } } } } while (0)

struct XcdBarrier {
    unsigned* bar; unsigned x;
    volatile LAS unsigned* st;
};

__device__ __forceinline__ XcdBarrier xcd_barrier_post(unsigned* bar, volatile LAS unsigned* st) {
    XcdBarrier b; b.bar = bar; b.x = xb_xcc_id(); b.st = st;
    if (threadIdx.x == 0) (void)xb_add(&bar[XB_XCNT(b.x)], 1u);
    return b;
}
__device__ __forceinline__ void xcd_barrier_complete(unsigned* bar, unsigned x, unsigned& nloc, unsigned& nx) {
    const unsigned G = gridDim.x * gridDim.y * gridDim.z;
    unsigned sum, cnt, mine, sp = 0u;
    for (;;) {
        sum = 0u; cnt = 0u; mine = 0u;
#pragma unroll
        for (unsigned j = 0; j < 16; ++j) { const unsigned c = xb_ld(&bar[XB_XCNT(j)]); sum += c; cnt += (c > 0u) ? 1u : 0u; mine = (j == x) ? c : mine; }
        if (sum == G) break;
        __builtin_amdgcn_s_sleep(1);
        if ((++sp & 255u) == 0u) { if (xb_ld(&bar[XB_TMO])) break; if (sp > XB_SPIN_CAP) { atomicAdd(&bar[XB_TMO], 1u); break; } }
    }
    nloc = mine > 0u ? mine : 1u; nx = cnt > 0u ? cnt : 1u;
}

__device__ __forceinline__ void xcd_barrier(const XcdBarrier& b) {
    asm volatile("s_waitcnt vmcnt(0)" ::: "memory");
    __syncthreads();
    if (threadIdx.x == 0) {
        unsigned* bar = b.bar;
        __builtin_amdgcn_s_waitcnt(0);
        unsigned nloc = b.st[0], nx = b.st[1];
        if (nloc == 0u) { xcd_barrier_complete(bar, b.x, nloc, nx); b.st[0] = nloc; b.st[1] = nx; }
        const unsigned old = xb_add(&bar[XB_XSUB(b.x)], 1u);
        const unsigned gen = old / nloc;
        if (old + 1u == (gen + 1u) * nloc) {
            __builtin_amdgcn_fence(__ATOMIC_RELEASE, "agent");
            asm volatile("s_waitcnt vmcnt(0)" ::: "memory");
            const unsigned og = xb_add(&bar[XB_TOP], 1u);
            const unsigned tg = og / nx;
            if (og + 1u == (tg + 1u) * nx) xb_add(&bar[XB_TOPGEN], 1u);
            else XB_SPIN(xb_ld(&bar[XB_TOPGEN]) == tg, bar);
            __builtin_amdgcn_fence(__ATOMIC_ACQUIRE, "agent");
            xb_add(&bar[XB_XGEN(b.x)], 1u);
            asm volatile("s_waitcnt vmcnt(0)" ::: "memory");
        } else {
            XB_SPIN(xb_ld(&bar[XB_XGEN(b.x)]) == gen, bar);
            __builtin_amdgcn_fence(__ATOMIC_ACQUIRE, "agent");
            asm volatile("s_waitcnt vmcnt(0)" ::: "memory");
        }
    }
    __syncthreads();
}

struct Args { const float* in[16]; float* out; unsigned char* ws; int ph_lo, ph_hi; };
struct Frame {
    LAS unsigned char* lds;
    int tid, lane, wave, vcu, G, gw, NGW;
};
#define IN_x         (A.in[0])
#define IN_c         (A.in[1])
#define IN_w_ada     (A.in[2])
#define IN_b_ada     (A.in[3])
#define IN_w_in      (A.in[4])
#define IN_lb_logits (A.in[5])
#define IN_hg_norm_g (A.in[6])
#define IN_w_up_a    (A.in[7])
#define IN_w_up_b    (A.in[8])
#define IN_w_o       (A.in[9])
#define IN_w_pq      (A.in[10])
#define IN_sub_keys  (A.in[11])
#define IN_peer_u    (A.in[12])
#define IN_peer_v    (A.in[13])
#define IN_ln_g      (A.in[14])
#define IN_ln_b      (A.in[15])
#define P_X      (xout)
#define WSF(off) ((float*)(ws + (off)))
#define WSB(off) ((bf16*)(ws + (off)))
#define P_MOD    WSF(WS_MOD)
#define P_LB     WSF(WS_LB)
#define P_MODP   WSF(WS_MODP)
#define P_GATE   WSF(WS_GATE)
#define P_WIN    WSB(WS_WIN)
#define P_WUA    WSB(WS_WUA)
#define P_WUB    WSB(WS_WUB)
#define P_WO     WSB(WS_WO)
#define P_WPQ    WSB(WS_WPQ)
#define P_SK     WSB(WS_SK)
#define P_HB     WSB(WS_HB)
#define P_OA     WSB(WS_OA)
#define P_OB     WSB(WS_OB)
#define P_QA     WSB(WS_QA)
#define P_GLOG   WSB(WS_GLOG)
#define P_MERGED WSB(WS_MERGED)
#define P_KK     WSB(WS_KK)
#define P_IA     WSB(WS_IA)
#define P_PQ     WSB(WS_PQ)
#define P_GA     WSB(WS_GA)
#define P_IDX    WSB(WS_IDX)
#define P_QB     WSB(WS_QB)
#define P_KB     WSB(WS_KB)
#define P_VT     WSB(WS_VT)
#define P_PU     WSB(WS_PU)
#define P_PV     WSB(WS_PV)
#define P_GTA    WSB(WS_GTA)
#define P_GTB    WSB(WS_GTB)
#define P_PART   WSF(WS_PART)
#define P_Y      WSB(WS_Y)
#define P_XT     WSB(WS_XT)
#define P_STATS  WSF(WS_STATS)
#define P_HB8    ((unsigned char*)(ws + WS_HB8))
#define P_HSC    WSF(WS_HSC)
#define P_SC     WSF(WS_SC)
#define P_W16    ((bf16*)(ws + WS_W16))
#define P_XS     ((bf16*)xout)
#define LAUNDER() Args A; { long z_ = 0; asm volatile("" : "+s"(z_)); _Pragma("unroll") for (int i_ = 0; i_ < 16; ++i_) A.in[i_] = A0.in[i_] + z_; A.out = A0.out + z_; A.ws = A0.ws + z_; A.ph_lo = A0.ph_lo; A.ph_hi = A0.ph_hi; } \
    Frame F = F0; { unsigned m_ = ~0u; asm volatile("" : "+s"(m_)); F.lane = (int)__builtin_amdgcn_mbcnt_hi(m_, __builtin_amdgcn_mbcnt_lo(m_, 0u)); F.tid = (F0.wave << 6) | F.lane; }     unsigned char* const ws = A.ws; float* const xout = A.out; (void)ws; (void)xout;

__device__ __forceinline__ void transpose_item(const float* W, int K, int N, bf16* WT, LAS float* scr, int item, int lane, bool inproj = false) {
    const int nblk = N / 32, kb = item / nblk, nb = item % nblk, k0 = 64 * kb, n0 = 32 * nb;
    const float ws_ = !inproj ? 1.0f : (n0 >= 3584 ? -1.4426950408889634f : ((n0 >= 2048 && n0 < 2560) ? 0.125f : 1.0f));
    { f32x4 wv[8]; const int cg = lane & 7, kr = lane >> 3;
#pragma unroll
      for (int i = 0; i < 8; ++i) wv[i] = *(const f32x4*)(W + (size_t)(k0 + kr + 8 * i) * N + n0 + 4 * cg);
#pragma unroll
      for (int i = 0; i < 8; ++i) { LAS float* sp = scr + (kr + 8 * i) * 33 + 4 * cg; sp[0] = wv[i][0]; sp[1] = wv[i][1]; sp[2] = wv[i][2]; sp[3] = wv[i][3]; } }
    LDS_WAIT(); asm volatile("" ::: "memory");
    const int c = lane & 7;
#pragma unroll
    for (int j = 0; j < 4; ++j) { const int n = (lane >> 3) + 8 * j; const LAS float* s = scr + (8 * c) * 33 + n;
        v4u o; o.x = pk2(s[0 * 33] * ws_, s[1 * 33] * ws_); o.y = pk2(s[2 * 33] * ws_, s[3 * 33] * ws_); o.z = pk2(s[4 * 33] * ws_, s[5 * 33] * ws_); o.w = pk2(s[6 * 33] * ws_, s[7 * 33] * ws_);
        *(v4u*)(WT + (size_t)(n0 + n) * K + k0 + 8 * c) = o; }
    LDS_WAIT(); asm volatile("" ::: "memory");
}

__device__ __forceinline__ void phase_proA(const Args& A0, Frame& F0) {
    LAUNDER();
    LAS float* scr = (LAS float*)(F.lds + F.wave * 16384);
    constexpr int I_IN = (DM / 64) * (INW / 32), I_UP = (512 / 64) * (DM / 32), I_SQ = (DM / 64) * (DM / 32), I_L = I_IN + 2 * I_UP + 2 * I_SQ;
    for (int it = F.gw; it < DEPTH * I_L; it += F.NGW) {
        const int l = it / I_L; int r = it % I_L;
        if (r < I_IN) { transpose_item(IN_w_in + (size_t)l * DM * INW, DM, INW, P_WIN + (size_t)l * INW * DM, scr, r, F.lane, true); continue; } r -= I_IN;
        if (r < I_UP) { transpose_item(IN_w_up_a + (size_t)l * 512 * DM, 512, DM, P_WUA + (size_t)l * DM * 512, scr, r, F.lane); continue; } r -= I_UP;
        if (r < I_UP) { transpose_item(IN_w_up_b + (size_t)l * 512 * DM, 512, DM, P_WUB + (size_t)l * DM * 512, scr, r, F.lane); continue; } r -= I_UP;
        if (r < I_SQ) { transpose_item(IN_w_o + (size_t)l * DM * DM, DM, DM, P_WO + (size_t)l * DM * DM, scr, r, F.lane); continue; } r -= I_SQ;
        transpose_item(IN_w_pq + (size_t)l * DM * DM, DM, DM, P_WPQ + (size_t)l * DM * DM, scr, r, F.lane);
    }
    { const int gt = F.vcu * NTHREADS + F.tid, NGT = F.G * NTHREADS;
      for (int i = gt; i < DEPTH * 2 * 8 * 128 * 64 / 8; i += NGT) { const f32x4 a = *(const f32x4*)(IN_sub_keys + (size_t)i * 8), b = *(const f32x4*)(IN_sub_keys + (size_t)i * 8 + 4);
          const int tab = i >> 10, n = (i & 1023) >> 3, d0 = (i & 7) * 8;
          *(v4u*)(P_SK + ((size_t)tab * 16 + (n >> 5) * 4 + (d0 >> 4)) * 512 + ((n & 31) + 32 * ((d0 >> 3) & 1)) * 8) = pk8(a, b); } }
    if (blockIdx.x == 0) { const int j = F.tid; float z[4], m = -1e30f, s = 0.f;
#pragma unroll
        for (int l = 0; l < 4; ++l) { z[l] = IN_lb_logits[l * 512 + j]; m = fmaxf(m, z[l]); }
#pragma unroll
        for (int l = 0; l < 4; ++l) { z[l] = __expf(z[l] - m); s += z[l]; }
        const float inv = 1.0f / s; float cum = 0.f; P_LB[j] = 0.f;
#pragma unroll
        for (int l = 1; l < 4; ++l) { cum += z[l] * inv; P_LB[l * 512 + j] = cum; } }
    for (int it = F.gw; it < DEPTH * 96 * 16; it += F.NGW) {
        const int l = it / 1536, r = it % 1536, nblk = r >> 4, ks = r & 15, n = nblk * 64 + F.lane, k0 = ks * 64;
#pragma unroll 8
        for (int i = 0; i < 32; ++i) { const int idx = F.lane + 64 * i, b = idx >> 6, kk = idx & 63; const float cv = IN_c[b * DM + k0 + kk]; scr[idx] = cv / (1.0f + __expf(-cv)); }
        LDS_WAIT(); asm volatile("" ::: "memory");
        float acc[32];
#pragma unroll
        for (int b = 0; b < 32; ++b) acc[b] = 0.f;
        const float* wp = IN_w_ada + ((size_t)l * DM + k0) * MODW + n;
#pragma unroll 4
        for (int kk = 0; kk < 64; kk += 4) {
            const float w0 = wp[(size_t)(kk + 0) * MODW], w1 = wp[(size_t)(kk + 1) * MODW], w2 = wp[(size_t)(kk + 2) * MODW], w3 = wp[(size_t)(kk + 3) * MODW];
#pragma unroll
            for (int b = 0; b < 32; ++b) { const f32x4 s = *(const LAS f32x4*)(scr + b * 64 + kk); acc[b] += s[0] * w0 + s[1] * w1 + s[2] * w2 + s[3] * w3; }
        }
#pragma unroll
        for (int b = 0; b < 32; ++b) P_MODP[(((size_t)ks * DEPTH + l) * 32 + b) * MODW + n] = acc[b];
        LDS_WAIT(); asm volatile("" ::: "memory");
    }
}
__device__ __forceinline__ void phase_proA2(const Args& A0, Frame& F0) {
    LAUNDER();
    const int gt = F.vcu * NTHREADS + F.tid, NGT = F.G * NTHREADS;
    for (int i = gt; i < DEPTH * 32 * MODW; i += NGT) { const int l = i / (32 * MODW), n = i % MODW; float s = IN_b_ada[l * MODW + n];
#pragma unroll
        for (int ks = 0; ks < 16; ++ks) s += P_MODP[(size_t)ks * DEPTH * 32 * MODW + i];
        P_MOD[i] = s; }
}
struct Row16 { f32x4 a0, a1, b0, b1; };
__device__ __forceinline__ Row16 ld_row(const float* p, int lane) { Row16 r; const f32x4* q = (const f32x4*)(p + 8 * lane); r.a0 = q[0]; r.a1 = q[1]; q = (const f32x4*)(p + 512 + 8 * lane); r.b0 = q[0]; r.b1 = q[1]; return r; }
__device__ __forceinline__ void st_row(float* p, int lane, const Row16& r) { f32x4* q = (f32x4*)(p + 8 * lane); q[0] = r.a0; q[1] = r.a1; q = (f32x4*)(p + 512 + 8 * lane); q[0] = r.b0; q[1] = r.b1; }
__device__ __forceinline__ Row16 ld_row_bf16(const bf16* p, int lane) { const v4u a = *(const v4u*)(p + 8 * lane), b = *(const v4u*)(p + 512 + 8 * lane); Row16 r;
    r.a0 = (f32x4){bflo(a.x), bfhi(a.x), bflo(a.y), bfhi(a.y)}; r.a1 = (f32x4){bflo(a.z), bfhi(a.z), bflo(a.w), bfhi(a.w)}; r.b0 = (f32x4){bflo(b.x), bfhi(b.x), bflo(b.y), bfhi(b.y)}; r.b1 = (f32x4){bflo(b.z), bfhi(b.z), bflo(b.w), bfhi(b.w)}; return r; }
__device__ __forceinline__ void st_row_bf16(bf16* p, int lane, const Row16& r) { *(v4u*)(p + 8 * lane) = pk8(r.a0, r.a1); *(v4u*)(p + 512 + 8 * lane) = pk8(r.b0, r.b1); }
__device__ __forceinline__ float sat8(float x) { return fminf(fmaxf(x, -448.0f), 448.0f); }
__device__ __forceinline__ unsigned pk4_fp8(f32x4 a) { int p = 0; p = __builtin_amdgcn_cvt_pk_fp8_f32(sat8(a[0]), sat8(a[1]), p, false); p = __builtin_amdgcn_cvt_pk_fp8_f32(sat8(a[2]), sat8(a[3]), p, true); return (unsigned)p; }
__device__ __forceinline__ v4u pk16_fp8(f32x4 a, f32x4 b, f32x4 c, f32x4 d) { v4u w; w.x = pk4_fp8(a); w.y = pk4_fp8(b); w.z = pk4_fp8(c); w.w = pk4_fp8(d); return w; }
__device__ __forceinline__ void st_row_fp8(unsigned char* p, int lane, const Row16& r) { v2u a, b; a.x = pk4_fp8(r.a0 * 16.0f); a.y = pk4_fp8(r.a1 * 16.0f); b.x = pk4_fp8(r.b0 * 16.0f); b.y = pk4_fp8(r.b1 * 16.0f); *(v2u*)(p + 8 * lane) = a; *(v2u*)(p + 512 + 8 * lane) = b; }
__device__ __forceinline__ float wave_max(float v) { return wave_max_fast(v); }
__device__ __forceinline__ unsigned pk4_i8(f32x4 a) { unsigned r = 0;
#pragma unroll
    for (int j = 0; j < 4; ++j) { const int q = (int)__builtin_amdgcn_fmed3f(__builtin_rintf(a[j]), -127.0f, 127.0f); r |= ((unsigned)q & 0xffu) << (8 * j); }
    return r; }
__device__ __forceinline__ float row_absmax(const Row16& r) { const f32x4 a = __builtin_elementwise_max(__builtin_elementwise_max(__builtin_elementwise_abs(r.a0), __builtin_elementwise_abs(r.a1)), __builtin_elementwise_max(__builtin_elementwise_abs(r.b0), __builtin_elementwise_abs(r.b1))); return fmaxf(fmaxf(a[0], a[1]), fmaxf(a[2], a[3])); }
__device__ __forceinline__ void st_row_i8(unsigned char* p, int lane, const Row16& r, float s) { v2u a, b; a.x = pk4_i8(r.a0 * s); a.y = pk4_i8(r.a1 * s); b.x = pk4_i8(r.b0 * s); b.y = pk4_i8(r.b1 * s); *(v2u*)(p + 8 * lane) = a; *(v2u*)(p + 512 + 8 * lane) = b; }
__device__ __forceinline__ void pk8_i4x2(f32x4 lo, f32x4 hi, float s, unsigned& wa, unsigned& wb) { wa = 0; wb = 0;
#pragma unroll
    for (int j = 0; j < 8; ++j) { const unsigned qi = __float_as_uint(__builtin_fmaf(j < 4 ? lo[j] : hi[j - 4], s, 12582912.0f)); wa |= (((qi + 8u) >> 4) & 15u) << (4 * j); wb |= (qi & 15u) << (4 * j); } }
__device__ __forceinline__ void st_row_i4x2(unsigned char* p, int lane, const Row16& r, float s) {
    unsigned char* q = p + (lane >> 5) * 256 + ((lane >> 2) & 7) * 32 + (lane & 3) * 4; unsigned wa, wb;
    pk8_i4x2(r.a0, r.a1, s, wa, wb); *(unsigned*)q = wa; *(unsigned*)(q + 16) = wb;
    pk8_i4x2(r.b0, r.b1, s, wa, wb); *(unsigned*)(q + 512) = wa; *(unsigned*)(q + 528) = wb; }
__device__ __forceinline__ Row16 modulate(const Row16& x, const Row16& sc, const Row16& sh) { Row16 r; r.a0 = x.a0 * (sc.a0 + 1.0f) + sh.a0; r.a1 = x.a1 * (sc.a1 + 1.0f) + sh.a1; r.b0 = x.b0 * (sc.b0 + 1.0f) + sh.b0; r.b1 = x.b1 * (sc.b1 + 1.0f) + sh.b1; return r; }
__device__ __forceinline__ float row_sum(const Row16& r) { const f32x4 s = (r.a0 + r.a1) + (r.b0 + r.b1); return (s[0] + s[1]) + (s[2] + s[3]); }
__device__ __forceinline__ Row16 layer_norm_row(const Row16& v, const float* g, const float* bta, int lane) {
    const float mean = wave_sum(row_sum(v)) * (1.0f / DM);
    Row16 d; d.a0 = v.a0 - mean; d.a1 = v.a1 - mean; d.b0 = v.b0 - mean; d.b1 = v.b1 - mean;
    Row16 q; q.a0 = d.a0 * d.a0; q.a1 = d.a1 * d.a1; q.b0 = d.b0 * d.b0; q.b1 = d.b1 * d.b1;
    const float rstd = __builtin_amdgcn_rsqf(wave_sum(row_sum(q)) * (1.0f / DM) + LN_EPS);
    const Row16 gg = ld_row(g, lane), bb = ld_row(bta, lane);
    Row16 o; o.a0 = d.a0 * rstd * gg.a0 + bb.a0; o.a1 = d.a1 * rstd * gg.a1 + bb.a1; o.b0 = d.b0 * rstd * gg.b0 + bb.b0; o.b1 = d.b1 * rstd * gg.b1 + bb.b1; return o;
}
__device__ __forceinline__ Row16 layer_norm_apply(const Row16& v, float mean, float rstd, const float* g, const float* bta, int lane) {
    const Row16 gg = ld_row(g, lane), bb = ld_row(bta, lane);
    Row16 o; o.a0 = (v.a0 - mean) * rstd * gg.a0 + bb.a0; o.a1 = (v.a1 - mean) * rstd * gg.a1 + bb.a1; o.b0 = (v.b0 - mean) * rstd * gg.b0 + bb.b0; o.b1 = (v.b1 - mean) * rstd * gg.b1 + bb.b1; return o;
}
__device__ __forceinline__ void row_stats(const Row16& v, float& mean, float& rstd) {
    mean = wave_sum(row_sum(v)) * (1.0f / DM);
    Row16 q; q.a0 = (v.a0 - mean) * (v.a0 - mean); q.a1 = (v.a1 - mean) * (v.a1 - mean); q.b0 = (v.b0 - mean) * (v.b0 - mean); q.b1 = (v.b1 - mean) * (v.b1 - mean);
    rstd = __builtin_amdgcn_rsqf(wave_sum(row_sum(q)) * (1.0f / DM) + LN_EPS);
}
__device__ __forceinline__ Row16 unpack_row(const v4u a, const v4u b) { Row16 r;
    r.a0 = (f32x4){bflo(a.x), bfhi(a.x), bflo(a.y), bfhi(a.y)}; r.a1 = (f32x4){bflo(a.z), bfhi(a.z), bflo(a.w), bfhi(a.w)}; r.b0 = (f32x4){bflo(b.x), bfhi(b.x), bflo(b.y), bfhi(b.y)}; r.b1 = (f32x4){bflo(b.z), bfhi(b.z), bflo(b.w), bfhi(b.w)}; return r; }
__device__ __forceinline__ Row16 row_affine(const Row16& v, float mean, float rstd, const Row16& g, const Row16& bb) {
    Row16 o; o.a0 = (v.a0 - mean) * rstd * g.a0 + bb.a0; o.a1 = (v.a1 - mean) * rstd * g.a1 + bb.a1; o.b0 = (v.b0 - mean) * rstd * g.b0 + bb.b0; o.b1 = (v.b1 - mean) * rstd * g.b1 + bb.b1; return o; }
__device__ __forceinline__ Row16 row_affine2(const Row16& v, float c1, float c0, const Row16& g, const Row16& bb) {
    Row16 o; o.a0 = (v.a0 * c1 + c0) * g.a0 + bb.a0; o.a1 = (v.a1 * c1 + c0) * g.a1 + bb.a1; o.b0 = (v.b0 * c1 + c0) * g.b0 + bb.b0; o.b1 = (v.b1 * c1 + c0) * g.b1 + bb.b1; return o; }
__device__ __forceinline__ Row16 row_scale(const Row16& v, float s) { Row16 o; o.a0 = v.a0 * s; o.a1 = v.a1 * s; o.b0 = v.b0 * s; o.b1 = v.b1 * s; return o; }
__device__ __forceinline__ Row16 row_fma(const Row16& x, const Row16& m, const Row16& a) { Row16 o; o.a0 = x.a0 * m.a0 + a.a0; o.a1 = x.a1 * m.a1 + a.a1; o.b0 = x.b0 * m.b0 + a.b0; o.b1 = x.b1 * m.b1 + a.b1; return o; }
__device__ __forceinline__ Row16 row_add1(const Row16& v) { Row16 o; o.a0 = v.a0 + 1.0f; o.a1 = v.a1 + 1.0f; o.b0 = v.b0 + 1.0f; o.b1 = v.b1 + 1.0f; return o; }
struct RowSpan { int t0, t1; };
__device__ __forceinline__ RowSpan wave_span(int gw, int NGW) { const int R = 2 * ((NTOK / 2 + NGW - 1) / NGW); RowSpan s; s.t0 = gw * R; s.t1 = s.t0 + R < NTOK ? s.t0 + R : NTOK; return s; }
__device__ __forceinline__ void phase_proB(const Args& A0, Frame& F0) {
    LAUNDER();
    const int lane = F.lane; const RowSpan sp = wave_span(F.gw, F.NGW);
    for (int s0 = sp.t0; s0 < sp.t1; ) { const int b = s0 >> 11, s1 = sp.t1 < ((b + 1) << 11) ? sp.t1 : ((b + 1) << 11);
        const float* mod = P_MOD + (size_t)b * MODW; const Row16 SH = ld_row(mod, lane), SC = ld_row(mod + 1024, lane);
#define CLP(t) ((t) < s1 - 2 ? (t) : s1 - 2)
        Row16 a0 = ld_row(IN_x + (size_t)s0 * DM, lane), a1 = ld_row(IN_x + (size_t)(s0 + 1) * DM, lane);
        for (int tok = s0; tok < s1; tok += 4) {
            const Row16 b0 = ld_row(IN_x + (size_t)CLP(tok + 2) * DM, lane), b1 = ld_row(IN_x + (size_t)(CLP(tok + 2) + 1) * DM, lane);
            __builtin_amdgcn_sched_barrier(0);
            st_row_bf16(P_HB + (size_t)tok * DM, lane, modulate(a0, SC, SH)); st_row_bf16(P_HB + (size_t)(tok + 1) * DM, lane, modulate(a1, SC, SH));
            __builtin_amdgcn_sched_barrier(0);
            a0 = ld_row(IN_x + (size_t)CLP(tok + 4) * DM, lane); a1 = ld_row(IN_x + (size_t)(CLP(tok + 4) + 1) * DM, lane);
            __builtin_amdgcn_sched_barrier(0);
            st_row_bf16(P_HB + (size_t)CLP(tok + 2) * DM, lane, modulate(b0, SC, SH)); st_row_bf16(P_HB + (size_t)(CLP(tok + 2) + 1) * DM, lane, modulate(b1, SC, SH));
            __builtin_amdgcn_sched_barrier(0);
        }
#undef CLP
        s0 = s1; }
}
__device__ __forceinline__ void phase_ln1(const Args& A0, Frame& F0, int l) {
    LAUNDER();
    const float* lng = IN_ln_g + (size_t)(l * 2 + 0) * DM; const float* lnb = IN_ln_b + (size_t)(l * 2 + 0) * DM;
    { const int lane = F.lane; const RowSpan sp = wave_span(F.gw, F.NGW);
      const Row16 G = ld_row(lng, lane), B = ld_row(lnb, lane);
      for (int s0 = sp.t0; s0 < sp.t1; ) { const int b = s0 >> 11, s1 = sp.t1 < ((b + 1) << 11) ? sp.t1 : ((b + 1) << 11);
        const float* mod = P_MOD + ((size_t)l * 32 + b) * MODW; const Row16 SH = ld_row(mod + 3072, lane), SC1 = row_add1(ld_row(mod + 4096, lane));
        struct Raw { v4u a, b; };
        auto ldraw = [&](int tok) __attribute__((always_inline)) { Raw r; const bf16* p = P_XT + (size_t)tok * DM; r.a = *(const v4u*)(p + 8 * lane); r.b = *(const v4u*)(p + 512 + 8 * lane); return r; };
        auto row = [&](const Raw& r, int tok) __attribute__((always_inline)) {
            const Row16 v = unpack_row(r.a, r.b);
            float mu, rs; row_stats(v, mu, rs);
            const Row16 xn = row_affine2(v, rs, -mu * rs, G, B);
            if (lane == 0) *(f32x2*)(P_STATS + (size_t)tok * 2) = (f32x2){mu, rs};
            const Row16 hf = row_fma(xn, SC1, SH);
            st_row_bf16(P_HB + (size_t)tok * DM, lane, hf);
            const float m1 = fmaxf(wave_max(row_absmax(hf)), 1e-20f); st_row_i4x2(P_HB8 + (size_t)tok * DM, lane, hf, 119.0f / m1); if (lane == 0) P_HSC[tok] = m1 * (1.0f / 119.0f); };
#define CLP(t) ((t) < s1 - 2 ? (t) : s1 - 2)
        Raw a0 = ldraw(s0), a1 = ldraw(s0 + 1);
        for (int tok = s0; tok < s1; tok += 4) {
            const Raw b0 = ldraw(CLP(tok + 2)), b1 = ldraw(CLP(tok + 2) + 1);
            __builtin_amdgcn_sched_barrier(0);
            row(a0, tok); row(a1, tok + 1);
            __builtin_amdgcn_sched_barrier(0);
            a0 = ldraw(CLP(tok + 4)); a1 = ldraw(CLP(tok + 4) + 1);
            __builtin_amdgcn_sched_barrier(0);
            row(b0, CLP(tok + 2)); row(b1, CLP(tok + 2) + 1);
            __builtin_amdgcn_sched_barrier(0);
        }
#undef CLP
        s0 = s1; } }
}
__device__ __forceinline__ void peer_convert(const Args& A0, Frame& F0, int l) {
    LAUNDER();
    const int gt = F.vcu * NTHREADS + F.tid, NGT = F.G * NTHREADS;
    const float* pu = IN_peer_u + (size_t)l * 16384 * DM; const float* pv = IN_peer_v + (size_t)l * 16384 * DM;
#if PEER_Q4
    for (int i = gt; i < 16384 * 64; i += NGT) { const int row = i >> 6, ln = i & 63; const size_t so = (size_t)row * DM + 16 * ln, dofs = (size_t)(ln >> 4) * 16384 * 128 + (size_t)row * 128 + (ln & 15) * 8;
        float ustep, vscale;
        { const f32x4 x[4] = {*(const f32x4*)(pu + so), *(const f32x4*)(pu + so + 4), *(const f32x4*)(pu + so + 8), *(const f32x4*)(pu + so + 12)};
          const f32x4 sq = (x[0] * x[0] + x[1] * x[1]) + (x[2] * x[2] + x[3] * x[3]);
          ustep = fmaxf(0.3352f * __builtin_sqrtf(wave_sum((sq[0] + sq[1]) + (sq[2] + sq[3])) * (1.0f / DM)), 1e-30f); const float inv = 1.0f / ustep;
          v2u w = (v2u){0u, 0u};
#pragma unroll
          for (int j = 0; j < 16; ++j) { const int q = (int)__builtin_amdgcn_fmed3f(__builtin_rintf(x[j >> 2][j & 3] * inv), -8.0f, 7.0f); if (j < 8) w.x |= ((unsigned)q & 15u) << (4 * j); else w.y |= ((unsigned)q & 15u) << (4 * (j - 8)); }
          *(v2u*)((unsigned char*)P_PU + dofs) = w; }
        { const f32x4 x[4] = {*(const f32x4*)(pv + so), *(const f32x4*)(pv + so + 4), *(const f32x4*)(pv + so + 8), *(const f32x4*)(pv + so + 12)};
          const f32x4 am = __builtin_elementwise_max(__builtin_elementwise_max(__builtin_elementwise_abs(x[0]), __builtin_elementwise_abs(x[1])), __builtin_elementwise_max(__builtin_elementwise_abs(x[2]), __builtin_elementwise_abs(x[3])));
          vscale = fmaxf(wave_max(fmaxf(fmaxf(am[0], am[1]), fmaxf(am[2], am[3]))) * (1.0f / 6.0f), 1e-30f); const float inv = 1.0f / vscale;
          v2u w = (v2u){0u, 0u};
#pragma unroll
          for (int j = 0; j < 16; ++j) { const float t = x[j >> 2][j & 3] * inv, a = fabsf(t);
              const unsigned c = (unsigned)(a > 0.25f) + (unsigned)(a > 0.75f) + (unsigned)(a > 1.25f) + (unsigned)(a > 1.75f) + (unsigned)(a > 2.5f) + (unsigned)(a > 3.5f) + (unsigned)(a > 5.0f), q = c | (t < 0.0f ? 8u : 0u);
              if (j < 8) w.x |= q << (4 * j); else w.y |= q << (4 * (j - 8)); }
          *(v2u*)((unsigned char*)P_PV + dofs) = w; }
        if (ln == 0) *(f32x2*)(P_SC + (size_t)row * 2) = (f32x2){ustep, vscale}; }
#elif PEER_FP8
#if PEER_KSLICE
    for (int i = gt; i < 16384 * 64; i += NGT) { const int row = i >> 6, ln = i & 63; const size_t so = (size_t)row * DM + 16 * ln, dofs = (size_t)(ln >> 3) * 16384 * 128 + (size_t)row * 128 + (ln & 7) * 16;
        { const f32x4 a = *(const f32x4*)(pu + so) * 2048.0f, b = *(const f32x4*)(pu + so + 4) * 2048.0f, c = *(const f32x4*)(pu + so + 8) * 2048.0f, d = *(const f32x4*)(pu + so + 12) * 2048.0f;
          if (U_INT8) { v4u w; w.x = pk4_i8(a * (600.0f / 2048.0f)); w.y = pk4_i8(b * (600.0f / 2048.0f)); w.z = pk4_i8(c * (600.0f / 2048.0f)); w.w = pk4_i8(d * (600.0f / 2048.0f)); *(v4u*)((unsigned char*)P_PU + dofs) = w; }
          else *(v4u*)((unsigned char*)P_PU + dofs) = pk16_fp8(a, b, c, d); }
        { const f32x4 a = *(const f32x4*)(pv + so) * 128.0f, b = *(const f32x4*)(pv + so + 4) * 128.0f, c = *(const f32x4*)(pv + so + 8) * 128.0f, d = *(const f32x4*)(pv + so + 12) * 128.0f;
          *(v4u*)((unsigned char*)P_PV + dofs) = pk16_fp8(a, b, c, d); } }
#else
    for (int i = gt; i < 16384 * 64; i += NGT) { const int row = i >> 6, ln = i & 63; const size_t so = (size_t)row * DM + 8 * ln;
        { const f32x4 a = *(const f32x4*)(pu + so) * 2048.0f, b = *(const f32x4*)(pu + so + 4) * 2048.0f, c = *(const f32x4*)(pu + so + 512) * 2048.0f, d = *(const f32x4*)(pu + so + 516) * 2048.0f;
          *(v4u*)((unsigned char*)P_PU + (size_t)row * 1024 + 16 * ln) = pk16_fp8(a, b, c, d); }
        { const f32x4 a = *(const f32x4*)(pv + so) * 128.0f, b = *(const f32x4*)(pv + so + 4) * 128.0f, c = *(const f32x4*)(pv + so + 512) * 128.0f, d = *(const f32x4*)(pv + so + 516) * 128.0f;
          *(v4u*)((unsigned char*)P_PV + (size_t)row * 1024 + 16 * ln) = pk16_fp8(a, b, c, d); } }
#endif
#else
    for (int i = gt; i < 16384 * DM / 8; i += NGT) {
        const f32x4 a = *(const f32x4*)(pu + (size_t)i * 8), b = *(const f32x4*)(pu + (size_t)i * 8 + 4); *(v4u*)(P_PU + (size_t)i * 8) = pk8(a, b);
        const f32x4 c = *(const f32x4*)(pv + (size_t)i * 8), d = *(const f32x4*)(pv + (size_t)i * 8 + 4); *(v4u*)(P_PV + (size_t)i * 8) = pk8(c, d); }
#endif
}

__device__ __forceinline__ void hgrn_simple(const Args& A0, Frame& F0, int l) {
    LAUNDER();
    LAS float* fL = (LAS float*)F.lds;
    LAS float* kL = fL + 2048, *qL = kL + 2048, *vL = qL + 2048;
    LAS float* part = vL + 2048;
    const int tid = F.tid, e = tid & 127, dq = tid >> 7;
    for (int unit = blockIdx.x; unit < 128; unit += F.G) {
        const int b = unit >> 2, h = unit & 3;
        float S[32];
#pragma unroll
        for (int i = 0; i < 32; ++i) S[i] = 0.f;
        for (int t0 = 0; t0 < SEQ; t0 += 16) {
#pragma unroll
            for (int i = 0; i < 4; ++i) { const int idx = tid + 512 * i, tt = idx >> 7, d = idx & 127; const size_t off = ((size_t)(b * SEQ + t0 + tt)) * 512 + h * 128 + d;
                fL[idx] = __expf(bf2f(P_GLOG[off])); kL[idx] = bf2f(P_KK[off]); qL[idx] = bf2f(P_QA[off]); vL[idx] = bf2f(P_IA[off]); }
            __syncthreads();
            for (int tt = 0; tt < 16; ++tt) {
                const float ve = vL[tt * 128 + e]; float o = 0.f;
#pragma unroll
                for (int i4 = 0; i4 < 8; ++i4) {
                    const f32x4 f4 = *(const LAS f32x4*)(fL + tt * 128 + 32 * dq + 4 * i4), k4 = *(const LAS f32x4*)(kL + tt * 128 + 32 * dq + 4 * i4), q4 = *(const LAS f32x4*)(qL + tt * 128 + 32 * dq + 4 * i4);
#pragma unroll
                    for (int j = 0; j < 4; ++j) { S[4 * i4 + j] = f4[j] * S[4 * i4 + j] + k4[j] * ve; o += S[4 * i4 + j] * q4[j]; }
                }
                part[(tt * 4 + dq) * 128 + e] = o;
            }
            __syncthreads();
            { const int tt = tid >> 5, eg = (tid & 31) * 4; f32x4 o4 = (f32x4){0.f, 0.f, 0.f, 0.f};
#pragma unroll
              for (int q = 0; q < 4; ++q) o4 = o4 + *(const LAS f32x4*)(part + (tt * 4 + q) * 128 + eg);
              float ss = (o4[0] * o4[0] + o4[1] * o4[1]) + (o4[2] * o4[2] + o4[3] * o4[3]);
#pragma unroll
              for (int m = 1; m < 32; m <<= 1) ss += __shfl_xor(ss, m);
              const float rstd = 1.0f / sqrtf(ss * (1.0f / 128.0f) + RMS_EPS);
              const size_t ro = ((size_t)(b * SEQ + t0 + tt)) * 512 + h * 128 + eg;
              const f32x4 gn = *(const f32x4*)(IN_hg_norm_g + l * 512 + h * 128 + eg); const v2u gw2 = *(const v2u*)(P_GA + ro);
              const float r0 = o4[0] * rstd * gn[0] * bflo(gw2.x), r1 = o4[1] * rstd * gn[1] * bfhi(gw2.x), r2 = o4[2] * rstd * gn[2] * bflo(gw2.y), r3 = o4[3] * rstd * gn[3] * bfhi(gw2.y);
              v2u w; w.x = pk2(r0, r1); w.y = pk2(r2, r3); *(v2u*)(P_OA + ro) = w; }
            __syncthreads();
        }
    }
}
__device__ __forceinline__ void attn_simple(const Args& A0, Frame& F0) {
    LAUNDER();
    for (int item = blockIdx.x; item < 1024; item += F.G) {
        const int bh = item >> 2, t = (item & 3) * 512 + F.tid, b = bh >> 3, h = bh & 7;
        float q[64], o[64];
        { const v4u* qp = (const v4u*)(P_QB + ((size_t)bh * SEQ + t) * 64);
#pragma unroll
          for (int i = 0; i < 8; ++i) { const v4u w = qp[i]; q[8 * i] = bflo(w.x); q[8 * i + 1] = bfhi(w.x); q[8 * i + 2] = bflo(w.y); q[8 * i + 3] = bfhi(w.y); q[8 * i + 4] = bflo(w.z); q[8 * i + 5] = bfhi(w.z); q[8 * i + 6] = bflo(w.w); q[8 * i + 7] = bfhi(w.w); } }
#pragma unroll
        for (int d = 0; d < 64; ++d) o[d] = 0.f;
        float R = 0.f;
        for (int s = t - 1; s >= 0; --s) {
            if (R < -104.0f) break;
            const v4u* kp = (const v4u*)(P_KB + ((size_t)bh * SEQ + s) * 64); float z = 0.f;
#pragma unroll
            for (int i = 0; i < 8; ++i) { const v4u w = kp[i]; z += q[8 * i] * bflo(w.x) + q[8 * i + 1] * bfhi(w.x) + q[8 * i + 2] * bflo(w.y) + q[8 * i + 3] * bfhi(w.y) + q[8 * i + 4] * bflo(w.z) + q[8 * i + 5] * bfhi(w.z) + q[8 * i + 6] * bflo(w.w) + q[8 * i + 7] * bfhi(w.w); }
            const float sp = fmaxf(z, 0.f) + __logf(1.0f + __expf(-fabsf(z)));
            const float w = __expf(z - sp + R); R -= sp;
            const bf16* vp = P_VT + (size_t)bh * 64 * SEQ + s;
#pragma unroll
            for (int d = 0; d < 64; ++d) o[d] += w * bf2f(vp[(size_t)d * SEQ]);
        }
        bf16* op = P_OB + ((size_t)(b * SEQ + t)) * 512 + h * 64;
#pragma unroll
        for (int i = 0; i < 8; ++i) { v4u w; w.x = pk2(o[8 * i], o[8 * i + 1]); w.y = pk2(o[8 * i + 2], o[8 * i + 3]); w.z = pk2(o[8 * i + 4], o[8 * i + 5]); w.w = pk2(o[8 * i + 6], o[8 * i + 7]); *(v4u*)(op + 8 * i) = w; }
    }
}

__device__ __forceinline__ unsigned f2sort(float f) { const unsigned u = __float_as_uint(f); return u ^ ((unsigned)((int)u >> 31) | 0x80000000u); }
__device__ __forceinline__ float sort2f(unsigned k) { return __uint_as_float((k & 0x80000000u) ? (k ^ 0x80000000u) : ~k); }
__device__ __forceinline__ void ins16(unsigned (&top)[16], unsigned x) {
#pragma unroll
    for (int i = 0; i < 16; ++i) { const unsigned hi = top[i] > x ? top[i] : x; x = top[i] > x ? x : top[i]; top[i] = hi; }
}
__device__ __forceinline__ void peer_topk_simple(const Args& A0, Frame& F0, int l) {
    LAUNDER();
    LAS unsigned char* nscr = (LAS unsigned char*)F.lds + (F.wave * 64 + F.lane) * 32;
    for (int item = blockIdx.x; item < NTOK / 64; item += F.G) {
        const int tok = item * 64 + F.lane, h = F.wave;
        unsigned top[2][16];
#pragma unroll
        for (int p = 0; p < 2; ++p) {
            float q[64];
            { const v4u* qp = (const v4u*)(P_PQ + (size_t)tok * DM + h * 128 + p * 64);
#pragma unroll
              for (int i = 0; i < 8; ++i) { const v4u w = qp[i]; q[8 * i] = bflo(w.x); q[8 * i + 1] = bfhi(w.x); q[8 * i + 2] = bflo(w.y); q[8 * i + 3] = bfhi(w.y); q[8 * i + 4] = bflo(w.z); q[8 * i + 5] = bfhi(w.z); q[8 * i + 6] = bflo(w.w); q[8 * i + 7] = bfhi(w.w); } }
#pragma unroll
            for (int i = 0; i < 16; ++i) top[p][i] = 0u;
            const bf16* key = P_SK + ((size_t)((l * 2 + p) * 8 + h)) * 128 * 64;
            for (int n = 0; n < 128; ++n) {
                const v4u* kp = (const v4u*)(key + n * 64); float s = 0.f;
#pragma unroll
                for (int i = 0; i < 8; ++i) { const v4u w = kp[i]; s += q[8 * i] * bflo(w.x) + q[8 * i + 1] * bfhi(w.x) + q[8 * i + 2] * bflo(w.y) + q[8 * i + 3] * bfhi(w.y) + q[8 * i + 4] * bflo(w.z) + q[8 * i + 5] * bfhi(w.z) + q[8 * i + 6] * bflo(w.w) + q[8 * i + 7] * bfhi(w.w); }
                ins16(top[p], (f2sort(s) & ~127u) | (unsigned)(127 - n));
            }
        }
        float v1[16], v2[16];
#pragma unroll
        for (int i = 0; i < 16; ++i) { v1[i] = sort2f(top[0][i] & ~127u); v2[i] = sort2f(top[1][i] & ~127u); nscr[i] = (unsigned char)(127u - (top[0][i] & 127u)); nscr[16 + i] = (unsigned char)(127u - (top[1][i] & 127u)); }
        unsigned ct[16];
#pragma unroll
        for (int i = 0; i < 16; ++i) ct[i] = 0u;
#pragma unroll
        for (int i = 0; i < 16; ++i)
#pragma unroll
            for (int j = 0; j < 16; ++j) if ((i + 1) * (j + 1) <= 16) ins16(ct, (f2sort(v1[i] + v2[j]) & ~255u) | (unsigned)(255 - (i * 16 + j)));
        LDS_WAIT(); asm volatile("" ::: "memory");
        float ev[16], es = 0.f; const float vmax = sort2f(ct[0] & ~255u);
#pragma unroll
        for (int k = 0; k < 16; ++k) { ev[k] = __expf(sort2f(ct[k] & ~255u) - vmax); es += ev[k]; }
        const float inv = 1.0f / es;
        bf16* ip = P_IDX + (size_t)tok * 128 + h * 16; float* gp = P_GATE + (size_t)tok * 128 + h * 16;
#pragma unroll
        for (int k = 0; k < 16; ++k) { const unsigned code = 255u - (ct[k] & 255u); const unsigned n1 = nscr[code >> 4], n2 = nscr[16 + (code & 15u)];
            ip[k] = (bf16)(n1 * 128u + n2); gp[k] = ev[k] * inv; }
        LDS_WAIT(); asm volatile("" ::: "memory");
    }
}

typedef __bf16 bf16x2_t __attribute__((ext_vector_type(2)));
__device__ __forceinline__ float dot2(unsigned a, unsigned b, float c) { return __builtin_amdgcn_fdot2_f32_bf16(__builtin_bit_cast(bf16x2_t, a), __builtin_bit_cast(bf16x2_t, b), c, false); }
__device__ __forceinline__ float dot8(v4u a, v4u b, float c) { c = dot2(a.x, b.x, c); c = dot2(a.y, b.y, c); c = dot2(a.z, b.z, c); return dot2(a.w, b.w, c); }
__device__ __forceinline__ void axpy8(float (&y)[16], int o, float w, v4u v) {
    y[o + 0] += w * bflo(v.x); y[o + 1] += w * bfhi(v.x); y[o + 2] += w * bflo(v.y); y[o + 3] += w * bfhi(v.y);
    y[o + 4] += w * bflo(v.z); y[o + 5] += w * bfhi(v.z); y[o + 6] += w * bflo(v.w); y[o + 7] += w * bfhi(v.w);
}
#if PEER_FP8
__device__ __forceinline__ void peer_group8(const bf16* PUp, const bf16* PVp, Frame& F, const float (&hf)[16], unsigned idxv, float gatev, int e0, float (&y)[16]) {
    const int lane = F.lane;
    v4u uq[8], vq[8];
#pragma unroll
    for (int j = 0; j < 8; ++j) { const unsigned e = (unsigned)__builtin_amdgcn_readlane((int)idxv, e0 + j);
        uq[j] = *(const v4u*)((const unsigned char*)PUp + (size_t)e * 1024 + 16 * lane); vq[j] = *(const v4u*)((const unsigned char*)PVp + (size_t)e * 1024 + 16 * lane); }
    float p[8];
#pragma unroll
    for (int j = 0; j < 8; ++j) { float s = 0.f; const unsigned uw[4] = {uq[j].x, uq[j].y, uq[j].z, uq[j].w};
#pragma unroll
        for (int w = 0; w < 4; ++w) { const f32x2 lo = __builtin_amdgcn_cvt_pk_f32_fp8((int)uw[w], false), hi = __builtin_amdgcn_cvt_pk_f32_fp8((int)uw[w], true);
            s += hf[4 * w] * lo[0]; s += hf[4 * w + 1] * lo[1]; s += hf[4 * w + 2] * hi[0]; s += hf[4 * w + 3] * hi[1]; }
        p[j] = s; }
    const bool b5 = lane & 32, b4 = lane & 16, b3 = lane & 8;
    float r[4];
#pragma unroll
    for (int i = 0; i < 4; ++i) { const float snd = b5 ? p[i] : p[i + 4], kp = b5 ? p[i + 4] : p[i]; r[i] = kp + __shfl_xor(snd, 32); }
    float r2[2];
#pragma unroll
    for (int i = 0; i < 2; ++i) { const float snd = b4 ? r[i] : r[i + 2], kp = b4 ? r[i + 2] : r[i]; r2[i] = kp + __shfl_xor(snd, 16); }
    float r3; { const float snd = b3 ? r2[0] : r2[1], kp = b3 ? r2[1] : r2[0]; r3 = kp + __shfl_xor(snd, 8); }
    r3 += __shfl_xor(r3, 4); r3 += __shfl_xor(r3, 2); r3 += __shfl_xor(r3, 1);
    r3 *= (1.0f / 2048.0f);
    const float g = __shfl(gatev, e0 + (lane >> 3));
    const float wv = g * (0.5f / 128.0f) * r3 * (1.0f + erff(r3 * 0.70710678118654752f));
#pragma unroll
    for (int j = 0; j < 8; ++j) { const float w = __int_as_float(__builtin_amdgcn_readlane(__float_as_int(wv), 8 * j)); const unsigned vw[4] = {vq[j].x, vq[j].y, vq[j].z, vq[j].w};
#pragma unroll
        for (int q = 0; q < 4; ++q) { const f32x2 lo = __builtin_amdgcn_cvt_pk_f32_fp8((int)vw[q], false), hi = __builtin_amdgcn_cvt_pk_f32_fp8((int)vw[q], true);
            y[4 * q] += w * lo[0]; y[4 * q + 1] += w * lo[1]; y[4 * q + 2] += w * hi[0]; y[4 * q + 3] += w * hi[1]; } }
}
#else
__device__ __forceinline__ void peer_group8(const bf16* PUp, const bf16* PVp, Frame& F, const v4u hA, const v4u hB, unsigned idxv, float gatev, int e0, float (&y)[16]) {
    const int lane = F.lane;
    v4u uA[8], uB[8], vA[8], vB[8];
#pragma unroll
    for (int j = 0; j < 8; ++j) { const unsigned e = (unsigned)__builtin_amdgcn_readlane((int)idxv, e0 + j);
        const bf16* up = PUp + (size_t)e * DM + 8 * lane; const bf16* vp = PVp + (size_t)e * DM + 8 * lane;
        uA[j] = *(const v4u*)up; uB[j] = *(const v4u*)(up + 512); vA[j] = *(const v4u*)vp; vB[j] = *(const v4u*)(vp + 512); }
    float p[8];
#pragma unroll
    for (int j = 0; j < 8; ++j) p[j] = dot8(hB, uB[j], dot8(hA, uA[j], 0.f));
    const bool b5 = lane & 32, b4 = lane & 16, b3 = lane & 8;
    float r[4];
#pragma unroll
    for (int i = 0; i < 4; ++i) { const float snd = b5 ? p[i] : p[i + 4], kp = b5 ? p[i + 4] : p[i]; r[i] = kp + __shfl_xor(snd, 32); }
    float r2[2];
#pragma unroll
    for (int i = 0; i < 2; ++i) { const float snd = b4 ? r[i] : r[i + 2], kp = b4 ? r[i + 2] : r[i]; r2[i] = kp + __shfl_xor(snd, 16); }
    float r3; { const float snd = b3 ? r2[0] : r2[1], kp = b3 ? r2[1] : r2[0]; r3 = kp + __shfl_xor(snd, 8); }
    r3 += __shfl_xor(r3, 4); r3 += __shfl_xor(r3, 2); r3 += __shfl_xor(r3, 1);
    const float g = __shfl(gatev, e0 + (lane >> 3));
    const float wv = g * 0.5f * r3 * (1.0f + erff(r3 * 0.70710678118654752f));
#pragma unroll
    for (int j = 0; j < 8; ++j) { const float w = __int_as_float(__builtin_amdgcn_readlane(__float_as_int(wv), 8 * j)); axpy8(y, 0, w, vA[j]); axpy8(y, 8, w, vB[j]); }
}
#endif
__device__ __forceinline__ void phase_peer_expert(const Args& A0, Frame& F0, int l) {
    LAUNDER();
    const int lane = opqv(F.lane); const bf16* const PUp = P_PU; const bf16* const PVp = P_PV;
    for (int tok = F.gw; tok < NTOK; tok += F.NGW) {
        const int b = tok >> 11;
        const v4u hA = *(const v4u*)(P_HB + (size_t)tok * DM + 8 * lane), hB = *(const v4u*)(P_HB + (size_t)tok * DM + 512 + 8 * lane);
        const unsigned i0 = P_IDX[(size_t)tok * 128 + lane], i1 = P_IDX[(size_t)tok * 128 + 64 + lane];
        const float g0 = P_GATE[(size_t)tok * 128 + lane], g1 = P_GATE[(size_t)tok * 128 + 64 + lane];
        float y[16];
#pragma unroll
        for (int i = 0; i < 16; ++i) y[i] = 0.f;
        for (int rep = 0; rep < ((PROBE_MASK & 64) ? 2 : 1); ++rep) {
#if PEER_FP8
        float hf[16]; { const unsigned hw[8] = {hA.x, hA.y, hA.z, hA.w, hB.x, hB.y, hB.z, hB.w};
#pragma unroll
          for (int i = 0; i < 8; ++i) { hf[2 * i] = bflo(hw[i]); hf[2 * i + 1] = bfhi(hw[i]); } }
        for (int grp = 0; grp < 8; ++grp) peer_group8(PUp, PVp, F, hf, i0, g0, grp * 8, y);
        for (int grp = 0; grp < 8; ++grp) peer_group8(PUp, PVp, F, hf, i1, g1, grp * 8, y);
#else
        for (int grp = 0; grp < 8; ++grp) peer_group8(PUp, PVp, F, hA, hB, i0, g0, grp * 8, y);
        for (int grp = 0; grp < 8; ++grp) peer_group8(PUp, PVp, F, hA, hB, i1, g1, grp * 8, y);
#endif
        }
        if (PROBE_MASK & 64) {
#pragma unroll
            for (int i = 0; i < 16; ++i) y[i] *= 0.5f; }
        const float* mod = P_MOD + ((size_t)l * 32 + b) * MODW;
        const Row16 xr = ld_row(P_X + (size_t)tok * DM, lane), gt = ld_row(mod + 5120, lane);
        Row16 v;
        v.a0 = xr.a0 * DN_ALPHA + (f32x4){y[0], y[1], y[2], y[3]} * gt.a0; v.a1 = xr.a1 * DN_ALPHA + (f32x4){y[4], y[5], y[6], y[7]} * gt.a1;
        v.b0 = xr.b0 * DN_ALPHA + (f32x4){y[8], y[9], y[10], y[11]} * gt.b0; v.b1 = xr.b1 * DN_ALPHA + (f32x4){y[12], y[13], y[14], y[15]} * gt.b1;
        const Row16 xn = layer_norm_row(v, IN_ln_g + (size_t)(l * 2 + 1) * DM, IN_ln_b + (size_t)(l * 2 + 1) * DM, lane);
        st_row(P_X + (size_t)tok * DM, lane, xn);
        if (l + 1 < DEPTH) { const float* mod2 = P_MOD + ((size_t)(l + 1) * 32 + b) * MODW; const Row16 sh = ld_row(mod2, lane), sc = ld_row(mod2 + 1024, lane);
            st_row_bf16(P_HB + (size_t)tok * DM, lane, modulate(xn, sc, sh)); }
    }
}

typedef short bf16x8 __attribute__((ext_vector_type(8)));
typedef float f32x16 __attribute__((ext_vector_type(16)));
typedef float f32x2_t __attribute__((ext_vector_type(2)));
typedef unsigned u32x2v __attribute__((ext_vector_type(2)));
#define MFMA32(a, b, c) __builtin_amdgcn_mfma_f32_32x32x16_bf16((a), (b), (c), 0, 0, 0)
__device__ __forceinline__ unsigned cvtpk(float lo, float hi) { f32x2_t v = {lo, hi}; bf16x2_t b = __builtin_convertvector(v, bf16x2_t); return __builtin_bit_cast(unsigned, b); }
__device__ __forceinline__ bf16x8 ld_frag(const bf16* p) { return __builtin_bit_cast(bf16x8, *(const v4u*)p); }
__device__ __forceinline__ bf16x8 ld_frag2(const bf16* p0, const bf16* p1) { const v2u a = *(const v2u*)p0, b = *(const v2u*)p1; v4u w; w.x = a.x; w.y = a.y; w.z = b.x; w.w = b.y; return __builtin_bit_cast(bf16x8, w); }

template <bool MASK>
__device__ __forceinline__ void sb_tile(const bf16* Kp, const bf16* Vp, const bf16x8 (&qf)[4], const bf16x8 (&kf)[4], const bf16x8 (&vf)[2][2], bf16x8 (&kn)[4], bf16x8 (&vn)[2][2], f32x16 (&oacc)[2], float& R, int s0, int s0n, int t, int lane, int h) {
#pragma unroll
    for (int kk = 0; kk < 4; ++kk) kn[kk] = ld_frag(Kp + ((size_t)((s0n >> 5) * 4 + kk) * 64 + lane) * 8);
#pragma unroll
    for (int db = 0; db < 2; ++db)
#pragma unroll
        for (int s2 = 0; s2 < 2; ++s2) vn[db][s2] = ld_frag(Vp + ((size_t)(((s0n >> 5) * 2 + db) * 2 + s2) * 64 + lane) * 8);
    f32x16 z;
#pragma unroll
    for (int i = 0; i < 16; ++i) z[i] = 0.f;
#pragma unroll
    for (int kk = 0; kk < 4; ++kk) z = MFMA32(kf[kk], qf[kk], z);
    float q[16], bt[16];
#pragma unroll
    for (int i = 0; i < 16; ++i) {
        const float e = __builtin_amdgcn_exp2f(fminf(z[i] * 1.4426950408889634f, 60.0f)), r = __builtin_amdgcn_rcpf(1.0f + e);
        const bool valid = !MASK || (s0 + (i & 3) + 8 * (i >> 2) + 4 * h < t);
        q[i] = valid ? r : 1.0f; bt[i] = valid ? e * r : 0.0f;
    }
    float a[16], G[4], P[4];
#pragma unroll
    for (int g = 0; g < 4; ++g) { a[4 * g + 3] = 1.0f; a[4 * g + 2] = q[4 * g + 3]; a[4 * g + 1] = a[4 * g + 2] * q[4 * g + 2]; a[4 * g] = a[4 * g + 1] * q[4 * g + 1]; G[g] = a[4 * g] * q[4 * g]; }
    { const u32x2v a01 = __builtin_amdgcn_permlane32_swap(__float_as_uint(G[0]), __float_as_uint(G[1]), false, false), b01 = __builtin_amdgcn_permlane32_swap(__float_as_uint(G[1]), __float_as_uint(G[0]), false, false);
      const u32x2v a23 = __builtin_amdgcn_permlane32_swap(__float_as_uint(G[2]), __float_as_uint(G[3]), false, false), b23 = __builtin_amdgcn_permlane32_swap(__float_as_uint(G[3]), __float_as_uint(G[2]), false, false);
      P[0] = __uint_as_float(h ? b01[0] : a01[1]); P[1] = __uint_as_float(h ? a01[0] : b01[1]); P[2] = __uint_as_float(h ? b23[0] : a23[1]); P[3] = __uint_as_float(h ? a23[0] : b23[1]); }
    float off[4]; float run = R;
#pragma unroll
    for (int g = 3; g >= 0; --g) { off[g] = run * (h == 0 ? P[g] : 1.0f); run *= G[g] * P[g]; }
    float w[16];
#pragma unroll
    for (int i = 0; i < 16; ++i) w[i] = bt[i] * (off[i >> 2] * a[i]);
    R = run;
    bf16x8 pf[2];
#pragma unroll
    for (int s2 = 0; s2 < 2; ++s2) { v4u pw; pw.x = cvtpk(w[8 * s2], w[8 * s2 + 1]); pw.y = cvtpk(w[8 * s2 + 2], w[8 * s2 + 3]); pw.z = cvtpk(w[8 * s2 + 4], w[8 * s2 + 5]); pw.w = cvtpk(w[8 * s2 + 6], w[8 * s2 + 7]); pf[s2] = __builtin_bit_cast(bf16x8, pw); }
#pragma unroll
    for (int db = 0; db < 2; ++db)
#pragma unroll
        for (int s2 = 0; s2 < 2; ++s2) oacc[db] = MFMA32(vf[db][s2], pf[s2], oacc[db]);
}
__device__ __forceinline__ void sb_block(const bf16* QBp, const bf16* KBp, const bf16* VTp, bf16* OBp, int bh, int t0, int r, int h) {
    const int t = t0 + r, lane = r + 32 * h;
    const bf16* Kp = KBp + (size_t)bh * SEQ * 64; const bf16* Vp = VTp + (size_t)bh * 64 * SEQ; const bf16* Qp = QBp + (size_t)bh * SEQ * 64;
    bf16x8 qf[4], ka[4], kb[4], va[2][2], vb[2][2];
#pragma unroll
    for (int kk = 0; kk < 4; ++kk) { qf[kk] = ld_frag(Qp + ((size_t)((t0 >> 5) * 4 + kk) * 64 + lane) * 8); ka[kk] = ld_frag(Kp + ((size_t)((t0 >> 5) * 4 + kk) * 64 + lane) * 8); }
#pragma unroll
    for (int db = 0; db < 2; ++db)
#pragma unroll
        for (int s2 = 0; s2 < 2; ++s2) va[db][s2] = ld_frag(Vp + ((size_t)(((t0 >> 5) * 2 + db) * 2 + s2) * 64 + lane) * 8);
    f32x16 oacc[2];
#pragma unroll
    for (int i = 0; i < 16; ++i) { oacc[0][i] = 0.f; oacc[1][i] = 0.f; }
    float R = 1.0f;
    sb_tile<true>(Kp, Vp, qf, ka, va, kb, vb, oacc, R, t0, t0 >= 32 ? t0 - 32 : 0, t, lane, h);
    for (int s0 = t0 - 32; s0 >= 0; s0 -= 64) {
        if (__all(R < 5.421010862427522e-20f)) break;
        sb_tile<false>(Kp, Vp, qf, kb, vb, ka, va, oacc, R, s0, s0 >= 32 ? s0 - 32 : 0, t, lane, h);
        if (s0 < 32 || __all(R < 5.421010862427522e-20f)) break;
        sb_tile<false>(Kp, Vp, qf, ka, va, kb, vb, oacc, R, s0 - 32, s0 >= 64 ? s0 - 64 : 0, t, lane, h);
    }
    bf16* op = OBp + ((size_t)((bh >> 3) * SEQ + t)) * 512 + (bh & 7) * 64 + 4 * h;
#pragma unroll
    for (int db = 0; db < 2; ++db)
#pragma unroll
        for (int g = 0; g < 4; ++g) { v2u o; o.x = cvtpk(oacc[db][4 * g], oacc[db][4 * g + 1]); o.y = cvtpk(oacc[db][4 * g + 2], oacc[db][4 * g + 3]); *(v2u*)(op + 32 * db + 8 * g) = o; }
}
__device__ __forceinline__ void attn_fast(const Args& A0, Frame& F0, int l) {
    LAUNDER();
    const int lane = F.lane, r = lane & 31, h = lane >> 5;
    const bf16* QBp = P_QB; const bf16* KBp = P_KB; const bf16* VTp = P_VT; bf16* OBp = P_OB;
    unsigned* qhead = (unsigned*)(A.ws + WS_CTL) + CW_QUEUE + 1024 * l;
    int shard = (int)blockIdx.x & 7, tried = 0;
    unsigned tkv = 0; if (lane == 0) tkv = __hip_atomic_fetch_add(qhead + 64 * shard, 1u, RLX_AGENT);
    unsigned tk = (unsigned)__builtin_amdgcn_readfirstlane((int)tkv);
    while (tried < 8) {
        if (tk >= 1024u) { shard = (shard + 1) & 7; ++tried; tkv = 0; if (lane == 0) tkv = __hip_atomic_fetch_add(qhead + 64 * shard, 1u, RLX_AGENT); tk = (unsigned)__builtin_amdgcn_readfirstlane((int)tkv); continue; }
        const int unit = shard * 1024 + (int)tk;
        tkv = 0; if (lane == 0) tkv = __hip_atomic_fetch_add(qhead + 64 * shard, 1u, RLX_AGENT);
        const int bh = unit >> 5, tb = (unit & 31) * 64;
        sb_block(QBp, KBp, VTp, OBp, bh, tb + 32, r, h);
        sb_block(QBp, KBp, VTp, OBp, bh, tb, r, h);
        tk = (unsigned)__builtin_amdgcn_readfirstlane((int)tkv);
    }
}

__device__ __forceinline__ void ce_desc(unsigned& x, unsigned& y) { const float fx = __uint_as_float(x), fy = __uint_as_float(y); x = __float_as_uint(fmaxf(fx, fy)); y = __float_as_uint(fminf(fx, fy)); }
__device__ __forceinline__ void sort16_desc(unsigned (&a)[16]) {
    ce_desc(a[0], a[13]); ce_desc(a[1], a[12]); ce_desc(a[2], a[15]); ce_desc(a[3], a[14]); ce_desc(a[4], a[8]); ce_desc(a[5], a[6]); ce_desc(a[7], a[11]); ce_desc(a[9], a[10]);
    ce_desc(a[0], a[5]); ce_desc(a[1], a[7]); ce_desc(a[2], a[9]); ce_desc(a[3], a[4]); ce_desc(a[6], a[13]); ce_desc(a[8], a[14]); ce_desc(a[10], a[15]); ce_desc(a[11], a[12]);
    ce_desc(a[0], a[1]); ce_desc(a[2], a[3]); ce_desc(a[4], a[5]); ce_desc(a[6], a[8]); ce_desc(a[7], a[9]); ce_desc(a[10], a[11]); ce_desc(a[12], a[13]); ce_desc(a[14], a[15]);
    ce_desc(a[0], a[2]); ce_desc(a[1], a[3]); ce_desc(a[4], a[10]); ce_desc(a[5], a[11]); ce_desc(a[6], a[7]); ce_desc(a[8], a[9]); ce_desc(a[12], a[14]); ce_desc(a[13], a[15]);
    ce_desc(a[1], a[2]); ce_desc(a[3], a[12]); ce_desc(a[4], a[6]); ce_desc(a[5], a[7]); ce_desc(a[8], a[10]); ce_desc(a[9], a[11]); ce_desc(a[13], a[14]);
    ce_desc(a[1], a[4]); ce_desc(a[2], a[6]); ce_desc(a[5], a[8]); ce_desc(a[7], a[10]); ce_desc(a[9], a[13]); ce_desc(a[11], a[14]);
    ce_desc(a[2], a[4]); ce_desc(a[3], a[6]); ce_desc(a[9], a[12]); ce_desc(a[11], a[13]);
    ce_desc(a[3], a[5]); ce_desc(a[6], a[8]); ce_desc(a[7], a[9]); ce_desc(a[10], a[12]);
    ce_desc(a[3], a[4]); ce_desc(a[5], a[6]); ce_desc(a[7], a[8]); ce_desc(a[9], a[10]); ce_desc(a[11], a[12]);
    ce_desc(a[6], a[7]); ce_desc(a[8], a[9]);
}
__device__ __forceinline__ void merge_top16(unsigned (&a)[16], const unsigned (&b)[16]) {
#pragma unroll
    for (int i = 0; i < 16; ++i) a[i] = __float_as_uint(fmaxf(__uint_as_float(a[i]), __uint_as_float(b[15 - i])));
#pragma unroll
    for (int j = 8; j > 0; j >>= 1)
#pragma unroll
        for (int i = 0; i < 16; ++i) { const int l = i ^ j; if (l > i) ce_desc(a[i], a[l]); }
}
__device__ __forceinline__ void topk_scores(const bf16* keyp, const bf16* qp, int lane, int hh, unsigned (&top)[16]) {
    bf16x8 qf[4], kf[4][4];
#pragma unroll
    for (int kk = 0; kk < 4; ++kk) qf[kk] = ld_frag(qp + ((size_t)kk * 64 + lane) * 8);
#pragma unroll
    for (int nb = 0; nb < 4; ++nb)
#pragma unroll
        for (int kk = 0; kk < 4; ++kk) kf[nb][kk] = ld_frag(keyp + ((size_t)(nb * 4 + kk) * 64 + lane) * 8);
#pragma unroll
    for (int nb = 0; nb < 4; ++nb) {
        f32x16 s;
#pragma unroll
        for (int i = 0; i < 16; ++i) s[i] = 0.f;
#pragma unroll
        for (int kk = 0; kk < 4; ++kk) s = MFMA32(kf[nb][kk], qf[kk], s);
        unsigned u[16];
#pragma unroll
        for (int i = 0; i < 16; ++i) u[i] = (__float_as_uint(s[i]) & ~127u) | (unsigned)(127 - (32 * nb + (i & 3) + 8 * (i >> 2) + 4 * hh));
        sort16_desc(u);
        if (nb == 0) {
#pragma unroll
            for (int i = 0; i < 16; ++i) top[i] = u[i];
        } else merge_top16(top, u);
    }
}
__device__ __forceinline__ void peer_topk_fast(const Args& A0, Frame& F0, int l) {
    LAUNDER();
    const int lane = F.lane, r = lane & 31, hh = lane >> 5;
    LAS unsigned char* nscr = (LAS unsigned char*)F.lds + (F.wave * 64 + lane) * 32;
    for (int item = F.gw; item < NTOK / 32; item += F.NGW) {
        const int tok = item * 32 + r;
        for (int pair = 0; pair < 4; ++pair) {
            unsigned mine[2][16];
#pragma unroll
            for (int p = 0; p < 2; ++p) {
                unsigned ta[16], tb[16];
                topk_scores(P_SK + ((size_t)((l * 2 + p) * 8 + 2 * pair)) * 128 * 64, P_PQ + ((size_t)((item * 8 + 2 * pair) * 2 + p)) * 2048, lane, hh, ta);
                topk_scores(P_SK + ((size_t)((l * 2 + p) * 8 + 2 * pair + 1)) * 128 * 64, P_PQ + ((size_t)((item * 8 + 2 * pair + 1) * 2 + p)) * 2048, lane, hh, tb);
                unsigned other[16];
#pragma unroll
                for (int i = 0; i < 16; ++i) { const u32x2v sw = __builtin_amdgcn_permlane32_swap(ta[i], tb[i], false, false);
                    mine[p][i] = hh ? sw[1] : sw[0]; other[i] = hh ? sw[0] : sw[1]; }
                merge_top16(mine[p], other);
            }
            const int head = 2 * pair + hh;
            float v1[16], v2[16];
#pragma unroll
            for (int i = 0; i < 16; ++i) { v1[i] = __uint_as_float(mine[0][i] & ~127u); v2[i] = __uint_as_float(mine[1][i] & ~127u); nscr[i] = (unsigned char)(127u - (mine[0][i] & 127u)); nscr[16 + i] = (unsigned char)(127u - (mine[1][i] & 127u)); }
#define CKEY(i, j) ((__float_as_uint(v1[i] + v2[j]) & ~255u) | (unsigned)(255 - ((i) * 16 + (j))))
            unsigned ct[16], gb[16], gc[16], gd[16];
#pragma unroll
            for (int j = 0; j < 16; ++j) ct[j] = CKEY(0, j);
            { int n = 0;
#pragma unroll
              for (int i = 1; i <= 2; ++i)
#pragma unroll
                  for (int j = 0; j < 16; ++j) if ((i + 1) * (j + 1) <= 16) { gb[n] = CKEY(i, j); ++n; }
#pragma unroll
              for (int q = 13; q < 16; ++q) gb[q] = 0xff800000u; }
            { int n = 0;
#pragma unroll
              for (int i = 3; i <= 7; ++i)
#pragma unroll
                  for (int j = 0; j < 16; ++j) if ((i + 1) * (j + 1) <= 16) { gc[n] = CKEY(i, j); ++n; }
#pragma unroll
              for (int q = 13; q < 16; ++q) gc[q] = 0xff800000u; }
#pragma unroll
            for (int i = 8; i < 16; ++i) gd[i - 8] = CKEY(i, 0);
#pragma unroll
            for (int q = 8; q < 16; ++q) gd[q] = 0xff800000u;
#undef CKEY
            sort16_desc(gb); sort16_desc(gc); sort16_desc(gd);
            merge_top16(ct, gb); merge_top16(gc, gd); merge_top16(ct, gc);
            LDS_WAIT(); asm volatile("" ::: "memory");
            float ev[16], es = 0.f; const float vmax = __uint_as_float(ct[0] & ~255u);
#pragma unroll
            for (int k = 0; k < 16; ++k) { ev[k] = __expf(__uint_as_float(ct[k] & ~255u) - vmax); es += ev[k]; }
            const float inv = __builtin_amdgcn_rcpf(es);
            unsigned idx[16];
#pragma unroll
            for (int k = 0; k < 16; ++k) { const unsigned code = 255u - (ct[k] & 255u); idx[k] = (unsigned)nscr[code >> 4] * 128u + (unsigned)nscr[16 + (code & 15u)]; }
            bf16* ip = P_IDX + (size_t)tok * 128 + head * 16; float* gp = P_GATE + (size_t)tok * 128 + head * 16;
            v4u iw0, iw1; iw0.x = idx[0] | (idx[1] << 16); iw0.y = idx[2] | (idx[3] << 16); iw0.z = idx[4] | (idx[5] << 16); iw0.w = idx[6] | (idx[7] << 16);
            iw1.x = idx[8] | (idx[9] << 16); iw1.y = idx[10] | (idx[11] << 16); iw1.z = idx[12] | (idx[13] << 16); iw1.w = idx[14] | (idx[15] << 16);
            *(v4u*)ip = iw0; *(v4u*)(ip + 8) = iw1;
#pragma unroll
            for (int k4 = 0; k4 < 4; ++k4) *(f32x4*)(gp + 4 * k4) = (f32x4){ev[4 * k4] * inv, ev[4 * k4 + 1] * inv, ev[4 * k4 + 2] * inv, ev[4 * k4 + 3] * inv};
            LDS_WAIT(); asm volatile("" ::: "memory");
        }
    }
}

__device__ __forceinline__ void hg_bar() { asm volatile("s_waitcnt lgkmcnt(0)" ::: "memory"); __builtin_amdgcn_s_barrier(); asm volatile("" ::: "memory"); }
#define MFMA16(a, b, c) __builtin_amdgcn_mfma_f32_16x16x32_bf16((a), (b), (c), 0, 0, 0)
__device__ __forceinline__ void hgrn_fast(const Args& A0, Frame& F0, int l) {
    LAUNDER();
    constexpr int QM_OFF = 0, KM_OFF = 8704, QI_OFF = 17408, KET_OFF = 26112, VT_OFF = 36352, AL_OFF = 46592, EBC_OFF = 49152, TOT_OFF = 49664, ST_OFF = 51712, OL_OFF = ST_OFF + 8 * 4352;
    static_assert(OL_OFF + 32 * 132 * 4 <= RING_BYTES, "hgrn LDS");
    const int tid = F.tid, lane = F.lane, w = F.wave, fr = lane & 15, fq = lane >> 4;
    const int d = tid & 127, tq = tid >> 7, et = tid >> 4, eg = (tid & 15) * 8;
    LAS unsigned char* L = F.lds;
    LAS float* TOT = (LAS float*)(L + TOT_OFF); LAS float* EBC = (LAS float*)(L + EBC_OFF); LAS float* OL = (LAS float*)(L + OL_OFF);
    for (int unit = blockIdx.x; unit < 128; unit += F.G) {
        const int b = unit >> 2, h = unit & 3;
        const size_t ebase = ((size_t)b * SEQ + 8 * tq) * 512 + h * 128 + d;
        const size_t obase = ((size_t)b * SEQ + et) * 512 + h * 128 + eg;
        const f32x4 gn0 = *(const f32x4*)(IN_hg_norm_g + l * 512 + h * 128 + eg), gn1 = *(const f32x4*)(IN_hg_norm_g + l * 512 + h * 128 + eg + 4);
        f32x4 S[8];
#pragma unroll
        for (int i = 0; i < 8; ++i) S[i] = (f32x4){0.f, 0.f, 0.f, 0.f};
        unsigned rgA[8], rqA[8], rvA[8], rgB[8], rqB[8], rvB[8];
#define HG_LOAD(c, rg, rq, rv) do { const size_t o_ = ebase + (size_t)(c) * 32 * 512; _Pragma("unroll") for (int i = 0; i < 8; ++i) { rg[i] = P_GLOG[o_ + i * 512]; rq[i] = P_QA[o_ + i * 512]; rv[i] = P_IA[o_ + i * 512]; } } while (0)
        float cs[8];
#define HG_PIN(r) do { _Pragma("unroll") for (int i = 0; i < 8; ++i) asm volatile("" : "+v"(r[i])); } while (0)
#define HG_TOT(rg) do { HG_PIN(rg); float run_ = 0.f; _Pragma("unroll") for (int i = 0; i < 8; ++i) { run_ += bf2f(rg[i]); cs[i] = run_; } TOT[tq * 128 + d] = run_; } while (0)
#define HG_STAGE(rg, rq, rv) do { HG_PIN(rq); HG_PIN(rv); const float t0_ = TOT[d], t1_ = TOT[128 + d], t2_ = TOT[256 + d], t3_ = TOT[384 + d]; \
            const float offs_ = (tq > 0 ? t0_ : 0.f) + (tq > 1 ? t1_ : 0.f) + (tq > 2 ? t2_ : 0.f), bmid_ = t0_ + t1_, bC_ = (t0_ + t1_) + (t2_ + t3_); \
            unsigned ke_[8], vv_[8]; const float emid_ = __expf(bmid_), ecm_ = __expf(bC_ - bmid_);     \
            _Pragma("unroll") for (int i = 0; i < 8; ++i) { const float bt_ = offs_ + cs[i], q_ = bf2f(rq[i]), k_ = 1.0f - __expf(bf2f(rg[i])); const int t_     = 8 * tq + i; \
                const float qmf_ = q_ * __expf(fminf(bt_ - bmid_, 80.f)), kmf_ = k_ * __expf(fminf(bmid_ - bt_, 80.f)); \
                const unsigned qm_ = cvtpk(qmf_, 0.f), km_ = cvtpk(kmf_, 0.f), qi_ = cvtpk(qmf_ * emid_, 0.f); ke_[i] = cvtpk(kmf_ * ecm_, 0.f); vv_[i] = rv[i]; \
                *(LAS unsigned short*)(L + QM_OFF + t_ * 272 + d * 2) = (unsigned short)qm_; *(LAS unsigned short*)(L + KM_OFF + t_ * 272 + d * 2) = (unsigned short)km_; *(LAS unsigned short*)(L + QI_OFF + t_ * 272 + d * 2) = (unsigned short)qi_; } \
            v4u kw_, vw_; kw_.x = (ke_[0] & 0xffffu) | (ke_[1] << 16); kw_.y = (ke_[2] & 0xffffu) | (ke_[3] << 16); kw_.z = (ke_[4] & 0xffffu) | (ke_[5] << 16); kw_.w = (ke_[6] & 0xffffu) | (ke_[7] << 16); \
            vw_.x = vv_[0] | (vv_[1] << 16); vw_.y = vv_[2] | (vv_[3] << 16); vw_.z = vv_[4] | (vv_[5] << 16); vw_.w = vv_[6] | (vv_[7] << 16); \
            *(LAS v4u*)(L + KET_OFF + d * 80 + tq * 16) = kw_; *(LAS v4u*)(L + VT_OFF + d * 80 + tq * 16) = vw_; \
            if (tq == 0) EBC[d] = __expf(bC_); } while (0)
        HG_LOAD(0, rgA, rqA, rvA); HG_TOT(rgA); hg_bar(); HG_STAGE(rgA, rqA, rvA); hg_bar();
        HG_LOAD(1, rgB, rqB, rvB);
        auto body = [&](const int c, unsigned (&cg)[8], unsigned (&cq)[8], unsigned (&cv)[8], unsigned (&lg)[8], unsigned (&lq)[8], unsigned (&lv)[8]) __attribute__((always_inline)) {
            const bool more = c + 1 < SEQ / 32;
            const v4u rga = *(const v4u*)(P_GA + obase + (size_t)c * 32 * 512);
            __builtin_amdgcn_sched_barrier(0);
            HG_LOAD((c + 2 < SEQ / 32 ? c + 2 : SEQ / 32 - 1), lg, lq, lv);
            bf16x8 kmf[4], qmf[4]; v4u qif[2][4];
            const int ats = w >> 1, att = w & 1;
            if (w < 4) {
#pragma unroll
                for (int ks = 0; ks < 4; ++ks) { kmf[ks] = *(const LAS bf16x8*)(L + KM_OFF + (16 * ats + fr) * 272 + (32 * ks + 8 * fq) * 2); qmf[ks] = *(const LAS bf16x8*)(L + QM_OFF + (16 * att + fr) * 272 + (32 * ks + 8 * fq) * 2); } }
#pragma unroll
            for (int tt = 0; tt < 2; ++tt)
#pragma unroll
                for (int ks = 0; ks < 4; ++ks) { const LAS unsigned char* qp = L + QI_OFF + (16 * tt + fr) * 272 + (32 * ks + 4 * fq) * 2; const v2u q0 = *(const LAS v2u*)qp, q1 = *(const LAS v2u*)(qp + 32);
                    qif[tt][ks].x = q0.x; qif[tt][ks].y = q0.y; qif[tt][ks].z = q1.x; qif[tt][ks].w = q1.y; }
            __builtin_amdgcn_sched_barrier(0);
            f32x4 o[2];
            { bf16x8 sf[4];
#pragma unroll
              for (int ks = 0; ks < 4; ++ks) { v4u pw; pw.x = cvtpk(S[2 * ks][0], S[2 * ks][1]); pw.y = cvtpk(S[2 * ks][2], S[2 * ks][3]); pw.z = cvtpk(S[2 * ks + 1][0], S[2 * ks + 1][1]); pw.w = cvtpk(S[2 * ks + 1][2], S[2 * ks + 1][3]); sf[ks] = __builtin_bit_cast(bf16x8, pw); }
#pragma unroll
              for (int tt = 0; tt < 2; ++tt) { o[tt] = (f32x4){0.f, 0.f, 0.f, 0.f};
#pragma unroll
                for (int ks = 0; ks < 4; ++ks) o[tt] = MFMA16(sf[ks], __builtin_bit_cast(bf16x8, qif[tt][ks]), o[tt]); } }
            if (w < 4) { f32x4 at = (f32x4){0.f, 0.f, 0.f, 0.f};
#pragma unroll
                for (int ks = 0; ks < 4; ++ks) at = MFMA16(kmf[ks], qmf[ks], at);
                const int t = 16 * att + fr, s0 = 16 * ats + 4 * fq; v2u aw;
                aw.x = cvtpk(s0 <= t ? at[0] : 0.f, s0 + 1 <= t ? at[1] : 0.f); aw.y = cvtpk(s0 + 2 <= t ? at[2] : 0.f, s0 + 3 <= t ? at[3] : 0.f);
                *(LAS v2u*)(L + AL_OFF + t * 80 + s0 * 2) = aw; }
            hg_bar();
            const bf16x8 vb = *(const LAS bf16x8*)(L + VT_OFF + (16 * w + fr) * 80 + 16 * fq);
            bf16x8 alf[2], kef[8]; f32x4 ebf[8];
#pragma unroll
            for (int tt = 0; tt < 2; ++tt) alf[tt] = *(const LAS bf16x8*)(L + AL_OFF + (16 * tt + fr) * 80 + 16 * fq);
#pragma unroll
            for (int dt = 0; dt < 8; ++dt) { ebf[dt] = *(const LAS f32x4*)(EBC + 16 * dt + 4 * fq); kef[dt] = *(const LAS bf16x8*)(L + KET_OFF + (16 * dt + fr) * 80 + 16 * fq); }
            __builtin_amdgcn_sched_barrier(0);
#pragma unroll
            for (int tt = 0; tt < 2; ++tt) { o[tt] = MFMA16(vb, alf[tt], o[tt]);
                *(LAS f32x4*)(OL + (16 * tt + fr) * 132 + 16 * w + 4 * fq) = o[tt]; }
#pragma unroll
            for (int dt = 0; dt < 8; ++dt) S[dt] = MFMA16(kef[dt], vb, S[dt] * ebf[dt]);
            if (more) HG_TOT(cg);
            hg_bar();
            { const f32x4 o0 = *(const LAS f32x4*)(OL + et * 132 + eg), o1 = *(const LAS f32x4*)(OL + et * 132 + eg + 4);
              float ss = ((o0[0] * o0[0] + o0[1] * o0[1]) + (o0[2] * o0[2] + o0[3] * o0[3])) + ((o1[0] * o1[0] + o1[1] * o1[1]) + (o1[2] * o1[2] + o1[3] * o1[3]));
              ss += dpp_f<0xB1>(ss); ss += dpp_f<0x4E>(ss); ss += dpp_f<0x141>(ss); ss += dpp_f<0x140>(ss);
              const float rstd = __builtin_amdgcn_rsqf(ss * (1.0f / 128.0f) + RMS_EPS);
              const f32x4 r0 = o0 * rstd * gn0 * (f32x4){bflo(rga.x), bfhi(rga.x), bflo(rga.y), bfhi(rga.y)}, r1 = o1 * rstd * gn1 * (f32x4){bflo(rga.z), bfhi(rga.z), bflo(rga.w), bfhi(rga.w)};
              *(v4u*)(P_OA + obase + (size_t)c * 32 * 512) = pk8(r0, r1); }
            if (more) HG_STAGE(cg, cq, cv);
            hg_bar();
        };
        for (int c = 0; c < SEQ / 32; c += 2) { body(c, rgB, rqB, rvB, rgA, rqA, rvA); body(c + 1, rgA, rqA, rvA, rgB, rqB, rvB); }
#undef HG_LOAD
#undef HG_TOT
#undef HG_PIN
#undef HG_STAGE
    }
}

#if PEER_KSLICE
typedef float f32x2v __attribute__((ext_vector_type(2)));
__device__ __forceinline__ f32x2v cvt8lo(unsigned w) { return __builtin_amdgcn_cvt_pk_f32_fp8((int)w, false); }
__device__ __forceinline__ f32x2v cvt8hi(unsigned w) { return __builtin_amdgcn_cvt_pk_f32_fp8((int)w, true); }
template <int CTRL> __device__ __forceinline__ float dppf(float v) { return __int_as_float(__builtin_amdgcn_update_dpp(0, __float_as_int(v), CTRL, 0xF, 0xF, true)); }
__device__ __forceinline__ float swap32_sum(float a, float b) { const u32x2v r = __builtin_amdgcn_permlane32_swap(__float_as_uint(a), __float_as_uint(b), false, false); return __uint_as_float(r[0]) + __uint_as_float(r[1]); }
__device__ __forceinline__ float swap16_sum(float a, float b) { const u32x2v r = __builtin_amdgcn_permlane16_swap(__float_as_uint(a), __float_as_uint(b), false, false); return __uint_as_float(r[0]) + __uint_as_float(r[1]); }
struct SlicePre { v4u ia, ib, x0, x1, x2, x3; };
__device__ __forceinline__ void slice_issue(const unsigned char* base, unsigned lofs, const SlicePre& P, v4u (&q)[16]) {
    const unsigned iw[8] = {P.ia.x, P.ia.y, P.ia.z, P.ia.w, P.ib.x, P.ib.y, P.ib.z, P.ib.w};
#pragma unroll
    for (int i = 0; i < 16; ++i) { const unsigned off = (((i & 1) ? (iw[i >> 1] >> 9) : (iw[i >> 1] << 7)) & 0x7fff80u) | lofs; q[i] = *(const v4u*)(base + off); }
}
__device__ __forceinline__ SlicePre u_pre(const bf16* HBp, const bf16* IDXp, int tok, int xs, int g, int m) {
    SlicePre P; P.ia = *(const v4u*)(IDXp + (size_t)tok * 128 + 16 * g); P.ib = *(const v4u*)(IDXp + (size_t)tok * 128 + 16 * g + 8);
    P.x0 = *(const v4u*)(HBp + (size_t)tok * DM + 128 * xs + 16 * m); P.x1 = *(const v4u*)(HBp + (size_t)tok * DM + 128 * xs + 16 * m + 8); P.x2 = P.x0; P.x3 = P.x0; return P;
}
__device__ __forceinline__ void u_compute(const SlicePre& P, const v4u (&uq)[16], bf16* dst, bool b2, bool b1, bool b0) {
    const unsigned hw[8] = {P.x0.x, P.x0.y, P.x0.z, P.x0.w, P.x1.x, P.x1.y, P.x1.z, P.x1.w};
    f32x2v hf[8];
#pragma unroll
    for (int i = 0; i < 8; ++i) hf[i] = (f32x2v){bflo(hw[i]), bfhi(hw[i])};
    float p[16];
#pragma unroll
    for (int i = 0; i < 16; ++i) { const unsigned uw[4] = {uq[i].x, uq[i].y, uq[i].z, uq[i].w}; f32x2v acc = (f32x2v){0.f, 0.f};
#pragma unroll
        for (int w = 0; w < 4; ++w) { acc += hf[2 * w] * cvt8lo(uw[w]); acc += hf[2 * w + 1] * cvt8hi(uw[w]); }
        if (PROBE_MASK & 16384) { unsigned uw2[4] = {uq[i].x, uq[i].y, uq[i].z, uq[i].w}; asm volatile("" : "+v"(uw2[0]), "+v"(uw2[1]), "+v"(uw2[2]), "+v"(uw2[3]));
#pragma unroll
            for (int w = 0; w < 4; ++w) { acc += hf[2 * w] * cvt8lo(uw2[w]); acc += hf[2 * w + 1] * cvt8hi(uw2[w]); }
            acc *= 0.5f; }
        p[i] = acc[0] + acc[1]; }
    float r[8], r2[4], r3[2];
#pragma unroll
    for (int j = 0; j < 8; ++j) { const float snd = b2 ? p[j] : p[8 + j], kp = b2 ? p[8 + j] : p[j]; r[j] = kp + dppf<0x141>(snd); }
#pragma unroll
    for (int j = 0; j < 4; ++j) { const float snd = b1 ? r[j] : r[4 + j], kp = b1 ? r[4 + j] : r[j]; r2[j] = kp + dppf<0x4E>(snd); }
#pragma unroll
    for (int j = 0; j < 2; ++j) { const float snd = b0 ? r2[j] : r2[2 + j], kp = b0 ? r2[2 + j] : r2[j]; r3[j] = kp + dppf<0xB1>(snd); }
    *(unsigned*)dst = pk2(r3[0], r3[1]);
}
#if U_MFMA
typedef long i64_t;
struct UPre { v4u id, h0, h1; };
__device__ __forceinline__ UPre um_pre(const unsigned char* HB8p, const bf16* IDXp, int tok, int fr) {
    UPre P; P.id = *(const v4u*)(IDXp + (size_t)tok * 128 + 8 * fr); const v4u* hp = (const v4u*)(HB8p + (size_t)tok * DM); P.h0 = hp[0]; P.h1 = hp[1]; return P; }
__device__ __forceinline__ void um_issue(const unsigned char* tab, const UPre& P, v4u (&q)[16]) {
    const unsigned iw[4] = {P.id.x, P.id.y, P.id.z, P.id.w};
#pragma unroll
    for (int T = 0; T < 8; ++T) { const unsigned e = (T & 1) ? (iw[T >> 1] >> 16) : (iw[T >> 1] & 0xffffu); const v4u* rp = (const v4u*)(tab + (size_t)e * 128); q[2 * T] = rp[0]; q[2 * T + 1] = rp[1]; }
}
__device__ __forceinline__ i64_t mk64(unsigned lo, unsigned hi) { return (i64_t)(((unsigned long long)hi << 32) | lo); }
__device__ __forceinline__ void um_compute(const UPre& P, const v4u (&q)[16], bf16* dst, int fr) {
    const i64_t b0 = mk64(P.h0.x, P.h0.y), b1 = mk64(P.h0.z, P.h0.w), b2 = mk64(P.h1.x, P.h1.y), b3 = mk64(P.h1.z, P.h1.w);
    float val[8];
#pragma unroll
    for (int T = 0; T < 8; ++T) { f32x4 acc = (f32x4){0.f, 0.f, 0.f, 0.f};
        acc = __builtin_amdgcn_mfma_f32_16x16x32_fp8_fp8(mk64(q[2 * T].x, q[2 * T].y), b0, acc, 0, 0, 0); acc = __builtin_amdgcn_mfma_f32_16x16x32_fp8_fp8(mk64(q[2 * T].z, q[2 * T].w), b1, acc, 0, 0, 0);
        acc = __builtin_amdgcn_mfma_f32_16x16x32_fp8_fp8(mk64(q[2 * T + 1].x, q[2 * T + 1].y), b2, acc, 0, 0, 0); acc = __builtin_amdgcn_mfma_f32_16x16x32_fp8_fp8(mk64(q[2 * T + 1].z, q[2 * T + 1].w), b3, acc, 0, 0, 0);
        const float v01 = (fr & 1) ? acc[1] : acc[0], v23 = (fr & 1) ? acc[3] : acc[2]; val[T] = (fr & 2) ? v23 : v01; }
    if (fr < 4) { v4u w; w.x = pk2(val[0], val[1]); w.y = pk2(val[2], val[3]); w.z = pk2(val[4], val[5]); w.w = pk2(val[6], val[7]); *(v4u*)dst = w; }
}
__device__ __forceinline__ void peer_slice_u(const Args& A0, Frame& F0) {
    LAUNDER();
    const int lane = F.lane, fr = lane & 15, fq = lane >> 4;
    const int xs = blockIdx.x & 7, nwv = (F.G >> 3) * NWAVES, wv = (blockIdx.x >> 3) * NWAVES + F.wave;
    const unsigned char* tab = (const unsigned char*)P_PU + (size_t)xs * 16384 * 128 + 32 * fq;
    const unsigned char* HB8p = P_HB8 + 128 * xs + 32 * fq; const bf16* IDXp = P_IDX;
    bf16* part = (bf16*)P_PART + (size_t)xs * NTOK * 128 + 8 * (4 * fq + (fr & 3));
    const int n = (NTOK - wv + nwv - 1) / nwv;
#define TOKK(k) (wv + ((k) < n ? (k) : n - 1) * nwv)
    v4u qa[16], qb[16];
    UPre pa = um_pre(HB8p, IDXp, TOKK(0), fr); um_issue(tab, pa, qa);
    UPre pb = um_pre(HB8p, IDXp, TOKK(1), fr);
    for (int k = 0; k < n; k += 2) {
        um_issue(tab, pb, qb);
        const UPre pc = um_pre(HB8p, IDXp, TOKK(k + 2), fr);
        um_compute(pa, qa, part + (size_t)TOKK(k) * 128, fr);
        um_issue(tab, pc, qa);
        const UPre pd = um_pre(HB8p, IDXp, TOKK(k + 3), fr);
        if (k + 1 < n) um_compute(pb, qb, part + (size_t)TOKK(k + 1) * 128, fr);
        pa = pc; pb = pd;
    }
#undef TOKK
}
#else
#if U_INT8
template <int CTRL> __device__ __forceinline__ int dppi(int v) { return __builtin_amdgcn_update_dpp(0, v, CTRL, 0xF, 0xF, true); }
__device__ __forceinline__ SlicePre u_pre8(const unsigned char* HB8p, const float* HSCp, const bf16* IDXp, int tok, int g) {
    SlicePre P; P.ia = *(const v4u*)(IDXp + (size_t)tok * 128 + 16 * g); P.ib = *(const v4u*)(IDXp + (size_t)tok * 128 + 16 * g + 8);
    P.x0 = *(const v4u*)(HB8p + (size_t)tok * DM); P.x1 = (v4u){__float_as_uint(HSCp[tok]), 0u, 0u, 0u}; P.x2 = P.x0; P.x3 = P.x0; return P;
}
__device__ __forceinline__ void u_compute8(const SlicePre& P, const v4u (&uq)[16], bf16* dst, bool b2, bool b1, bool b0) {
    int p[16];
#pragma unroll
    for (int i = 0; i < 16; ++i) p[i] = __builtin_amdgcn_sdot4((int)P.x0.w, (int)uq[i].w, __builtin_amdgcn_sdot4((int)P.x0.z, (int)uq[i].z, __builtin_amdgcn_sdot4((int)P.x0.y, (int)uq[i].y, __builtin_amdgcn_sdot4((int)P.x0.x, (int)uq[i].x, 0, false), false), false), false);
    int r[8], r2[4], r3[2];
#pragma unroll
    for (int j = 0; j < 8; ++j) { const int snd = b2 ? p[j] : p[8 + j], kp = b2 ? p[8 + j] : p[j]; r[j] = kp + dppi<0x141>(snd); }
#pragma unroll
    for (int j = 0; j < 4; ++j) { const int snd = b1 ? r[j] : r[4 + j], kp = b1 ? r[4 + j] : r[j]; r2[j] = kp + dppi<0x4E>(snd); }
#pragma unroll
    for (int j = 0; j < 2; ++j) { const int snd = b0 ? r2[j] : r2[2 + j], kp = b0 ? r2[2 + j] : r2[j]; r3[j] = kp + dppi<0xB1>(snd); }
    const float sc = __uint_as_float(P.x1.x) * (1.0f / 600.0f);
    *(unsigned*)dst = pk2((float)r3[0] * sc, (float)r3[1] * sc);
}
#endif
__device__ __forceinline__ void peer_slice_u(const Args& A0, Frame& F0) {
    LAUNDER();
    const int lane = F.lane, g = lane >> 3, m = lane & 7;
    const int xs = blockIdx.x & 7, nwv = (F.G >> 3) * NWAVES, wv = (blockIdx.x >> 3) * NWAVES + F.wave;
    const unsigned char* tab = (const unsigned char*)P_PU + (size_t)xs * 16384 * 128; const unsigned lofs = 16u * (unsigned)m;
    bf16* part = (bf16*)P_PART + (size_t)xs * NTOK * 128 + 2 * lane;
    const bf16* HBp = P_HB; const bf16* IDXp = P_IDX; const unsigned char* HB8p = P_HB8 + 128 * xs + 16 * m; const float* HSCp = P_HSC; (void)HBp; (void)HB8p; (void)HSCp;
    const bool b2 = m & 4, b1 = m & 2, b0 = m & 1;
    const int n = (NTOK - wv + nwv - 1) / nwv;
#if U_INT8
#define UPRE(t) u_pre8(HB8p, HSCp, IDXp, (t), g)
#define UCOMP(P_, q_, d_) u_compute8(P_, q_, d_, b2, b1, b0)
#else
#define UPRE(t) u_pre(HBp, IDXp, (t), xs, g, m)
#define UCOMP(P_, q_, d_) u_compute(P_, q_, d_, b2, b1, b0)
#endif
#define TOKK(k) (wv + ((k) < n ? (k) : n - 1) * nwv)
    v4u qa[16], qb[16];
    SlicePre pa = UPRE(TOKK(0)); slice_issue(tab, lofs, pa, qa);
    SlicePre pb = UPRE(TOKK(1));
    for (int k = 0; k < n; k += 2) {
        slice_issue(tab, lofs, pb, qb);
        const SlicePre pc = UPRE(TOKK(k + 2));
        UCOMP(pa, qa, part + (size_t)TOKK(k) * 128);
        slice_issue(tab, lofs, pc, qa);
        const SlicePre pd = UPRE(TOKK(k + 3));
        if (k + 1 < n) UCOMP(pb, qb, part + (size_t)TOKK(k + 1) * 128);
        pa = pc; pb = pd;
    }
#undef TOKK
}
#endif
__device__ __forceinline__ void peer_slice_r(const Args& A0, Frame& F0) {
    LAUNDER();
    const int gt = F.vcu * NTHREADS + F.tid, NGT = F.G * NTHREADS;
    for (int i = gt; i < NTOK * 128 / 4; i += NGT) {
        f32x4 s = (f32x4){0.f, 0.f, 0.f, 0.f};
#pragma unroll
        for (int q = 0; q < 8; ++q) { const v2u w = *(const v2u*)((const bf16*)P_PART + (size_t)q * NTOK * 128 + (size_t)i * 4); s = s + (f32x4){bflo(w.x), bfhi(w.x), bflo(w.y), bfhi(w.y)}; }
        const f32x4 gv = *(const f32x4*)(P_GATE + (size_t)i * 4); f32x4 o;
#pragma unroll
        for (int j = 0; j < 4; ++j) { const float pre = s[j] * (U_INT8 ? 1.0f : (U_MFMA ? (1.0f / (2048.0f * 16.0f)) : (1.0f / 2048.0f))); o[j] = gv[j] * (0.5f / 128.0f) * pre * (1.0f + erff(pre * 0.70710678118654752f)); }
        *(f32x4*)(P_GATE + (size_t)i * 4) = o;
    }
}
__device__ __forceinline__ SlicePre v_pre(const float* Wp, const bf16* IDXp, int tok, int g) {
    SlicePre P; P.ia = *(const v4u*)(IDXp + (size_t)tok * 128 + 16 * g); P.ib = *(const v4u*)(IDXp + (size_t)tok * 128 + 16 * g + 8);
    const v4u* w = (const v4u*)(Wp + (size_t)tok * 128 + 16 * g); P.x0 = w[0]; P.x1 = w[1]; P.x2 = w[2]; P.x3 = w[3]; return P;
}
__device__ __forceinline__ void v_compute(const SlicePre& P, const v4u (&vq)[16], bf16* dst, bool b3) {
    const unsigned ww[16] = {P.x0.x, P.x0.y, P.x0.z, P.x0.w, P.x1.x, P.x1.y, P.x1.z, P.x1.w, P.x2.x, P.x2.y, P.x2.z, P.x2.w, P.x3.x, P.x3.y, P.x3.z, P.x3.w};
    f32x2v acc[8];
#pragma unroll
    for (int q = 0; q < 8; ++q) acc[q] = (f32x2v){0.f, 0.f};
#pragma unroll
    for (int i = 0; i < 16; ++i) { const unsigned vw[4] = {vq[i].x, vq[i].y, vq[i].z, vq[i].w}; const float wi = __uint_as_float(ww[i]); const f32x2v w2 = (f32x2v){wi, wi};
#pragma unroll
        for (int w = 0; w < 4; ++w) { acc[2 * w] += w2 * cvt8lo(vw[w]); acc[2 * w + 1] += w2 * cvt8hi(vw[w]); } }
    float a[16], r[8], r2[4], r3[2];
#pragma unroll
    for (int q = 0; q < 8; ++q) { a[2 * q] = acc[q][0]; a[2 * q + 1] = acc[q][1]; }
#pragma unroll
    for (int j = 0; j < 8; ++j) r[j] = swap32_sum(a[j], a[8 + j]);
#pragma unroll
    for (int j = 0; j < 4; ++j) r2[j] = swap16_sum(r[j], r[4 + j]);
#pragma unroll
    for (int j = 0; j < 2; ++j) { const float snd = b3 ? r2[j] : r2[2 + j], kp = b3 ? r2[2 + j] : r2[j]; r3[j] = kp + dppf<0x128>(snd); }
    *(unsigned*)dst = pk2(r3[0], r3[1]);
}
__device__ __forceinline__ void peer_slice_v(const Args& A0, Frame& F0) {
    LAUNDER();
    const int lane = F.lane, g = lane >> 3, m = lane & 7;
    const int xs = blockIdx.x & 7, nwv = (F.G >> 3) * NWAVES, wv = (blockIdx.x >> 3) * NWAVES + F.wave;
    const unsigned char* tab = (const unsigned char*)P_PV + (size_t)xs * 16384 * 128; const unsigned lofs = 16u * (unsigned)m;
    const bool b5 = lane & 32, b4 = lane & 16, b3 = lane & 8;
    bf16* yp = P_Y + 128 * xs + 16 * m + (b5 ? 8 : 0) + (b4 ? 4 : 0) + (b3 ? 2 : 0);
    const float* Wp = P_GATE; const bf16* IDXp = P_IDX;
    const int n = (NTOK - wv + nwv - 1) / nwv;
#define TOKK(k) (wv + ((k) < n ? (k) : n - 1) * nwv)
    v4u qa[16], qb[16];
    SlicePre pa = v_pre(Wp, IDXp, TOKK(0), g); slice_issue(tab, lofs, pa, qa);
    SlicePre pb = v_pre(Wp, IDXp, TOKK(1), g);
    for (int k = 0; k < n; k += 2) {
        slice_issue(tab, lofs, pb, qb);
        const SlicePre pc = v_pre(Wp, IDXp, TOKK(k + 2), g);
        v_compute(pa, qa, yp + (size_t)TOKK(k) * DM, b3);
        slice_issue(tab, lofs, pc, qa);
        const SlicePre pd = v_pre(Wp, IDXp, TOKK(k + 3), g);
        if (k + 1 < n) v_compute(pb, qb, yp + (size_t)TOKK(k + 1) * DM, b3);
        pa = pc; pb = pd;
    }
#undef TOKK
}
#if PEER_Q4
struct Ids { v4u a, b; };
__device__ __forceinline__ Ids ld_ids(const bf16* IDXp, int tok, int g) { Ids I; I.a = *(const v4u*)(IDXp + (size_t)tok * 128 + 16 * g); I.b = *(const v4u*)(IDXp + (size_t)tok * 128 + 16 * g + 8); return I; }
__device__ __forceinline__ void ids_issue(const unsigned char* base, unsigned lofs, const Ids& I, v4u (&q)[16]) {
    const unsigned iw[8] = {I.a.x, I.a.y, I.a.z, I.a.w, I.b.x, I.b.y, I.b.z, I.b.w};
#pragma unroll
    for (int i = 0; i < 16; ++i) { const unsigned off = (((i & 1) ? (iw[i >> 1] >> 9) : (iw[i >> 1] << 7)) & 0x7fff80u) | lofs; q[i] = *(const v4u*)(base + off); }
}
struct UX { v4u a, b; float sc; };
__device__ __forceinline__ UX ld_ux(const unsigned char* H4p, const float* HSCp, int tok) { UX X; X.a = *(const v4u*)(H4p + (size_t)tok * DM); X.b = *(const v4u*)(H4p + (size_t)tok * DM + 16); X.sc = HSCp[tok]; return X; }
__device__ __forceinline__ int dot8x4(const v4u& h, const v4u& u) { return __builtin_amdgcn_sdot8((int)h.w, (int)u.w, __builtin_amdgcn_sdot8((int)h.z, (int)u.z, __builtin_amdgcn_sdot8((int)h.y, (int)u.y, __builtin_amdgcn_sdot8((int)h.x, (int)u.x, 0, false), false), false), false); }
__device__ __forceinline__ void u4_compute(const UX& X, const v4u (&uq)[16], bf16* dst, bool b2, bool b1, bool b0) {
    int p[16];
#pragma unroll
    for (int i = 0; i < 16; ++i) { p[i] = (dot8x4(X.a, uq[i]) << 4) + dot8x4(X.b, uq[i]);
        if (PROBE_MASK & 16384) { v4u u2 = uq[i]; asm volatile("" : "+v"(u2.x), "+v"(u2.y), "+v"(u2.z), "+v"(u2.w)); p[i] = (p[i] + (dot8x4(X.a, u2) << 4) + dot8x4(X.b, u2)) >> 1; } }
    int r[8], r2[4], r3[2];
#pragma unroll
    for (int j = 0; j < 8; ++j) { const int snd = b2 ? p[j] : p[8 + j], kp = b2 ? p[8 + j] : p[j]; r[j] = kp + dppi<0x141>(snd); }
#pragma unroll
    for (int j = 0; j < 4; ++j) { const int snd = b1 ? r[j] : r[4 + j], kp = b1 ? r[4 + j] : r[j]; r2[j] = kp + dppi<0x4E>(snd); }
#pragma unroll
    for (int j = 0; j < 2; ++j) { const int snd = b0 ? r2[j] : r2[2 + j], kp = b0 ? r2[2 + j] : r2[j]; r3[j] = kp + dppi<0xB1>(snd); }
    *(unsigned*)dst = pk2((float)r3[0] * X.sc, (float)r3[1] * X.sc);
}
__device__ __forceinline__ void peer4_u(const Args& A0, Frame& F0) {
    LAUNDER();
    const int lane = F.lane, g = lane >> 3, m = lane & 7;
    const int xs = blockIdx.x & 3, nwv = (F.G >> 2) * NWAVES, wv = (blockIdx.x >> 2) * NWAVES + F.wave;
    const unsigned char* tab = (const unsigned char*)P_PU + (size_t)xs * 16384 * 128; const unsigned lofs = 16u * (unsigned)m;
    bf16* part = (bf16*)P_PART + (size_t)xs * NTOK * 128 + 2 * lane;
    const bf16* IDXp = P_IDX; const unsigned char* H4p = P_HB8 + 256 * xs + 32 * m; const float* HSCp = P_HSC;
    const bool b2 = m & 4, b1 = m & 2, b0 = m & 1;
    const int n = (NTOK - wv + nwv - 1) / nwv;
#define TOKK(k) (wv + ((k) < n ? (k) : n - 1) * nwv)
    v4u qa[16], qb[16];
    Ids i1 = ld_ids(IDXp, TOKK(1), g), i2 = ld_ids(IDXp, TOKK(2), g);
    __builtin_amdgcn_sched_barrier(0);
    { const Ids i0 = ld_ids(IDXp, TOKK(0), g); ids_issue(tab, lofs, i0, qa); }
    UX x0 = ld_ux(H4p, HSCp, TOKK(0)), x1 = x0;
    for (int k = 0; k < n; k += 2) {
        ids_issue(tab, lofs, i1, qb); x1 = ld_ux(H4p, HSCp, TOKK(k + 1));
        i1 = ld_ids(IDXp, TOKK(k + 3), g);
        __builtin_amdgcn_sched_barrier(0);
        u4_compute(x0, qa, part + (size_t)TOKK(k) * 128, b2, b1, b0);
        __builtin_amdgcn_sched_barrier(0);
        ids_issue(tab, lofs, i2, qa); x0 = ld_ux(H4p, HSCp, TOKK(k + 2));
        i2 = ld_ids(IDXp, TOKK(k + 4), g);
        __builtin_amdgcn_sched_barrier(0);
        u4_compute(x1, qb, part + (size_t)TOKK(k + 1) * 128, b2, b1, b0);
        __builtin_amdgcn_sched_barrier(0);
    }
#undef TOKK
}
typedef _Float16 h16x2 __attribute__((ext_vector_type(2)));
__device__ __forceinline__ unsigned pkh2(float a, float b) { const h16x2 p = {(_Float16)a, (_Float16)b}; return __builtin_bit_cast(unsigned, p); }
__device__ __forceinline__ void peer4_r(const Args& A0, Frame& F0) {
    LAUNDER();
    const int gt = F.vcu * NTHREADS + F.tid, NGT = F.G * NTHREADS;
    constexpr int NI = NTOK * 128 / 8;
    struct RIn { v4u iw, p[4]; f32x4 g0, g1; };
    auto ldin = [&](int i) __attribute__((always_inline)) { RIn r; r.iw = *(const v4u*)(P_IDX + (size_t)i * 8);
#pragma unroll
        for (int q = 0; q < 4; ++q) r.p[q] = *(const v4u*)((const bf16*)P_PART + (size_t)q * NTOK * 128 + (size_t)i * 8);
        r.g0 = *(const f32x4*)(P_GATE + (size_t)i * 8); r.g1 = *(const f32x4*)(P_GATE + (size_t)i * 8 + 4); return r; };
    auto eval = [&](const RIn& r, int i) __attribute__((always_inline)) {
        const unsigned e[8] = {r.iw.x & 0xffffu, r.iw.x >> 16, r.iw.y & 0xffffu, r.iw.y >> 16, r.iw.z & 0xffffu, r.iw.z >> 16, r.iw.w & 0xffffu, r.iw.w >> 16};
        f32x2 sc[8];
#pragma unroll
        for (int j = 0; j < 8; ++j) sc[j] = *(const f32x2*)(P_SC + (size_t)e[j] * 2);
        float s[8];
#pragma unroll
        for (int j = 0; j < 8; ++j) s[j] = 0.f;
#pragma unroll
        for (int q = 0; q < 4; ++q) { const v4u w = r.p[q];
            s[0] += bflo(w.x); s[1] += bfhi(w.x); s[2] += bflo(w.y); s[3] += bfhi(w.y); s[4] += bflo(w.z); s[5] += bfhi(w.z); s[6] += bflo(w.w); s[7] += bfhi(w.w); }
        float o[8];
#pragma unroll
        for (int j = 0; j < 8; ++j) { const float pre = s[j] * sc[j][0], gv = j < 4 ? r.g0[j] : r.g1[j - 4]; o[j] = gv * sc[j][1] * 0.5f * pre * (1.0f + erff(pre * 0.70710678118654752f)); }
        v4u ow; ow.x = pkh2(o[0], o[1]); ow.y = pkh2(o[2], o[3]); ow.z = pkh2(o[4], o[5]); ow.w = pkh2(o[6], o[7]); *(v4u*)(P_W16 + (size_t)i * 8) = ow; };
#define CLI(i_) ((i_) < NI ? (i_) : NI - 1)
    RIn ra = ldin(CLI(gt));
    for (int i = gt; i < NI; i += 2 * NGT) {
        RIn rb = ldin(CLI(i + NGT));
        __builtin_amdgcn_sched_barrier(0);
        eval(ra, i);
        __builtin_amdgcn_sched_barrier(0);
        ra = ldin(CLI(i + 2 * NGT));
        __builtin_amdgcn_sched_barrier(0);
        eval(rb, CLI(i + NGT));
        __builtin_amdgcn_sched_barrier(0);
    }
#undef CLI
}
struct VX { v4u a, b; };
__device__ __forceinline__ VX ld_vx(const bf16* Wp, int tok, int g) { VX X; const v4u* w = (const v4u*)(Wp + (size_t)tok * 128 + 16 * g); X.a = w[0]; X.b = w[1]; return X; }
template <int K> __device__ __forceinline__ h16x2 cvt4h(unsigned w) { return __builtin_amdgcn_cvt_scalef32_pk_f16_fp4(w, 1.0f, K); }
__device__ __forceinline__ unsigned swap32_sumh(unsigned a, unsigned b) { const u32x2v r = __builtin_amdgcn_permlane32_swap(a, b, false, false); unsigned x = r[0], y = r[1]; asm volatile("" : "+v"(x), "+v"(y)); return __builtin_bit_cast(unsigned, __builtin_bit_cast(h16x2, x) + __builtin_bit_cast(h16x2, y)); }
__device__ __forceinline__ unsigned swap16_sumh(unsigned a, unsigned b) { const u32x2v r = __builtin_amdgcn_permlane16_swap(a, b, false, false); unsigned x = r[0], y = r[1]; asm volatile("" : "+v"(x), "+v"(y)); return __builtin_bit_cast(unsigned, __builtin_bit_cast(h16x2, x) + __builtin_bit_cast(h16x2, y)); }
__device__ __forceinline__ void v4_compute(const VX& X, const v4u (&vq)[16], bf16* dst, bool b3) {
    const unsigned ww[8] = {X.a.x, X.a.y, X.a.z, X.a.w, X.b.x, X.b.y, X.b.z, X.b.w};
    h16x2 acc[16];
#pragma unroll
    for (int q = 0; q < 16; ++q) acc[q] = (h16x2){(_Float16)0, (_Float16)0};
#pragma unroll
    for (int i = 0; i < 16; ++i) { const unsigned vw[4] = {vq[i].x, vq[i].y, vq[i].z, vq[i].w}; const h16x2 wp = __builtin_bit_cast(h16x2, ww[i >> 1]); const _Float16 wi = (i & 1) ? wp[1] : wp[0]; const h16x2 w2 = {wi, wi};
#pragma unroll
        for (int w = 0; w < 4; ++w) { acc[4 * w] += w2 * cvt4h<0>(vw[w]); acc[4 * w + 1] += w2 * cvt4h<1>(vw[w]); acc[4 * w + 2] += w2 * cvt4h<2>(vw[w]); acc[4 * w + 3] += w2 * cvt4h<3>(vw[w]); } }
    unsigned a[16], r[8], r2[4], r3[2];
#pragma unroll
    for (int q = 0; q < 16; ++q) a[q] = __builtin_bit_cast(unsigned, acc[q]);
#pragma unroll
    for (int j = 0; j < 8; ++j) r[j] = swap32_sumh(a[j], a[8 + j]);
#pragma unroll
    for (int j = 0; j < 4; ++j) r2[j] = swap16_sumh(r[j], r[4 + j]);
#pragma unroll
    for (int j = 0; j < 2; ++j) { const unsigned snd = b3 ? r2[j] : r2[2 + j], kp = b3 ? r2[2 + j] : r2[j];
        const unsigned got = (unsigned)__builtin_amdgcn_update_dpp(0, (int)snd, 0x128, 0xF, 0xF, true);
        r3[j] = __builtin_bit_cast(unsigned, __builtin_bit_cast(h16x2, kp) + __builtin_bit_cast(h16x2, got)); }
    const h16x2 y0 = __builtin_bit_cast(h16x2, r3[0]), y1 = __builtin_bit_cast(h16x2, r3[1]);
    v2u o; o.x = pk2((float)y0[0], (float)y0[1]); o.y = pk2((float)y1[0], (float)y1[1]); *(v2u*)dst = o;
}
__device__ __forceinline__ void peer4_v(const Args& A0, Frame& F0) {
    LAUNDER();
    const int lane = F.lane, g = lane >> 3, m = lane & 7;
    const int xs = blockIdx.x & 3, nwv = (F.G >> 2) * NWAVES, wv = (blockIdx.x >> 2) * NWAVES + F.wave;
    const unsigned char* tab = (const unsigned char*)P_PV + (size_t)xs * 16384 * 128; const unsigned lofs = 16u * (unsigned)m;
    const bool b5 = lane & 32, b4 = lane & 16, b3 = lane & 8;
    bf16* yp = P_Y + 256 * xs + 32 * m + (b5 ? 16 : 0) + (b4 ? 8 : 0) + (b3 ? 4 : 0);
    const bf16* Wp = P_W16; const bf16* IDXp = P_IDX;
    const int n = (NTOK - wv + nwv - 1) / nwv;
#define TOKK(k) (wv + ((k) < n ? (k) : n - 1) * nwv)
    v4u qa[16], qb[16];
    Ids i1 = ld_ids(IDXp, TOKK(1), g), i2 = ld_ids(IDXp, TOKK(2), g);
    __builtin_amdgcn_sched_barrier(0);
    { const Ids i0 = ld_ids(IDXp, TOKK(0), g); ids_issue(tab, lofs, i0, qa); }
    VX x0 = ld_vx(Wp, TOKK(0), g), x1 = x0;
    for (int k = 0; k < n; k += 2) {
        ids_issue(tab, lofs, i1, qb); x1 = ld_vx(Wp, TOKK(k + 1), g);
        i1 = ld_ids(IDXp, TOKK(k + 3), g);
        __builtin_amdgcn_sched_barrier(0);
        v4_compute(x0, qa, yp + (size_t)TOKK(k) * DM, b3);
        __builtin_amdgcn_sched_barrier(0);
        ids_issue(tab, lofs, i2, qa); x0 = ld_vx(Wp, TOKK(k + 2), g);
        i2 = ld_ids(IDXp, TOKK(k + 4), g);
        __builtin_amdgcn_sched_barrier(0);
        v4_compute(x1, qb, yp + (size_t)TOKK(k + 1) * DM, b3);
        __builtin_amdgcn_sched_barrier(0);
    }
#undef TOKK
}
#endif
#if PEER_Q4
#define PEER_PH_U peer4_u
#define PEER_PH_R peer4_r
#define PEER_PH_V peer4_v
#else
#define PEER_PH_U peer_slice_u
#define PEER_PH_R peer_slice_r
#define PEER_PH_V peer_slice_v
#endif
__device__ __forceinline__ Row16 ln2_in(const bf16* Xp, const float* stats, const float* lng1, const float* lnb1, const bf16* Yp, const float* gtp, int tok, int lane) {
    const f32x2 st = *(const f32x2*)(stats + (size_t)tok * 2);
    const Row16 xr = layer_norm_apply(ld_row_bf16(Xp + (size_t)tok * DM, lane), st[0], st[1], lng1, lnb1, lane), gt = ld_row(gtp, lane);
    const v4u ya = *(const v4u*)(Yp + (size_t)tok * DM + 8 * lane), yb = *(const v4u*)(Yp + (size_t)tok * DM + 512 + 8 * lane);
    Row16 v;
    v.a0 = xr.a0 * DN_ALPHA + (f32x4){bflo(ya.x), bfhi(ya.x), bflo(ya.y), bfhi(ya.y)} * gt.a0; v.a1 = xr.a1 * DN_ALPHA + (f32x4){bflo(ya.z), bfhi(ya.z), bflo(ya.w), bfhi(ya.w)} * gt.a1;
    v.b0 = xr.b0 * DN_ALPHA + (f32x4){bflo(yb.x), bfhi(yb.x), bflo(yb.y), bfhi(yb.y)} * gt.b0; v.b1 = xr.b1 * DN_ALPHA + (f32x4){bflo(yb.z), bfhi(yb.z), bflo(yb.w), bfhi(yb.w)} * gt.b1;
    return v;
}
__device__ __forceinline__ void peer_slice_ln(const Args& A0, Frame& F0, int l) {
    LAUNDER();
    const int lane = F.lane; const RowSpan sp = wave_span(F.gw, F.NGW);
    const Row16 G2 = ld_row(IN_ln_g + (size_t)(l * 2 + 1) * DM, lane), B2 = ld_row(IN_ln_b + (size_t)(l * 2 + 1) * DM, lane);
    const Row16 AG1 = row_scale(ld_row(IN_ln_g + (size_t)(l * 2 + 0) * DM, lane), DN_ALPHA), AB1 = row_scale(ld_row(IN_ln_b + (size_t)(l * 2 + 0) * DM, lane), DN_ALPHA);
    const bool lastl = (l + 1 == DEPTH);
    for (int s0 = sp.t0; s0 < sp.t1; ) { const int b = s0 >> 11, s1 = sp.t1 < ((b + 1) << 11) ? sp.t1 : ((b + 1) << 11);
        const Row16 GT = ld_row(P_MOD + ((size_t)l * 32 + b) * MODW + 5120, lane);
        const float* m1 = P_MOD + ((size_t)(lastl ? l : l + 1) * 32 + b) * MODW; const Row16 SC1 = row_add1(ld_row(m1 + 1024, lane)), SH = ld_row(m1, lane);
        struct Raw { v4u xa, xb, ya, yb; f32x2 st; };
        auto ldraw = [&](int tok) __attribute__((always_inline)) { Raw r; const bf16* px = P_XT + (size_t)tok * DM; const bf16* py = P_Y + (size_t)tok * DM;
            r.xa = *(const v4u*)(px + 8 * lane); r.xb = *(const v4u*)(px + 512 + 8 * lane); r.ya = *(const v4u*)(py + 8 * lane); r.yb = *(const v4u*)(py + 512 + 8 * lane); r.st = *(const f32x2*)(P_STATS + (size_t)tok * 2); return r; };
        auto row = [&](const Raw& r, int tok) __attribute__((always_inline)) {
            const Row16 ax = row_affine2(unpack_row(r.xa, r.xb), r.st[1], -r.st[0] * r.st[1], AG1, AB1), y = unpack_row(r.ya, r.yb);
            const Row16 v = row_fma(y, GT, ax);
            float mu, rs; row_stats(v, mu, rs);
            const Row16 xn = row_affine2(v, rs, -mu * rs, G2, B2);
            if (lastl) st_row(P_X + (size_t)tok * DM, lane, xn);
            else { st_row_bf16(P_XS + (size_t)tok * DM, lane, xn); st_row_bf16(P_HB + (size_t)tok * DM, lane, row_fma(xn, SC1, SH)); } };
#define CLP(t) ((t) < s1 - 2 ? (t) : s1 - 2)
        Raw a0 = ldraw(s0), a1 = ldraw(s0 + 1);
        for (int tok = s0; tok < s1; tok += 4) {
            const Raw b0 = ldraw(CLP(tok + 2)), b1 = ldraw(CLP(tok + 2) + 1);
            __builtin_amdgcn_sched_barrier(0);
            row(a0, tok); row(a1, tok + 1);
            __builtin_amdgcn_sched_barrier(0);
            a0 = ldraw(CLP(tok + 4)); a1 = ldraw(CLP(tok + 4) + 1);
            __builtin_amdgcn_sched_barrier(0);
            row(b0, CLP(tok + 2)); row(b1, CLP(tok + 2) + 1);
            __builtin_amdgcn_sched_barrier(0);
        }
#undef CLP
        s0 = s1; }
}
#endif

__device__ __forceinline__ void hgrn_ws(const Args& A0, Frame& F0, int l) {
    LAUNDER();
    constexpr int BUFSZ = 47104, QM_O = 0, KM_O = 8704, QI_O = 17408, KET_O = 26112, VT_O = 36352, EBC_O = 46592;
    constexpr int OL_OFF = 2 * BUFSZ, OLSZ = 8704, SCR_OFF = OL_OFF + 2 * OLSZ, AL_SZ = 2560, SCRW = AL_SZ + 8704;
    static_assert(SCR_OFF + 4 * SCRW <= LDSCTL_OFF, "hgrn_ws LDS");
    const int tid = F.tid, lane = F.lane, w = F.wave;
    LAS unsigned char* L = F.lds;
    constexpr int NCH = SEQ / 32;
    for (int unit = blockIdx.x; unit < 128; unit += F.G) {
        const int b = unit >> 2, h = unit & 3;
        if (w < 4) {
            const int mw = w, fr = lane & 15, fq = lane >> 4;
            LAS unsigned char* ALw = L + SCR_OFF + mw * SCRW; LAS unsigned char* STw = ALw + AL_SZ;
            f32x4 S[8][2];
#pragma unroll
            for (int dt = 0; dt < 8; ++dt) { S[dt][0] = (f32x4){0.f, 0.f, 0.f, 0.f}; S[dt][1] = (f32x4){0.f, 0.f, 0.f, 0.f}; }
            { const v2u z2 = {0u, 0u}; *(LAS v2u*)(ALw + (fr) * 80 + (16 + 4 * fq) * 2) = z2; }
            hg_bar();
            for (int c = 0; c < NCH; ++c) {
                LAS unsigned char* B = L + (c & 1) * BUFSZ; LAS unsigned char* OLc = L + OL_OFF + (c & 1) * OLSZ;
#pragma unroll
                for (int dt = 0; dt < 8; ++dt)
#pragma unroll
                    for (int et = 0; et < 2; ++et) { v2u sw; sw.x = cvtpk(S[dt][et][0], S[dt][et][1]); sw.y = cvtpk(S[dt][et][2], S[dt][et][3]); *(LAS v2u*)(STw + (16 * et + fr) * 272 + (16 * dt + 4 * fq) * 2) = sw; }
#pragma unroll
                for (int ts = 0; ts < 2; ++ts)
#pragma unroll
                    for (int tt = 0; tt < 2; ++tt) { if (ts == 1 && tt == 0) continue;
                        f32x4 at = (f32x4){0.f, 0.f, 0.f, 0.f};
#pragma unroll
                        for (int ks = 0; ks < 4; ++ks) at = MFMA16(*(const LAS bf16x8*)(B + KM_O + (16 * ts + fr) * 272 + (32 * ks + 8 * fq) * 2), *(const LAS bf16x8*)(B + QM_O + (16 * tt + fr) * 272 + (32 * ks + 8 * fq) * 2), at);
                        const int t = 16 * tt + fr, s0 = 16 * ts + 4 * fq; v2u aw;
                        aw.x = cvtpk(s0 <= t ? at[0] : 0.f, s0 + 1 <= t ? at[1] : 0.f); aw.y = cvtpk(s0 + 2 <= t ? at[2] : 0.f, s0 + 3 <= t ? at[3] : 0.f);
                        *(LAS v2u*)(ALw + t * 80 + s0 * 2) = aw; }
                asm volatile("s_waitcnt lgkmcnt(0)" ::: "memory");
                const bf16x8 vb0 = *(const LAS bf16x8*)(B + VT_O + (32 * mw + fr) * 80 + 16 * fq), vb1 = *(const LAS bf16x8*)(B + VT_O + (32 * mw + 16 + fr) * 80 + 16 * fq);
#pragma unroll
                for (int tt = 0; tt < 2; ++tt) {
                    f32x4 o0 = (f32x4){0.f, 0.f, 0.f, 0.f}, o1 = (f32x4){0.f, 0.f, 0.f, 0.f};
#pragma unroll
                    for (int ks = 0; ks < 4; ++ks) { const bf16x8 qi = *(const LAS bf16x8*)(B + QI_O + (16 * tt + fr) * 272 + (32 * ks + 8 * fq) * 2);
                        o0 = MFMA16(*(const LAS bf16x8*)(STw + (fr) * 272 + (32 * ks + 8 * fq) * 2), qi, o0); o1 = MFMA16(*(const LAS bf16x8*)(STw + (16 + fr) * 272 + (32 * ks + 8 * fq) * 2), qi, o1); }
                    const bf16x8 al = *(const LAS bf16x8*)(ALw + (16 * tt + fr) * 80 + 16 * fq);
                    o0 = MFMA16(vb0, al, o0); o1 = MFMA16(vb1, al, o1);
                    v2u w0, w1; w0.x = cvtpk(o0[0], o0[1]); w0.y = cvtpk(o0[2], o0[3]); w1.x = cvtpk(o1[0], o1[1]); w1.y = cvtpk(o1[2], o1[3]);
                    *(LAS v2u*)(OLc + (16 * tt + fr) * 272 + (32 * mw + 4 * fq) * 2) = w0; *(LAS v2u*)(OLc + (16 * tt + fr) * 272 + (32 * mw + 16 + 4 * fq) * 2) = w1; }
#pragma unroll
                for (int dt = 0; dt < 8; ++dt) { const f32x4 e4 = *(const LAS f32x4*)(B + EBC_O + (16 * dt + 4 * fq) * 4); const bf16x8 ke = *(const LAS bf16x8*)(B + KET_O + (16 * dt + fr) * 80 + 16 * fq);
                    S[dt][0] = MFMA16(ke, vb0, S[dt][0] * e4); S[dt][1] = MFMA16(ke, vb1, S[dt][1] * e4); }
                hg_bar();
            }
        } else {
            const int gt = tid - 256, d = gt >> 1, half = gt & 1, et = gt >> 3, eg = (gt & 7) * 16;
            const size_t ebase = ((size_t)b * SEQ + 16 * half) * 512 + h * 128 + d;
            const size_t obase = ((size_t)b * SEQ + et) * 512 + h * 128 + eg;
            f32x4 gn[4];
#pragma unroll
            for (int q = 0; q < 4; ++q) gn[q] = *(const f32x4*)(IN_hg_norm_g + l * 512 + h * 128 + eg + 4 * q);
            unsigned short rg[16], rk[16], rq[16], rv[16];
#define WS_LOAD(c) do { const size_t o_ = ebase + (size_t)(c) * 32 * 512; _Pragma("unroll") for (int i = 0; i < 16; ++i) { rg[i] = P_GLOG[o_ + i * 512]; rk[i] = P_KK[o_ + i * 512]; rq[i] = P_QA[o_ + i * 512]; rv[i] = P_IA[o_ + i * 512]; } } while (0)
#define WS_STAGE(c) do { LAS unsigned char* B_ = L + ((c) & 1) * BUFSZ; float cs_[16], run_ = 0.f; \
            _Pragma("unroll") for (int i = 0; i < 16; ++i) { run_ += bf2f(rg[i]); cs_[i] = run_; } \
            const float ptot_ = dppf<0xB1>(run_), offs_ = half ? ptot_ : 0.f, bmid_ = half ? ptot_ : run_, bC_ = run_ + ptot_, emid_ = __expf(bmid_), ecm_ = __expf(bC_ - bmid_); \
            unsigned ke_[16]; \
            _Pragma("unroll") for (int i = 0; i < 16; ++i) { const float bt_ = offs_ + cs_[i], qmf_ = bf2f(rq[i]) * __expf(fminf(bt_ - bmid_, 80.f)), kmf_ = bf2f(rk[i]) * __expf(fminf(bmid_ - bt_, 80.f)); const int t_ = 16 * half + i; \
                *(LAS unsigned short*)(B_ + QM_O + t_ * 272 + d * 2) = (unsigned short)cvtpk(qmf_, 0.f); *(LAS unsigned short*)(B_ + KM_O + t_ * 272 + d * 2) = (unsigned short)cvtpk(kmf_, 0.f); \
                *(LAS unsigned short*)(B_ + QI_O + t_ * 272 + d * 2) = (unsigned short)cvtpk(qmf_ * emid_, 0.f); ke_[i] = cvtpk(kmf_ * ecm_, 0.f) & 0xffffu; } \
            v4u k0_, k1_, v0_, v1_; k0_.x = ke_[0] | (ke_[1] << 16); k0_.y = ke_[2] | (ke_[3] << 16); k0_.z = ke_[4] | (ke_[5] << 16); k0_.w = ke_[6] | (ke_[7] << 16); \
            k1_.x = ke_[8] | (ke_[9] << 16); k1_.y = ke_[10] | (ke_[11] << 16); k1_.z = ke_[12] | (ke_[13] << 16); k1_.w = ke_[14] | (ke_[15] << 16); \
            v0_.x = rv[0] | ((unsigned)rv[1] << 16); v0_.y = rv[2] | ((unsigned)rv[3] << 16); v0_.z = rv[4] | ((unsigned)rv[5] << 16); v0_.w = rv[6] | ((unsigned)rv[7] << 16); \
            v1_.x = rv[8] | ((unsigned)rv[9] << 16); v1_.y = rv[10] | ((unsigned)rv[11] << 16); v1_.z = rv[12] | ((unsigned)rv[13] << 16); v1_.w = rv[14] | ((unsigned)rv[15] << 16); \
            *(LAS v4u*)(B_ + KET_O + d * 80 + half * 32) = k0_; *(LAS v4u*)(B_ + KET_O + d * 80 + half * 32 + 16) = k1_; *(LAS v4u*)(B_ + VT_O + d * 80 + half * 32) = v0_; *(LAS v4u*)(B_ + VT_O + d * 80 + half * 32 + 16) = v1_; \
            if (half == 0) *(LAS float*)(B_ + EBC_O + d * 4) = __expf(bC_); } while (0)
#define WS_EPI(c, ga0, ga1) do { const LAS unsigned char* O_ = L + OL_OFF + ((c) & 1) * OLSZ + et * 272 + eg * 2; const v4u oa_ = *(const LAS v4u*)O_, ob_ = *(const LAS v4u*)(O_ + 16); \
            const f32x4 o0_ = (f32x4){bflo(oa_.x), bfhi(oa_.x), bflo(oa_.y), bfhi(oa_.y)}, o1_ = (f32x4){bflo(oa_.z), bfhi(oa_.z), bflo(oa_.w), bfhi(oa_.w)}, o2_ = (f32x4){bflo(ob_.x), bfhi(ob_.x), bflo(ob_.y), bfhi(ob_.y)}, o3_ = (f32x4){bflo(ob_.z), bfhi(ob_.z), bflo(ob_.w), bfhi(ob_.w)}; \
            const f32x4 sq_ = (o0_ * o0_ + o1_ * o1_) + (o2_ * o2_ + o3_ * o3_); float ss_ = (sq_[0] + sq_[1]) + (sq_[2] + sq_[3]); \
            ss_ += dppf<0xB1>(ss_); ss_ += dppf<0x4E>(ss_); ss_ += dppf<0x141>(ss_); \
            const float rstd_ = __builtin_amdgcn_rsqf(ss_ * (1.0f / 128.0f) + RMS_EPS); \
            const f32x4 g0_ = (f32x4){bflo(ga0.x), bfhi(ga0.x), bflo(ga0.y), bfhi(ga0.y)}, g1_ = (f32x4){bflo(ga0.z), bfhi(ga0.z), bflo(ga0.w), bfhi(ga0.w)}, g2_ = (f32x4){bflo(ga1.x), bfhi(ga1.x), bflo(ga1.y), bfhi(ga1.y)}, g3_ = (f32x4){bflo(ga1.z), bfhi(ga1.z), bflo(ga1.w), bfhi(ga1.w)}; \
            bf16* op_ = P_OA + obase + (size_t)(c) * 32 * 512; \
            *(v4u*)op_ = pk8(o0_ * rstd_ * gn[0] * g0_, o1_ * rstd_ * gn[1] * g1_); *(v4u*)(op_ + 8) = pk8(o2_ * rstd_ * gn[2] * g2_, o3_ * rstd_ * gn[3] * g3_); } while (0)
            WS_LOAD(0); WS_STAGE(0); WS_LOAD(1);
            hg_bar();
            for (int c = 0; c < NCH; ++c) {
                v4u ga0 = {0u, 0u, 0u, 0u}, ga1 = {0u, 0u, 0u, 0u};
                if (c >= 1) { const bf16* gp = P_GA + obase + (size_t)(c - 1) * 32 * 512; ga0 = *(const v4u*)gp; ga1 = *(const v4u*)(gp + 8); }
                if (c + 1 < NCH) { WS_STAGE(c + 1); if (c + 2 < NCH) WS_LOAD(c + 2); }
                if (c >= 1) WS_EPI(c - 1, ga0, ga1);
                hg_bar();
            }
            { const bf16* gp = P_GA + obase + (size_t)(NCH - 1) * 32 * 512; const v4u ga0 = *(const v4u*)gp, ga1 = *(const v4u*)(gp + 8); WS_EPI(NCH - 1, ga0, ga1); }
#undef WS_LOAD
#undef WS_STAGE
#undef WS_EPI
        }
        hg_bar();
    }
}

__device__ __forceinline__ void hgrn_pipe(const Args& A0, Frame& F0, int l) {
    LAUNDER();
    constexpr int BUFSZ = 47104, QM_OFF = 0, KM_OFF = 8704, QI_OFF = 17408, KET_OFF = 26112, VT_OFF = 36352, EBC_OFF = 46592;
    constexpr int AL_OFF = 2 * BUFSZ, TOT_OFF = AL_OFF + 2560, ST_OFF = TOT_OFF + 2048, OL_OFF = ST_OFF + 8 * 4352;
    static_assert(OL_OFF + 32 * 132 * 4 <= LDSCTL_OFF, "hgrn_pipe LDS");
    const int tid = F.tid, lane = F.lane, w = F.wave, fr = lane & 15, fq = lane >> 4;
    const int d = tid & 127, tq = tid >> 7, et = tid >> 4, eg = (tid & 15) * 8;
    LAS unsigned char* L = F.lds;
    LAS float* TOT = (LAS float*)(L + TOT_OFF); LAS float* OL = (LAS float*)(L + OL_OFF);
    LAS unsigned char* STw = L + ST_OFF + w * 4352;
    for (int unit = blockIdx.x; unit < 128; unit += F.G) {
        const int b = unit >> 2, h = unit & 3;
        const size_t ebase = ((size_t)b * SEQ + 8 * tq) * 512 + h * 128 + d;
        const size_t obase = ((size_t)b * SEQ + et) * 512 + h * 128 + eg;
        const f32x4 gn0 = *(const f32x4*)(IN_hg_norm_g + l * 512 + h * 128 + eg), gn1 = *(const f32x4*)(IN_hg_norm_g + l * 512 + h * 128 + eg + 4);
        f32x4 S[8];
#pragma unroll
        for (int i = 0; i < 8; ++i) S[i] = (f32x4){0.f, 0.f, 0.f, 0.f};
        for (int i = lane; i < 4352 / 4; i += 64) ((LAS unsigned*)STw)[i] = 0u;
        unsigned short rg[8], rk[8], rq[8], rv[8];
#define HG_LOAD(c) do { const size_t o_ = ebase + (size_t)(c) * 32 * 512; _Pragma("unroll") for (int i = 0; i < 8; ++i) { rg[i] = P_GLOG[o_ + i * 512]; rk[i] = P_KK[o_ + i * 512]; rq[i] = P_QA[o_ + i * 512]; rv[i] = P_IA[o_ + i * 512]; } } while (0)
        float cs[8];
#define HG_TOT() do { float run_ = 0.f; _Pragma("unroll") for (int i = 0; i < 8; ++i) { run_ += bf2f(rg[i]); cs[i] = run_; } TOT[tq * 128 + d] = run_; } while (0)
#define HG_STAGE(BW) do { LAS unsigned char* W_ = (BW); const float t0_ = TOT[d], t1_ = TOT[128 + d], t2_ = TOT[256 + d], t3_ = TOT[384 + d]; \
            const float offs_ = (tq > 0 ? t0_ : 0.f) + (tq > 1 ? t1_ : 0.f) + (tq > 2 ? t2_ : 0.f), bmid_ = t0_ + t1_, bC_ = (t0_ + t1_) + (t2_ + t3_); \
            unsigned ke_[8], vv_[8]; const float emid_ = __expf(bmid_), ecm_ = __expf(bC_ - bmid_);     \
            _Pragma("unroll") for (int i = 0; i < 8; ++i) { const float bt_ = offs_ + cs[i], q_ = bf2f(rq[i]), k_ = bf2f(rk[i]); const int t_ = 8 * tq + i; \
                const float qmf_ = q_ * __expf(fminf(bt_ - bmid_, 80.f)), kmf_ = k_ * __expf(fminf(bmid_ - bt_, 80.f)); \
                const unsigned qm_ = cvtpk(qmf_, 0.f), km_ = cvtpk(kmf_, 0.f), qi_ = cvtpk(qmf_ * emid_, 0.f); ke_[i] = cvtpk(kmf_ * ecm_, 0.f); vv_[i] = rv[i]; \
                *(LAS unsigned short*)(W_ + QM_OFF + t_ * 272 + d * 2) = (unsigned short)qm_; *(LAS unsigned short*)(W_ + KM_OFF + t_ * 272 + d * 2) = (unsigned short)km_; *(LAS unsigned short*)(W_ + QI_OFF + t_ * 272 + d * 2) = (unsigned short)qi_; } \
            v4u kw_, vw_; kw_.x = (ke_[0] & 0xffffu) | (ke_[1] << 16); kw_.y = (ke_[2] & 0xffffu) | (ke_[3] << 16); kw_.z = (ke_[4] & 0xffffu) | (ke_[5] << 16); kw_.w = (ke_[6] & 0xffffu) | (ke_[7] << 16); \
            vw_.x = vv_[0] | (vv_[1] << 16); vw_.y = vv_[2] | (vv_[3] << 16); vw_.z = vv_[4] | (vv_[5] << 16); vw_.w = vv_[6] | (vv_[7] << 16); \
            *(LAS v4u*)(W_ + KET_OFF + d * 80 + tq * 16) = kw_; *(LAS v4u*)(W_ + VT_OFF + d * 80 + tq * 16) = vw_; \
            if (tq == 0) *(LAS float*)(W_ + EBC_OFF + d * 4) = __expf(bC_); } while (0)
        constexpr int NCH = SEQ / 32;
        HG_LOAD(0); HG_TOT(); hg_bar(); HG_STAGE(L); HG_LOAD(1); hg_bar();
        v4u rga = {0u, 0u, 0u, 0u};
        for (int c = 0; c < NCH; ++c) {
            const LAS unsigned char* B = L + (c & 1) * BUFSZ;
            if (w < 4) { const int ts = w >> 1, tt = w & 1; f32x4 at = (f32x4){0.f, 0.f, 0.f, 0.f};
#pragma unroll
                for (int ks = 0; ks < 4; ++ks) at = MFMA16(*(const LAS bf16x8*)(B + KM_OFF + (16 * ts + fr) * 272 + (32 * ks + 8 * fq) * 2), *(const LAS bf16x8*)(B + QM_OFF + (16 * tt + fr) * 272 + (32 * ks + 8 * fq) * 2), at);
                const int t = 16 * tt + fr, s0 = 16 * ts + 4 * fq; v2u aw;
                aw.x = cvtpk(s0 <= t ? at[0] : 0.f, s0 + 1 <= t ? at[1] : 0.f); aw.y = cvtpk(s0 + 2 <= t ? at[2] : 0.f, s0 + 3 <= t ? at[3] : 0.f);
                *(LAS v2u*)(L + AL_OFF + t * 80 + s0 * 2) = aw; }
            f32x4 o[2];
#pragma unroll
            for (int tt = 0; tt < 2; ++tt) { o[tt] = (f32x4){0.f, 0.f, 0.f, 0.f};
#pragma unroll
                for (int ks = 0; ks < 4; ++ks) o[tt] = MFMA16(*(const LAS bf16x8*)(B + QI_OFF + (16 * tt + fr) * 272 + (32 * ks + 8 * fq) * 2), *(const LAS bf16x8*)(STw + fr * 272 + (32 * ks + 8 * fq) * 2), o[tt]); }
            if (c + 1 < NCH) HG_TOT();
            if (c >= 1) { const f32x4 o0 = *(const LAS f32x4*)(OL + et * 132 + eg), o1 = *(const LAS f32x4*)(OL + et * 132 + eg + 4);
              float ss = ((o0[0] * o0[0] + o0[1] * o0[1]) + (o0[2] * o0[2] + o0[3] * o0[3])) + ((o1[0] * o1[0] + o1[1] * o1[1]) + (o1[2] * o1[2] + o1[3] * o1[3]));
              ss += __shfl_xor(ss, 1); ss += __shfl_xor(ss, 2); ss += __shfl_xor(ss, 4); ss += __shfl_xor(ss, 8);
              const float rstd = __builtin_amdgcn_rsqf(ss * (1.0f / 128.0f) + RMS_EPS);
              const f32x4 r0 = o0 * rstd * gn0 * (f32x4){bflo(rga.x), bfhi(rga.x), bflo(rga.y), bfhi(rga.y)}, r1 = o1 * rstd * gn1 * (f32x4){bflo(rga.z), bfhi(rga.z), bflo(rga.w), bfhi(rga.w)};
              *(v4u*)(P_OA + obase + (size_t)(c - 1) * 32 * 512) = pk8(r0, r1); }
            hg_bar();
            const bf16x8 vb = *(const LAS bf16x8*)(B + VT_OFF + (16 * w + fr) * 80 + 16 * fq);
#pragma unroll
            for (int tt = 0; tt < 2; ++tt) { o[tt] = MFMA16(*(const LAS bf16x8*)(L + AL_OFF + (16 * tt + fr) * 80 + 16 * fq), vb, o[tt]);
#pragma unroll
                for (int j = 0; j < 4; ++j) OL[(16 * tt + 4 * fq + j) * 132 + 16 * w + fr] = o[tt][j]; }
#pragma unroll
            for (int dt = 0; dt < 8; ++dt) { const f32x4 e4 = *(const LAS f32x4*)(B + EBC_OFF + (16 * dt + 4 * fq) * 4); S[dt] = S[dt] * e4;
                S[dt] = MFMA16(*(const LAS bf16x8*)(B + KET_OFF + (16 * dt + fr) * 80 + 16 * fq), vb, S[dt]);
                v2u sw; sw.x = cvtpk(S[dt][0], S[dt][1]); sw.y = cvtpk(S[dt][2], S[dt][3]); *(LAS v2u*)(STw + fr * 272 + (16 * dt + 4 * fq) * 2) = sw; }
            if (c + 1 < NCH) { HG_STAGE(L + ((c + 1) & 1) * BUFSZ); if (c + 2 < NCH) HG_LOAD(c + 2); }
            rga = *(const v4u*)(P_GA + obase + (size_t)c * 32 * 512);
            hg_bar();
        }
        { const f32x4 o0 = *(const LAS f32x4*)(OL + et * 132 + eg), o1 = *(const LAS f32x4*)(OL + et * 132 + eg + 4);
          float ss = ((o0[0] * o0[0] + o0[1] * o0[1]) + (o0[2] * o0[2] + o0[3] * o0[3])) + ((o1[0] * o1[0] + o1[1] * o1[1]) + (o1[2] * o1[2] + o1[3] * o1[3]));
          ss += __shfl_xor(ss, 1); ss += __shfl_xor(ss, 2); ss += __shfl_xor(ss, 4); ss += __shfl_xor(ss, 8);
          const float rstd = __builtin_amdgcn_rsqf(ss * (1.0f / 128.0f) + RMS_EPS);
          const f32x4 r0 = o0 * rstd * gn0 * (f32x4){bflo(rga.x), bfhi(rga.x), bflo(rga.y), bfhi(rga.y)}, r1 = o1 * rstd * gn1 * (f32x4){bflo(rga.z), bfhi(rga.z), bflo(rga.w), bfhi(rga.w)};
          *(v4u*)(P_OA + obase + (size_t)(NCH - 1) * 32 * 512) = pk8(r0, r1); }
        hg_bar();
#undef HG_LOAD
#undef HG_TOT
#undef HG_STAGE
    }
}

#if PEER_KSLICE
constexpr int PH_L = 11;
#else
constexpr int PH_L = 8;
#endif
constexpr int NPHASE = 3 + PH_L * DEPTH;
__global__ void __launch_bounds__(NTHREADS, 2) trunk_fwd(Args args) {
    extern __shared__ __attribute__((aligned(16))) unsigned char lds[];
    Frame F;
    F.lds = (LAS unsigned char*)lds;
        F.tid = threadIdx.x; F.lane = F.tid & 63; F.wave = __builtin_amdgcn_readfirstlane(F.tid >> 6);
    F.G = gridDim.x; { const int bx = blockIdx.x; F.vcu = (F.G % 8 == 0) ? (bx % 8) * (F.G / 8) + bx / 8 : bx; }
    F.gw = F.vcu * NWAVES + F.wave; F.NGW = F.G * NWAVES;
    const Args& A0 = args; Frame& F0 = F;
    gu32* const ctl = (gu32*)(A0.ws + WS_CTL);
    for (int u = F.tid; u < (LDS_BYTES - LDSCTL_OFF) / 4; u += NTHREADS) ((LAS unsigned*)(F.lds + LDSCTL_OFF))[u] = 0u;
    __syncthreads();
    XcdBarrier bar; bar.bar = (unsigned*)(ctl + CW_BAR); bar.x = 0; bar.st = nullptr;
    if (!MK_PER_PHASE) bar = xcd_barrier_post((unsigned*)(ctl + CW_BAR), (volatile LAS unsigned*)(F.lds + MISC_OFF) + 8);
    const int lo = args.ph_lo, hi = args.ph_hi;
#define IN(k) (lo <= (k) && (k) < hi)
#define SEAM(k) do { if (IN(k) && IN((k) + 1)) { XcdBarrier b2 = bar; b2.bar = opq(b2.bar); xcd_barrier(b2); if (PROBE_MASK & 8192) xcd_barrier(b2); } } while (0)

    if (PROBE_MASK & (1 << 18 | 1 << 19)) {
        unsigned char* base = A0.ws + WS_XT + (size_t)F.gw * 65536; const int fr = F.lane & 15, fq = F.lane >> 4;
        const size_t lofs = (PROBE_MASK & (1 << 18)) ? ((size_t)fr * 2048 + fq * 16) : ((size_t)(fr & 7) * 2048 + (fr >> 3) * 64 + fq * 16);
        const v4u val = {1u, 2u, 3u, 4u};
        for (int it = 0; it < 1024; ++it) { const int rg = it & 1, cg = it >> 1;
            *(v4u*)(base + (size_t)rg * ((PROBE_MASK & (1 << 18)) ? 16 : 8) * 2048 + (size_t)(cg & 15) * 128 + lofs) = val; }
        __syncthreads();
    }
    for (int rep = 0; rep < ((PROBE_MASK & 4096) ? 2 : 1); ++rep) {
    if (IN(0)) { phase_proA(A0, F0); } SEAM(0);
    if (IN(1)) { phase_proA2(A0, F0); } SEAM(1);
    if (IN(2)) { phase_proB(A0, F0); } SEAM(2);
    }

    for (int l = 0; l < DEPTH; ++l) {
        const int pb = 3 + PH_L * l;
        for (int rep = 0; rep < ((PROBE_MASK & 1) ? 2 : 1); ++rep)
        if (IN(pb + 0)) { LAUNDER();
            if (GEMM_STAGGER) { const unsigned long long dly = (unsigned long long)(((unsigned)blockIdx.x * 5u) & 15u) * GEMM_STAGGER, t0 = __builtin_amdgcn_s_memrealtime();
                while (__builtin_amdgcn_s_memrealtime() - t0 < dly) __builtin_amdgcn_s_sleep(8); }
            pg8::Gemm g{P_HB, P_WIN + (size_t)l * INW * DM, NTOK, INW, DM}; pg8::StaticOrder S; S.init(NTOK, INW, F.G, (int)blockIdx.x);
            pg8::EpiInProj E{ws, P_LB + l * 512};
            pg8::gemm_phase<pg8::EpiInProj, pg8::StaticOrder, true, true>(F.lds, g, S, E, F.tid);
        }
        SEAM(pb + 0);
        if (IN(pb + 1)) { for (int rep = 0; rep < ((PROBE_MASK & 2) ? 2 : 1); ++rep) { if (HGRN_WS) hgrn_ws(A0, F0, l); else if (HGRN_PIPE) hgrn_pipe(A0, F0, l); else hgrn_fast(A0, F0, l); } for (int rep = 0; rep < ((PROBE_MASK & 4) ? 2 : 1); ++rep) attn_fast(A0, F0, l + 4 * rep); }
        SEAM(pb + 1);
        for (int rep = 0; rep < ((PROBE_MASK & 8) ? 2 : 1); ++rep)
        if (IN(pb + 2)) {
            { LAUNDER(); pg8::Gemm g{P_OA, P_WUA + (size_t)l * DM * 512, NTOK, DM, 512, P_OB, P_WUB + (size_t)l * DM * 512}; pg8::SegOrder S; S.init(NTOK, DM, F.G, (int)blockIdx.x);
              pg8::EpiUp2 E{P_MERGED, (const unsigned char*)P_GTA, (const unsigned char*)P_GTB}; pg8::gemm_phase<pg8::EpiUp2, pg8::SegOrder, true, true>(F.lds, g, S, E, F.tid); }
        }
        SEAM(pb + 2);
        for (int rep = 0; rep < ((PROBE_MASK & 32768) ? 2 : 1); ++rep)
        if (IN(pb + 3)) { LAUNDER();
            pg8::Gemm g{P_MERGED, P_WO + (size_t)l * DM * DM, NTOK, DM, DM}; pg8::StaticOrder S; S.init(NTOK, DM, F.G, (int)blockIdx.x);
            pg8::EpiWo E{l == 0 ? IN_x : (const float*)nullptr, P_XS, P_XT, P_MOD + (size_t)l * 32 * MODW + 2048, DN_ALPHA};
            pg8::gemm_phase<pg8::EpiWo, pg8::StaticOrder, true, true>(F.lds, g, S, E, F.tid);
        }
        SEAM(pb + 3);
        if (IN(pb + 4)) { for (int rep = 0; rep < ((PROBE_MASK & 65536) ? 2 : 1); ++rep) { if (rep == 0) peer_convert(A0, F0, l); phase_ln1(A0, F0, l); } }
        SEAM(pb + 4);
        for (int rep = 0; rep < ((PROBE_MASK & 16) ? 2 : 1); ++rep)
        if (IN(pb + 5)) { LAUNDER();
            pg8::Gemm g{P_HB, P_WPQ + (size_t)l * DM * DM, NTOK, DM, DM}; pg8::StaticOrder S; S.init(NTOK, DM, F.G, (int)blockIdx.x);
            if (PROBE_MASK & 2048) { pg8::Gemm g2{P_HB, P_WPQ + (size_t)l * DM * DM, NTOK, DM, DM, P_HB, P_WPQ + (size_t)l * DM * DM}; pg8::SegOrder S2; S2.init(NTOK, DM, F.G, (int)blockIdx.x);
                pg8::EpiProbeK2 E2{P_PQ}; pg8::gemm_phase<pg8::EpiProbeK2, pg8::SegOrder, true, true>(F.lds, g2, S2, E2, F.tid); }
            else { pg8::EpiPQ E{P_PQ}; pg8::gemm_phase<pg8::EpiPQ, pg8::StaticOrder, true, true>(F.lds, g, S, E, F.tid); }
        }
        SEAM(pb + 5);
        if (IN(pb + 6)) { for (int rep = 0; rep < ((PROBE_MASK & 32) ? 2 : 1); ++rep) { if (FAST_TOPK) peer_topk_fast(A0, F0, l); else peer_topk_simple(A0, F0, l); __syncthreads(); } }
        SEAM(pb + 6);
#if PEER_KSLICE
        if (IN(pb + 7)) { for (int rep = 0; rep < ((PROBE_MASK & 128) ? 2 : 1); ++rep) PEER_PH_U(A0, F0); }
        SEAM(pb + 7);
        if (IN(pb + 8)) { PEER_PH_R(A0, F0); }
        SEAM(pb + 8);
        if (IN(pb + 9)) { for (int rep = 0; rep < ((PROBE_MASK & 256) ? 2 : 1); ++rep) PEER_PH_V(A0, F0); }
        SEAM(pb + 9);
        if (IN(pb + 10)) { for (int rep = 0; rep < ((PROBE_MASK & 131072) ? 2 : 1); ++rep) peer_slice_ln(A0, F0, l); }
        SEAM(pb + 10);
#else
        if (IN(pb + 7)) { phase_peer_expert(A0, F0, l); }
        SEAM(pb + 7);
#endif
    }
#undef IN
#undef SEAM
}

extern "C" void kernel_launch(void* const* d_in, const int* in_sizes, int n_in, void* d_out, int out_size, void* d_ws, size_t ws_size, hipStream_t stream) {
    static int grid = 0;
    if (grid == 0) {
        if (n_in != 16 || out_size != NTOK * DM || ws_size < WS_END) { fprintf(stderr, "kernel_launch: unexpected shapes (n_in %d, out %d, ws %zu)\n", n_in, out_size, ws_size); grid = -1; return; }
        int dev = 0, cus = 0, per_cu = 0;
        if (hipGetDevice(&dev) != hipSuccess || hipDeviceGetAttribute(&cus, hipDeviceAttributeMultiprocessorCount, dev) != hipSuccess) { grid = -1; return; }
        if (hipFuncSetAttribute((const void*)trunk_fwd, hipFuncAttributeMaxDynamicSharedMemorySize, LDS_BYTES) != hipSuccess) { fprintf(stderr, "kernel_launch: hipFuncSetAttribute failed\n"); grid = -1; return; }
        if (hipOccupancyMaxActiveBlocksPerMultiprocessor(&per_cu, (const void*)trunk_fwd, NTHREADS, LDS_BYTES) != hipSuccess || per_cu < 1) { fprintf(stderr, "kernel_launch: occupancy query says %d\n", per_cu); }
        (void)hipGetLastError();
        grid = cus;
    }
    if (grid < 0) return;
    if (hipMemsetAsync((char*)d_ws + WS_CTL, 0, CTL_ZERO_BYTES, stream) != hipSuccess) return;
    Args a{};
    for (int i = 0; i < 16; ++i) a.in[i] = (const float*)d_in[i];
    a.out = (float*)d_out; a.ws = (unsigned char*)d_ws;
#if MK_PER_PHASE
    for (int k = 0; k < NPHASE; ++k) { a.ph_lo = k; a.ph_hi = k + 1; hipLaunchKernelGGL(trunk_fwd, dim3(grid), dim3(NTHREADS), LDS_BYTES, stream, a); }
#else
    a.ph_lo = 0; a.ph_hi = NPHASE;
    hipLaunchKernelGGL(trunk_fwd, dim3(grid), dim3(NTHREADS), LDS_BYTES, stream, a);
#endif
    const hipError_t le = hipPeekAtLastError();
    if (le != hipSuccess) fprintf(stderr, "kernel_launch: launch failed: %s\n", hipGetErrorName(le));
}
```
